# Optimizing an MI355X kernel written in HIP

```python
import math
import jax, jax.numpy as jnp
from jax import lax
import numpy as np

D_MODEL = 1024
BATCH = 4
SEQ = 4096
DEPTH = 4

EPS = 1e-6
N_EVEN = (DEPTH + 1) // 2
N_ODD = DEPTH // 2
A_WIDTH = D_MODEL // 2
SGU_HEADS = 4
SGU_HEAD_DIM = A_WIDTH // SGU_HEADS
SGU_CHUNK = 128
B_WIDTH = D_MODEL - A_WIDTH
HGRN_HEADS = 4
HGRN_HEAD_DIM = B_WIDTH // HGRN_HEADS
HGRN_CHUNK = 64
C_WIDTH = D_MODEL // 2
CONV_WIDTH = 3
D_WIDTH = D_MODEL - C_WIDTH
DIFF_HEADS = 4
DIFF_V_DIM = D_WIDTH // DIFF_HEADS
DIFF_QK_DIM = DIFF_V_DIM // 2
ATTN_BLOCK = 128
ROPE_THETA = 10000.0
D_FF = 4 * D_MODEL

EVEN_SIZES = (A_WIDTH, A_WIDTH, B_WIDTH, B_WIDTH, B_WIDTH, B_WIDTH, B_WIDTH)
ODD_SIZES = (C_WIDTH, C_WIDTH, C_WIDTH, D_WIDTH, D_WIDTH, D_WIDTH)
EVEN_IN = sum(EVEN_SIZES)
ODD_IN = sum(ODD_SIZES)

kernel_name = "hybrid_sgu_hgrn2_shortconv_diffattn_encoder"


def split_cols(t, sizes):
    out, start = [], 0
    for s in sizes:
        out.append(t[..., start:start + s])
        start += s
    return out


def rmsnorm(x, g):
    xf = x.astype(jnp.float32)
    y = xf * lax.rsqrt(jnp.mean(xf * xf, axis=-1, keepdims=True) + EPS)
    return (y * g.astype(jnp.float32)).astype(x.dtype)


def rope_tables(seq, dim):
    inv = 1.0 / (ROPE_THETA ** (jnp.arange(0, dim, 2, dtype=jnp.float32) / dim))
    ang = jnp.arange(seq, dtype=jnp.float32)[:, None] * inv[None, :]
    return jnp.cos(ang), jnp.sin(ang)


def apply_rope(x, cos, sin):
    c = cos[None, :, None, None, :]
    s = sin[None, :, None, None, :]
    x1, x2 = jnp.split(x.astype(jnp.float32), 2, axis=-1)
    return jnp.concatenate([x1 * c - x2 * s, x2 * c + x1 * s], axis=-1).astype(x.dtype)


def sgu_mixer(u, v, norm_g, w_s, b_s):
    bsz, s, _ = u.shape
    u = jax.nn.gelu(u)
    v = rmsnorm(jax.nn.gelu(v).reshape(bsz, s, SGU_HEADS, SGU_HEAD_DIM),
                norm_g.reshape(SGU_HEADS, SGU_HEAD_DIM))
    vc = v.reshape(bsz, s // SGU_CHUNK, SGU_CHUNK, SGU_HEADS, SGU_HEAD_DIM)
    mixed = jnp.einsum('hpq,bnqhc->bnphc', w_s.astype(vc.dtype), vc) \
        + b_s.T.astype(vc.dtype)[None, None, :, :, None]
    return u * mixed.reshape(bsz, s, A_WIDTH)


def hgrn2_bidir(q, i, g, f_fwd, f_bwd, lb, norm_g):
    bsz, s, _ = q.shape
    h, dh = HGRN_HEADS, HGRN_HEAD_DIM
    lbf = lb.astype(jnp.float32)[:, None, None, :]
    f = lbf + (1.0 - lbf) * jax.nn.sigmoid(jnp.stack([f_fwd, f_bwd]).astype(jnp.float32))
    logf = jnp.log(f)
    k = 1.0 - f
    qf = q.astype(jnp.float32)
    vf = i.astype(jnp.float32)
    qd = jnp.stack([qf, qf[:, ::-1]])
    vd = jnp.stack([vf, vf[:, ::-1]])
    kd = jnp.stack([k[0], k[1][:, ::-1]])
    gd = jnp.stack([logf[0], logf[1][:, ::-1]])
    n_chunks = s // HGRN_CHUNK

    def to_chunks(t):
        return jnp.moveaxis(t.reshape(2, bsz, n_chunks, HGRN_CHUNK, h, dh), 2, 0)

    tril = jnp.tril(jnp.ones((HGRN_CHUNK, HGRN_CHUNK), dtype=bool))[None, None, :, :, None, None]

    def step(state, inp):
        qc, kc, vc, gc = inp
        b = jnp.cumsum(gc, axis=2)
        o_inter = jnp.einsum('zbthk,zbhkv->zbthv', qc * jnp.exp(b), state)
        diff = b[:, :, :, None] - b[:, :, None, :]
        decay = jnp.exp(jnp.where(tril, diff, -jnp.inf))
        att = jnp.einsum('zbthk,zbtjhk,zbjhk->zbhtj', qc, decay, kc)
        o_intra = jnp.einsum('zbhtj,zbjhv->zbthv', att, vc)
        b_last = b[:, :, -1]
        k_dec = kc * jnp.exp(b_last[:, :, None] - b)
        state = jnp.exp(b_last)[..., None] * state + jnp.einsum('zbjhk,zbjhv->zbhkv', k_dec, vc)
        return state, o_inter + o_intra

    s0 = jnp.zeros((2, bsz, h, dh, dh), jnp.float32)
    _, o = lax.scan(step, s0, (to_chunks(qd), to_chunks(kd), to_chunks(vd), to_chunks(gd)))
    o = jnp.moveaxis(o, 0, 2).reshape(2, bsz, s, h, dh)
    o = o[0] + o[1][:, ::-1]
    o = rmsnorm(o, norm_g.reshape(h, dh)) * jax.nn.silu(g.astype(jnp.float32).reshape(bsz, s, h, dh))
    return o.reshape(bsz, s, B_WIDTH).astype(q.dtype)


def short_conv_mixer(h_in, b_gate, c_gate, conv_w):
    z = c_gate * h_in
    pad = CONV_WIDTH // 2
    y = lax.conv_general_dilated(z, conv_w[:, None, :].astype(z.dtype), window_strides=(1,),
                                 padding=[(pad, pad)], dimension_numbers=('NWC', 'WIO', 'NWC'),
                                 feature_group_count=C_WIDTH)
    return b_gate * y


def diff_attention(q, k, v, q_g, k_g, lq1, lk1, lq2, lk2, sub_g, lambda_init, cos, sin):
    bsz, s, _ = q.shape
    h, dq, dv = DIFF_HEADS, DIFF_QK_DIM, DIFF_V_DIM
    qh = apply_rope(rmsnorm(q.reshape(bsz, s, h, 2, dq), q_g), cos, sin)
    kh = apply_rope(rmsnorm(k.reshape(bsz, s, h, 2, dq), k_g), cos, sin)
    kf = kh.astype(jnp.float32)
    vf = v.reshape(bsz, s, h, dv).astype(jnp.float32)
    lam = (jnp.exp(jnp.sum(lq1.astype(jnp.float32) * lk1.astype(jnp.float32)))
           - jnp.exp(jnp.sum(lq2.astype(jnp.float32) * lk2.astype(jnp.float32))) + lambda_init)
    scale = dq ** -0.5
    qb = jnp.moveaxis(qh.reshape(bsz, s // ATTN_BLOCK, ATTN_BLOCK, h, 2, dq), 1, 0)

    def block(qblk):
        sc = jnp.einsum('bqhcd,bkhcd->bhcqk', qblk.astype(jnp.float32), kf) * scale
        p = jax.nn.softmax(sc, axis=-1)
        a = p[:, :, 0] - lam * p[:, :, 1]
        return jnp.einsum('bhqk,bkhv->bqhv', a, vf)

    o = lax.map(block, qb)
    o = jnp.moveaxis(o, 0, 1).reshape(bsz, s, h, dv)
    o = rmsnorm(o, sub_g) * (1.0 - lambda_init)
    return o.reshape(bsz, s, D_WIDTH).astype(q.dtype)


def setup_inputs(seed: int = 0) -> dict:
    key = jax.random.key(seed)
    ks = jax.random.split(key, 24)

    def nrm(k, shape, scale):
        return jax.random.normal(k, shape, jnp.float32) * scale

    def gain(k, shape):
        return 1.0 + 0.02 * jax.random.normal(k, shape, jnp.float32)

    return {
        "x": nrm(ks[0], (BATCH, SEQ, D_MODEL), 1.0),
        "norm_mix_g": gain(ks[1], (DEPTH, D_MODEL)),
        "norm_mlp_g": gain(ks[2], (DEPTH, D_MODEL)),
        "w_in_even": nrm(ks[3], (N_EVEN, D_MODEL, EVEN_IN), D_MODEL ** -0.5),
        "w_out_even": nrm(ks[4], (N_EVEN, A_WIDTH + B_WIDTH, D_MODEL), (A_WIDTH + B_WIDTH) ** -0.5),
        "sgu_norm_g": gain(ks[5], (N_EVEN, A_WIDTH)),
        "sgu_w": nrm(ks[6], (N_EVEN, SGU_HEADS, SGU_CHUNK, SGU_CHUNK), SGU_CHUNK ** -0.5),
        "sgu_b": 1.0 + 0.01 * jax.random.normal(ks[7], (N_EVEN, SGU_HEADS, SGU_CHUNK), jnp.float32),
        "hgrn_lb_logits": nrm(ks[8], (2, N_EVEN, B_WIDTH), 0.1),
        "hgrn_norm_g": gain(ks[9], (N_EVEN, B_WIDTH)),
        "w_in_odd": nrm(ks[10], (N_ODD, D_MODEL, ODD_IN), D_MODEL ** -0.5),
        "w_out_odd": nrm(ks[11], (N_ODD, C_WIDTH + D_WIDTH, D_MODEL), (C_WIDTH + D_WIDTH) ** -0.5),
        "conv_w": nrm(ks[12], (N_ODD, CONV_WIDTH, C_WIDTH), CONV_WIDTH ** -0.5),
        "q_norm_g": gain(ks[13], (N_ODD, DIFF_QK_DIM)),
        "k_norm_g": gain(ks[14], (N_ODD, DIFF_QK_DIM)),
        "lambda_q1": nrm(ks[15], (N_ODD, DIFF_QK_DIM), 0.1),
        "lambda_k1": nrm(ks[16], (N_ODD, DIFF_QK_DIM), 0.1),
        "lambda_q2": nrm(ks[17], (N_ODD, DIFF_QK_DIM), 0.1),
        "lambda_k2": nrm(ks[18], (N_ODD, DIFF_QK_DIM), 0.1),
        "diff_norm_g": gain(ks[19], (N_ODD, DIFF_V_DIM)),
        "mlp_w1": nrm(ks[20], (DEPTH, D_MODEL, D_FF), D_MODEL ** -0.5),
        "mlp_w2": nrm(ks[21], (DEPTH, D_FF, D_MODEL), D_FF ** -0.5),
    }


def reference(x, norm_mix_g, norm_mlp_g, w_in_even, w_out_even, sgu_norm_g, sgu_w, sgu_b,
              hgrn_lb_logits, hgrn_norm_g, w_in_odd, w_out_odd, conv_w, q_norm_g, k_norm_g,
              lambda_q1, lambda_k1, lambda_q2, lambda_k2, diff_norm_g, mlp_w1, mlp_w2):
    s = x.shape[1]
    cos, sin = rope_tables(s, DIFF_QK_DIM)
    p_lb = jax.nn.softmax(hgrn_lb_logits.astype(jnp.float32), axis=1)
    lower_bounds = jnp.cumsum(p_lb, axis=1) - p_lb[:, :1]
    for l in range(DEPTH):
        h = rmsnorm(x, norm_mix_g[l])
        if l % 2 == 0:
            e = l // 2
            u, v, q, i, g, f_fwd, f_bwd = split_cols(h @ w_in_even[e], EVEN_SIZES)
            out_a = sgu_mixer(u, v, sgu_norm_g[e], sgu_w[e], sgu_b[e])
            out_b = hgrn2_bidir(q, i, g, f_fwd, f_bwd, lower_bounds[:, e], hgrn_norm_g[e])
            mix = jnp.concatenate([out_a, out_b], axis=-1) @ w_out_even[e]
        else:
            o = l // 2
            h_in, b_gate, c_gate, q, k, v = split_cols(h @ w_in_odd[o], ODD_SIZES)
            out_c = short_conv_mixer(h_in, b_gate, c_gate, conv_w[o])
            lambda_init = 0.8 - 0.6 * math.exp(-0.3 * l)
            out_d = diff_attention(q, k, v, q_norm_g[o], k_norm_g[o], lambda_q1[o], lambda_k1[o],
                                   lambda_q2[o], lambda_k2[o], diff_norm_g[o], lambda_init, cos, sin)
            mix = jnp.concatenate([out_c, out_d], axis=-1) @ w_out_odd[o]
        x = x + mix
        hm = rmsnorm(x, norm_mlp_g[l]) @ mlp_w1[l]
        x = x + jnp.square(jax.nn.relu(hm)) @ mlp_w2[l]
    return x
```

```cpp
#include <hip/hip_runtime.h>
#include <cstdio>
#include <cstdint>
namespace pg8 {
#define PG8_LAS __attribute__((address_space(3)))
typedef unsigned short bf16_t;
typedef short bf16x8 __attribute__((ext_vector_type(8)));
typedef float f32x4 __attribute__((ext_vector_type(4)));
typedef unsigned u32x4 __attribute__((ext_vector_type(4)));
constexpr int BM = 256, BK = 64, HALF = 128, HTB = HALF * BK * 2  , STAGE_BYTES = 8 * HTB, NXCD = 8, WGM = 8;

__host__ __device__ __forceinline__ int lds_byte(int r, int c) { const int st = (r >> 4) * 2 + (c >> 5), rr = r & 15, cc = c & 31, ob = rr * 64 + cc * 2; return st * 1024 + (ob ^ (((ob >> 9) & 1) << 5)); }
__host__ __device__ __forceinline__ void stage_rc(int b, int& R, int& C) { const int st = b / 1024, sb = b % 1024, swz = sb ^ (((sb >> 9) & 1) << 5); R = (st >> 1) * 16 + swz / 64; C = (st & 1) * 32 + (swz % 64) / 2; }
__host__ __device__ __forceinline__ int perm32(int rho) { const int n = rho >> 4, i = rho & 15; return 8 * (i >> 2) + 4 * n + (i & 3); }

struct Unit { int pm, pn; };
struct Gemm { const bf16_t* A; const bf16_t* Bt; int M, N, K; };

struct StaticOrder {
    int nM, nN, nwg, G, c;
    __host__ __device__ void init(int M, int N, int G_, int c_) { nM = M / BM; nN = N / BM; nwg = nM * nN; G = G_; c = c_; }
    __host__ __device__ bool next(int i, Unit& u) const {
        const long L = (long)i * G + c; if (L >= nwg) return false;
        int wgid = (int)L; { const int q = nwg / NXCD, r = nwg % NXCD, xcd = wgid % NXCD, off = wgid / NXCD; wgid = (xcd < r ? xcd * (q + 1) : r * (q + 1) + (xcd - r) * q) + off; }
        const int nig = WGM * nN, gid = wgid / nig, fm = gid * WGM, gsz = (nM - fm) < WGM ? (nM - fm) : WGM;
        u.pm = fm + ((wgid % nig) % gsz); u.pn = (wgid % nig) / gsz; return true;
    }
    __device__ __forceinline__ void a_ready(const Unit&) const {}
    __device__ __forceinline__ void done(const Unit&) const {}
};

__device__ __forceinline__ unsigned cvt_pk_bf16(float lo, float hi) { unsigned r; asm volatile("v_cvt_pk_bf16_f32 %0, %1, %2" : "=v"(r) : "v"(lo), "v"(hi)); return r; }
typedef float f32x2 __attribute__((ext_vector_type(2)));
__device__ __forceinline__ f32x2 gelu_pk(f32x2 v) {
    const f32x2 av = __builtin_elementwise_abs(v), d = av * 0.2316418882f + 1.0f;
    f32x2 t; t.x = __builtin_amdgcn_rcpf(d.x); t.y = __builtin_amdgcn_rcpf(d.y);
    f32x2 q = t * 0.5307027145f + (-0.7265760135f); q = q * t + 0.7107068705f; q = q * t + (-0.142248368f); q = q * t + 0.127414796f; q = q * t;
    const f32x2 s = (v * v) * (-0.72134752044f);
    f32x2 e; e.x = __builtin_amdgcn_exp2f(s.x); e.y = __builtin_amdgcn_exp2f(s.y);
    const f32x2 m = v * (q * e), r = v - m;
    f32x2 o; o.x = v.x < 0.f ? m.x : r.x; o.y = v.y < 0.f ? m.y : r.y; return o;
}

template <int ACT  > struct EpiBf16 {
    static constexpr bool PERM = true, AFTER_DRAIN = false; static_assert(ACT == 0 || ACT == 1, "EpiBf16: ACT is 0 (none) or 1 (gelu_pk)");
    bf16_t* O; int ldc; const float* bias; int split_cols; size_t split_stride; float scale0;
    __device__ __forceinline__ void operator()(const f32x4 (&acc)[2][2][4][2], const Unit& u, int wr, int wc, int fr, int fq) const {
        const int row0 = u.pm * BM + wr * 64 + fr; int colt = u.pn * BM; bf16_t* base = O;
        float sc = 1.f; if (split_cols) { const int t = colt / split_cols; base += (size_t)t * split_stride; colt -= t * split_cols; if (t == 0) sc = scale0; }
        const int col0 = colt + wc * 32 + 8 * fq, bcol0 = u.pn * BM + wc * 32 + 8 * fq;
        f32x4 bv[2][2];
#pragma unroll
        for (int bj = 0; bj < 2; ++bj)
#pragma unroll
            for (int n = 0; n < 2; ++n) bv[bj][n] = bias ? *(const f32x4*)(bias + bcol0 + bj * HALF + 4 * n) : (f32x4){0.f, 0.f, 0.f, 0.f};
#pragma unroll
        for (int ai = 0; ai < 2; ++ai)
#pragma unroll
            for (int m = 0; m < 4; ++m) { bf16_t* rowp = base + (size_t)(row0 + ai * HALF + m * 16) * ldc + col0;
#pragma unroll
                for (int bj = 0; bj < 2; ++bj) { f32x4 v0 = acc[ai][bj][m][0] + bv[bj][0], v1 = acc[ai][bj][m][1] + bv[bj][1];
                    if (ACT == 1) { f32x2 a = gelu_pk((f32x2){v0[0], v0[1]}), b = gelu_pk((f32x2){v0[2], v0[3]}), c = gelu_pk((f32x2){v1[0], v1[1]}), d = gelu_pk((f32x2){v1[2], v1[3]});
                        v0 = (f32x4){a.x, a.y, b.x, b.y}; v1 = (f32x4){c.x, c.y, d.x, d.y}; }
                    v0 = v0 * sc; v1 = v1 * sc; u32x4 w; w.x = cvt_pk_bf16(v0[0], v0[1]); w.y = cvt_pk_bf16(v0[2], v0[3]); w.z = cvt_pk_bf16(v1[0], v1[1]); w.w = cvt_pk_bf16(v1[2], v1[3]);
                    *(u32x4*)(rowp + bj * HALF) = w; } }
    }
};

struct PanelStats {
    unsigned* xbuf;
    unsigned* cnt;
    unsigned* tmo;
    int ntn; float eps;
    unsigned code;
    __device__ __forceinline__ bool run(const f32x4 (&v)[2][2][4][2], const Unit& u, int wr, int wc, int fr, int fq, PG8_LAS unsigned char* lds, int wid, int lane) const {
        typedef float f32x2v __attribute__((ext_vector_type(2)));
        PG8_LAS f32x2v* P = (PG8_LAS f32x2v*)lds;
        PG8_LAS f32x2v* S = (PG8_LAS f32x2v*)(lds + 8192);
        PG8_LAS unsigned* flag = (PG8_LAS unsigned*)(lds + 8192 + 2048);
#pragma unroll
        for (int ai = 0; ai < 2; ++ai)
#pragma unroll
            for (int m = 0; m < 4; ++m) {
                float s = 0.f;
#pragma unroll
                for (int bj = 0; bj < 2; ++bj)
#pragma unroll
                    for (int n = 0; n < 2; ++n) { const f32x4 x = v[ai][bj][m][n]; s += (x[0] + x[1]) + (x[2] + x[3]); }
                s += __shfl_xor(s, 16); s += __shfl_xor(s, 32);
                const float mw = s * (1.0f / 64.0f); float q = 0.f;
#pragma unroll
                for (int bj = 0; bj < 2; ++bj)
#pragma unroll
                    for (int n = 0; n < 2; ++n) { const f32x4 d = v[ai][bj][m][n] - mw; q += (d[0] * d[0] + d[1] * d[1]) + (d[2] * d[2] + d[3] * d[3]); }
                q += __shfl_xor(q, 16); q += __shfl_xor(q, 32);
                if (fq == 0) P[(ai * HALF + wr * 64 + m * 16 + fr) * 4 + wc] = (f32x2v){mw, q};
            }
        asm volatile("s_waitcnt lgkmcnt(0)" ::: "memory"); __builtin_amdgcn_s_barrier(); asm volatile("" ::: "memory");
#if defined(BROKEN_EXCHANGE_NO_WAIT)
#warning BROKEN CONTROL BUILD: the row-statistics exchange does not wait; results are wrong by design
        if (blockIdx.x >= 64) { const long long t0_ = clock64(); while (clock64() - t0_ < 60000) __builtin_amdgcn_s_sleep(8); }
#endif
        const int row = wid * 32 + (lane & 31);
        if (lane < 32) {
            const f32x2v a = P[row * 4 + 0], b = P[row * 4 + 1], c = P[row * 4 + 2], d = P[row * 4 + 3];
            const float mt = (a.x + b.x + c.x + d.x) * 0.25f;
            const float da = a.x - mt, db = b.x - mt, dc = c.x - mt, dd = d.x - mt;
            const float m2 = (a.y + b.y) + (c.y + d.y) + 64.0f * ((da * da + db * db) + (dc * dc + dd * dd));
            unsigned long long* slot = (unsigned long long*)xbuf + ((size_t)(u.pm * BM + row) * 4 + u.pn);
            __hip_atomic_store(slot, ((unsigned long long)__float_as_uint(m2) << 32) | __float_as_uint(mt), __ATOMIC_RELAXED, __HIP_MEMORY_SCOPE_AGENT);
        }
        asm volatile("s_waitcnt vmcnt(0)" ::: "memory");
        if (lane == 0) __hip_atomic_fetch_add(cnt + 64 * u.pm, 1u, __ATOMIC_RELAXED, __HIP_MEMORY_SCOPE_AGENT);
        if (wid == 0) {
            bool dead = false; const unsigned long long t0 = __builtin_amdgcn_s_memrealtime(); const unsigned want = 8u * (unsigned)ntn;
            for (;;) {
#if defined(BROKEN_EXCHANGE_NO_WAIT)
                break;
#endif
                if ((unsigned)__builtin_amdgcn_readfirstlane(__hip_atomic_load(cnt + 64 * u.pm, __ATOMIC_RELAXED, __HIP_MEMORY_SCOPE_AGENT)) >= want) break;
                if (__builtin_amdgcn_s_memrealtime() - t0 > 2000000ull) {
                    if (lane == 0) { unsigned expect = 0u; __hip_atomic_compare_exchange_strong(tmo + 1, &expect, code | (unsigned)(u.pm & 0xff), __ATOMIC_RELAXED, __ATOMIC_RELAXED, __HIP_MEMORY_SCOPE_AGENT);
                                     __hip_atomic_store(tmo, 1u, __ATOMIC_RELAXED, __HIP_MEMORY_SCOPE_AGENT); }
                    dead = true; break; }
                __builtin_amdgcn_s_sleep(2);
            }
            __builtin_amdgcn_fence(__ATOMIC_ACQUIRE, "agent");
            if (lane == 0) flag[0] = dead ? 1u : 0u;
        }
        asm volatile("s_waitcnt vmcnt(0) lgkmcnt(0)" ::: "memory"); __builtin_amdgcn_s_barrier(); asm volatile("" ::: "memory");
        const bool bad = flag[0] != 0u;
        if (lane < 32) {
            const unsigned long long* slot = (const unsigned long long*)xbuf + (size_t)(u.pm * BM + row) * 4; float mt[4], m2[4]; float ms = 0.f;
#pragma unroll
            for (int t = 0; t < 4; ++t) { if (t < ntn) { const unsigned long long w = __hip_atomic_load(slot + t, __ATOMIC_RELAXED, __HIP_MEMORY_SCOPE_AGENT); mt[t] = __uint_as_float((unsigned)w); m2[t] = __uint_as_float((unsigned)(w >> 32)); } else { mt[t] = 0.f; m2[t] = 0.f; } ms += mt[t]; }
            const float mean = ms / (float)ntn; float q = 0.f;
#pragma unroll
            for (int t = 0; t < 4; ++t) if (t < ntn) { const float dm = mt[t] - mean; q += m2[t] + 256.0f * dm * dm; }
            S[row] = (f32x2v){mean, 1.0f / sqrtf(q / (256.0f * (float)ntn) + eps)};
        }
        asm volatile("s_waitcnt lgkmcnt(0)" ::: "memory"); __builtin_amdgcn_s_barrier(); asm volatile("" ::: "memory");
        return bad;
    }
};
struct EpiLnRes {
    static constexpr bool PERM = false, AFTER_DRAIN = true;
    const float* base; float* out; int ldc; const float* bias; PanelStats st; unsigned poison;
    __device__ __forceinline__ void fused(f32x4 (&acc)[2][2][4][2], const Unit& u, int wr, int wc, int fr, int fq, PG8_LAS unsigned char* lds, int wid, int lane) const {
        typedef float f32x2v __attribute__((ext_vector_type(2)));
        const PG8_LAS f32x2v* S = (const PG8_LAS f32x2v*)(lds + 8192);
        const int col0 = u.pn * BM + wc * 32 + 4 * fq;
#pragma unroll
        for (int bj = 0; bj < 2; ++bj)
#pragma unroll
            for (int n = 0; n < 2; ++n) { const f32x4 bv = bias ? *(const f32x4*)(bias + col0 + bj * HALF + n * 16) : (f32x4){0.f, 0.f, 0.f, 0.f};
#pragma unroll
                for (int ai = 0; ai < 2; ++ai)
#pragma unroll
                    for (int m = 0; m < 4; ++m) acc[ai][bj][m][n] += bv; }
        f32x4 pre[4][2][2];
#pragma unroll
        for (int m = 0; m < 4; ++m) { const size_t off = (size_t)(u.pm * BM + wr * 64 + m * 16 + fr) * ldc + col0;
#pragma unroll
            for (int bj = 0; bj < 2; ++bj)
#pragma unroll
                for (int n = 0; n < 2; ++n) pre[m][bj][n] = *(const f32x4*)(base + off + bj * HALF + n * 16); }
        const bool bad = st.run(acc, u, wr, wc, fr, fq, lds, wid, lane) || poison != 0u;
        const float qnan = __builtin_nanf("");
#pragma unroll
        for (int ai = 0; ai < 2; ++ai)
#pragma unroll
            for (int m = 0; m < 4; ++m) { const int r = ai * HALF + wr * 64 + m * 16 + fr; const f32x2v sr = S[r]; const size_t off = (size_t)(u.pm * BM + r) * ldc + col0;
#pragma unroll
                for (int bj = 0; bj < 2; ++bj)
#pragma unroll
                    for (int n = 0; n < 2; ++n) { const f32x4 bs = ai == 0 ? pre[m][bj][n] : *(const f32x4*)(base + off + bj * HALF + n * 16); f32x4 o = bs + (acc[ai][bj][m][n] - sr.x) * sr.y;
                        if (bad) o = (f32x4){qnan, qnan, qnan, qnan}; *(f32x4*)(out + off + bj * HALF + n * 16) = o; }
                if (m & 1) asm volatile("" ::: "memory"); }
    }
};
struct EpiLnResLn {
    static constexpr bool PERM = false, AFTER_DRAIN = true;
    const float* base; float* out; bf16_t* xn; int ldc; const float* bias; PanelStats st1, st2; unsigned poison;
    __device__ __forceinline__ void fused(f32x4 (&acc)[2][2][4][2], const Unit& u, int wr, int wc, int fr, int fq, PG8_LAS unsigned char* lds, int wid, int lane) const {
        typedef float f32x2v __attribute__((ext_vector_type(2))); typedef unsigned u32x2v __attribute__((ext_vector_type(2)));
        const PG8_LAS f32x2v* S = (const PG8_LAS f32x2v*)(lds + 8192);
        const int col0 = u.pn * BM + wc * 32 + 4 * fq;
#pragma unroll
        for (int bj = 0; bj < 2; ++bj)
#pragma unroll
            for (int n = 0; n < 2; ++n) { const f32x4 bv = bias ? *(const f32x4*)(bias + col0 + bj * HALF + n * 16) : (f32x4){0.f, 0.f, 0.f, 0.f};
#pragma unroll
                for (int ai = 0; ai < 2; ++ai)
#pragma unroll
                    for (int m = 0; m < 4; ++m) acc[ai][bj][m][n] += bv; }
        bool bad = st1.run(acc, u, wr, wc, fr, fq, lds, wid, lane) || poison != 0u;
        const float qnan = __builtin_nanf("");
#pragma unroll
        for (int ai = 0; ai < 2; ++ai)
#pragma unroll
            for (int m = 0; m < 4; ++m) { const int r = ai * HALF + wr * 64 + m * 16 + fr; const f32x2v sr = S[r]; const size_t off = (size_t)(u.pm * BM + r) * ldc + col0;
#pragma unroll
                for (int bj = 0; bj < 2; ++bj)
#pragma unroll
                    for (int n = 0; n < 2; ++n) { const f32x4 bs = *(const f32x4*)(base + off + bj * HALF + n * 16); acc[ai][bj][m][n] = bs + (acc[ai][bj][m][n] - sr.x) * sr.y; }
                asm volatile("" : "+v"(acc[ai][0][m][0]), "+v"(acc[ai][0][m][1]), "+v"(acc[ai][1][m][0]), "+v"(acc[ai][1][m][1]));
                if (m & 1) asm volatile("" ::: "memory"); }
        const bool bad1 = bad;
        bad = st2.run(acc, u, wr, wc, fr, fq, lds, wid, lane) || bad;
#pragma unroll
        for (int ai = 0; ai < 2; ++ai)
#pragma unroll
            for (int m = 0; m < 4; ++m) { const int r = ai * HALF + wr * 64 + m * 16 + fr; const f32x2v sr = S[r]; const size_t off = (size_t)(u.pm * BM + r) * ldc + col0;
#pragma unroll
                for (int bj = 0; bj < 2; ++bj)
#pragma unroll
                    for (int n = 0; n < 2; ++n) { const f32x4 x1 = acc[ai][bj][m][n]; *(f32x4*)(out + off + bj * HALF + n * 16) = bad1 ? (f32x4){qnan, qnan, qnan, qnan} : x1;
                        const f32x4 o = (x1 - sr.x) * sr.y; u32x2v w; w.x = cvt_pk_bf16(o[0], o[1]); w.y = cvt_pk_bf16(o[2], o[3]);
                        if (bad) { w.x = 0x7fc07fc0u; w.y = 0x7fc07fc0u; } *(u32x2v*)(xn + off + bj * HALF + n * 16) = w; }
                asm volatile("" ::: "memory"); }
    }
};

template <class Epi, class Sched, bool ALIGN_EPI = false, bool SP2 = false>
__device__ __forceinline__ void gemm_phase(PG8_LAS unsigned char* lds, const Gemm g, const Sched& S, const Epi& E) {
    const int tid = threadIdx.x, wid = __builtin_amdgcn_readfirstlane(tid >> 6), lane = tid & 63, wr = wid >> 2, wc = wid & 3, fr = lane & 15, fq = lane >> 4;
    const int K = g.K, nt = K / BK;
    unsigned voffA[2], voffB[2];
#pragma unroll
    for (int i = 0; i < 2; ++i) { int R, C; stage_rc(tid * 16 + i * 8192, R, C); const int Rb = Epi::PERM ? ((R & ~31) + perm32(R & 31)) : R;
        voffA[i] = (unsigned)(R * K + C) * 2u; voffB[i] = (unsigned)(Rb * K + C) * 2u; }
    const size_t kstep = (size_t)(BK * 2);
    const size_t hstep = (size_t)HALF * K * 2;
    const size_t tstep = 2 * hstep;
    const unsigned ldsw = (unsigned)wid * 1024u;
    const int aoff = lds_byte(wr * 64 + fr, fq * 8), boff = lds_byte(wc * 32 + fr, fq * 8);
#define PG8_SA(b, h) (((b) * 2 + (h)) * HTB)
#define PG8_SB(b, h) ((4 + (b) * 2 + (h)) * HTB)
#define PG8_STAGE(bufoff, gbase, voff) do { _Pragma("unroll") for (int _i = 0; _i < 2; ++_i) \
        __builtin_amdgcn_global_load_lds((const unsigned*)((const char*)(gbase) + (voff)[_i]), (PG8_LAS unsigned*)(lds + (bufoff) + ldsw + _i * 8192), 16, 0, 0); } while (0)
#define PG8_LDA(dst, b, h) do { _Pragma("unroll") for (int m = 0; m < 4; ++m) _Pragma("unroll") for (int k = 0; k < 2; ++k) dst[m][k] = *(const PG8_LAS bf16x8*)(lds + PG8_SA(b, h) + aoff + m * 2048 + k * 1024); } while (0)
#define PG8_LDB(dst, b, h) do { _Pragma("unroll") for (int n = 0; n < 2; ++n) _Pragma("unroll") for (int k = 0; k < 2; ++k) dst[n][k] = *(const PG8_LAS bf16x8*)(lds + PG8_SB(b, h) + boff + n * 2048 + k * 1024); } while (0)
#define PG8_MMA(ai, bj, At, Bt) do { __builtin_amdgcn_s_setprio(1); _Pragma("unroll") for (int m = 0; m < 4; ++m) _Pragma("unroll") for (int n = 0; n < 2; ++n) _Pragma("unroll") for (int k = 0; k < 2; ++k) \
        acc[ai][bj][m][n] = __builtin_amdgcn_mfma_f32_16x16x32_bf16(Bt[n][k], At[m][k], acc[ai][bj][m][n], 0, 0, 0); __builtin_amdgcn_s_setprio(0); } while (0)
#define PG8_WAIT_V(n) asm volatile("s_waitcnt vmcnt(" #n ")" ::: "memory")
#define PG8_WAIT_L(n) asm volatile("s_waitcnt lgkmcnt(" #n ")" ::: "memory")
#define PG8_BAR __builtin_amdgcn_s_barrier()
#define PG8_SCHED __builtin_amdgcn_sched_barrier(0)
    Unit cur, nxt; int ui = 0;
    if (!S.next(0, cur)) return;
    f32x4 acc[2][2][4][2];
#pragma unroll
    for (int a = 0; a < 2; ++a)
#pragma unroll
        for (int b = 0; b < 2; ++b)
#pragma unroll
            for (int m = 0; m < 4; ++m)
#pragma unroll
                for (int n = 0; n < 2; ++n) acc[a][b][m][n] = (f32x4){0.f, 0.f, 0.f, 0.f};
    bf16x8 At[4][2], B0[2][2], B1[2][2];
    const char* cA = (const char*)g.A + (size_t)cur.pm * tstep; const char* cB = (const char*)g.Bt + (size_t)cur.pn * tstep;
    S.a_ready(cur);
    if constexpr (SP2) {
        PG8_STAGE(PG8_SB(0, 0), cB, voffB); PG8_STAGE(PG8_SB(0, 1), cB + hstep, voffB); PG8_STAGE(PG8_SA(0, 0), cA, voffA); PG8_STAGE(PG8_SA(0, 1), cA + hstep, voffA);
        if (wr == 1) PG8_BAR;
        PG8_WAIT_V(2); PG8_BAR;
        PG8_STAGE(PG8_SB(1, 0), cB + kstep, voffB); PG8_STAGE(PG8_SA(1, 0), cA + kstep, voffA); PG8_STAGE(PG8_SB(1, 1), cB + hstep + kstep, voffB);
        PG8_WAIT_V(6); PG8_BAR;
    } else {
        PG8_STAGE(PG8_SB(0, 0), cB, voffB); PG8_STAGE(PG8_SA(0, 0), cA, voffA); PG8_STAGE(PG8_SB(0, 1), cB + hstep, voffB); PG8_STAGE(PG8_SA(0, 1), cA + hstep, voffA);
        if (wr == 1) PG8_BAR;
        PG8_WAIT_V(4); PG8_BAR;
        PG8_STAGE(PG8_SB(1, 0), cB + kstep, voffB); PG8_STAGE(PG8_SA(1, 0), cA + kstep, voffA); PG8_STAGE(PG8_SB(1, 1), cB + hstep + kstep, voffB);
        PG8_WAIT_V(6); PG8_BAR;
    }
    for (;;) {
        const bool has_next = S.next(ui + 1, nxt);
        const char* nA = has_next ? (const char*)g.A + (size_t)nxt.pm * tstep : cA; const char* nB = has_next ? (const char*)g.Bt + (size_t)nxt.pn * tstep : cB;
        for (int t = 0; t < nt; t += 2) {
            const bool last = (t == nt - 2);
            const char* a1 = cA + (size_t)(t + 1) * kstep;
            const char* a2 = last ? nA : cA + (size_t)(t + 2) * kstep; const char* b2 = last ? nB : cB + (size_t)(t + 2) * kstep;
            const char* a3 = a2 + kstep; const char* b3 = b2 + kstep;
            if (last && has_next) S.a_ready(nxt);
            if constexpr (SP2) {
            PG8_LDB(B0, 0, 0); PG8_LDB(B1, 0, 1); PG8_SCHED; PG8_LDA(At, 0, 0); PG8_STAGE(PG8_SA(1, 1), a1 + hstep, voffA);
            PG8_WAIT_V(8); PG8_WAIT_L(0); PG8_BAR; PG8_MMA(0, 0, At, B0); PG8_MMA(0, 1, At, B1); PG8_BAR; PG8_SCHED;
            PG8_LDA(At, 0, 1); PG8_STAGE(PG8_SB(0, 0), b2, voffB); PG8_STAGE(PG8_SB(0, 1), b2 + hstep, voffB); PG8_STAGE(PG8_SA(0, 0), a2, voffA);
            PG8_WAIT_V(8); PG8_WAIT_L(0); PG8_BAR; PG8_MMA(1, 0, At, B0); PG8_MMA(1, 1, At, B1); PG8_BAR; PG8_SCHED;
            PG8_LDB(B0, 1, 0); PG8_LDB(B1, 1, 1); PG8_SCHED; PG8_LDA(At, 1, 0); PG8_STAGE(PG8_SA(0, 1), a2 + hstep, voffA);
            PG8_WAIT_V(8); PG8_WAIT_L(0); PG8_BAR; PG8_MMA(0, 0, At, B0); PG8_MMA(0, 1, At, B1); PG8_BAR; PG8_SCHED;
            PG8_LDA(At, 1, 1); PG8_STAGE(PG8_SB(1, 0), b3, voffB); PG8_STAGE(PG8_SB(1, 1), b3 + hstep, voffB); PG8_STAGE(PG8_SA(1, 0), a3, voffA);
            PG8_WAIT_V(8); PG8_WAIT_L(0); PG8_BAR; PG8_MMA(1, 0, At, B0); PG8_MMA(1, 1, At, B1); PG8_BAR; PG8_SCHED;
            } else {
            PG8_LDB(B0, 0, 0); PG8_SCHED; PG8_LDA(At, 0, 0); PG8_STAGE(PG8_SA(1, 1), a1 + hstep, voffA);
            PG8_WAIT_L(8); PG8_BAR; PG8_WAIT_L(0); PG8_MMA(0, 0, At, B0); PG8_BAR; PG8_SCHED;
            PG8_LDB(B1, 0, 1); PG8_STAGE(PG8_SB(0, 0), b2, voffB);
            PG8_BAR; PG8_WAIT_L(0); PG8_MMA(0, 1, At, B1); PG8_BAR;
            PG8_LDA(At, 0, 1); PG8_STAGE(PG8_SA(0, 0), a2, voffA);
            PG8_BAR; PG8_WAIT_L(0); PG8_MMA(1, 0, At, B0); PG8_BAR; PG8_SCHED;
            PG8_STAGE(PG8_SB(0, 1), b2 + hstep, voffB);
            PG8_WAIT_V(6); PG8_BAR; PG8_MMA(1, 1, At, B1); PG8_BAR;
            PG8_LDB(B0, 1, 0); PG8_SCHED; PG8_LDA(At, 1, 0); PG8_STAGE(PG8_SA(0, 1), a2 + hstep, voffA);
            PG8_WAIT_L(8); PG8_BAR; PG8_WAIT_L(0); PG8_MMA(0, 0, At, B0); PG8_BAR; PG8_SCHED;
            PG8_LDB(B1, 1, 1); PG8_STAGE(PG8_SB(1, 0), b3, voffB);
            PG8_BAR; PG8_WAIT_L(0); PG8_MMA(0, 1, At, B1); PG8_BAR;
            PG8_LDA(At, 1, 1); PG8_STAGE(PG8_SA(1, 0), a3, voffA);
            PG8_BAR; PG8_WAIT_L(0); PG8_MMA(1, 0, At, B0); PG8_BAR; PG8_SCHED;
            PG8_STAGE(PG8_SB(1, 1), b3 + hstep, voffB);
            PG8_WAIT_V(6); PG8_BAR; PG8_MMA(1, 1, At, B1); PG8_BAR;
            }
        }
        if constexpr (ALIGN_EPI) { if (wr == 0) PG8_BAR; }
        if constexpr (!Epi::AFTER_DRAIN) { E(acc, cur, wr, wc, fr, fq); S.done(cur); }
        if (!has_next) break;
#pragma unroll
        for (int a = 0; a < 2; ++a)
#pragma unroll
            for (int b = 0; b < 2; ++b)
#pragma unroll
                for (int m = 0; m < 4; ++m)
#pragma unroll
                    for (int n = 0; n < 2; ++n) acc[a][b][m][n] = (f32x4){0.f, 0.f, 0.f, 0.f};
        cur = nxt; cA = nA; cB = nB; ++ui;
        if constexpr (ALIGN_EPI) { if (wr == 1) PG8_BAR; }
    }
    PG8_WAIT_V(0);
    if constexpr (!ALIGN_EPI) { if (wr == 0) PG8_BAR; }
    PG8_BAR;
    if constexpr (Epi::AFTER_DRAIN) { E.fused(acc, cur, wr, wc, fr, fq, lds, wid, lane); S.done(cur); }
#undef PG8_SA
#undef PG8_SB
#undef PG8_STAGE
#undef PG8_LDA
#undef PG8_LDB
#undef PG8_MMA
#undef PG8_WAIT_V
#undef PG8_WAIT_L
#undef PG8_BAR
#undef PG8_SCHED
}
}
namespace pg8 {
template <int ACT  > struct EpiBf16S {
    static constexpr bool PERM = true, AFTER_DRAIN = false;
    bf16_t* O; int ldc;
    __device__ __forceinline__ void operator()(const f32x4 (&acc)[2][2][4][2], const Unit& u, int wr, int wc, int fr, int fq) const {
        const int row0 = u.pm * BM + wr * 64 + fr, col0 = u.pn * BM + wc * 32 + 8 * fq;
#pragma unroll
        for (int ai = 0; ai < 2; ++ai)
#pragma unroll
            for (int m = 0; m < 4; ++m) { bf16_t* rowp = O + (size_t)(row0 + ai * HALF + m * 16) * ldc + col0;
#pragma unroll
                for (int bj = 0; bj < 2; ++bj) { f32x4 v0 = acc[ai][bj][m][0], v1 = acc[ai][bj][m][1];
                    if (ACT == 2) {
#pragma unroll
                        for (int i = 0; i < 4; ++i) { const float a = v0[i] > 0.f ? v0[i] : 0.f, b = v1[i] > 0.f ? v1[i] : 0.f; v0[i] = a * a; v1[i] = b * b; } }
                    u32x4 w; w.x = cvt_pk_bf16(v0[0], v0[1]); w.y = cvt_pk_bf16(v0[2], v0[3]); w.z = cvt_pk_bf16(v1[0], v1[1]); w.w = cvt_pk_bf16(v1[2], v1[3]);
                    *(u32x4*)(rowp + bj * HALF) = w; } }
    }
};
struct EpiResF32 {
    static constexpr bool PERM = false, AFTER_DRAIN = false;
    const float* base; float* out; int ldc;
    __device__ __forceinline__ void operator()(const f32x4 (&acc)[2][2][4][2], const Unit& u, int wr, int wc, int fr, int fq) const {
        const int row0 = u.pm * BM + wr * 64 + fr, col0 = u.pn * BM + wc * 32 + 4 * fq;
#pragma unroll
        for (int ai = 0; ai < 2; ++ai)
#pragma unroll
            for (int m = 0; m < 4; ++m) { const size_t off = (size_t)(row0 + ai * HALF + m * 16) * ldc + col0;
#pragma unroll
                for (int bj = 0; bj < 2; ++bj)
#pragma unroll
                    for (int n = 0; n < 2; ++n) { const f32x4 bs = *(const f32x4*)(base + off + bj * HALF + n * 16); *(f32x4*)(out + off + bj * HALF + n * 16) = bs + acc[ai][bj][m][n]; } }
    }
};
}
#ifndef PG8_SP2
#define PG8_SP2 true
#endif
constexpr int NWAVES = 8;
constexpr int BATCH = 4, SEQ = 4096, DM = 1024, DEPTH = 4, FF = 4096, EVEN_IN = 3584, ODD_IN = 3072;
constexpr int M = BATCH * SEQ;
constexpr float EPS = 1e-6f;
constexpr float LOG2E = 1.4426950408889634f;
#ifndef MK_ONE_LAUNCH
#define MK_ONE_LAUNCH 0
#endif
enum { I_X = 0, I_NMIX, I_NMLP, I_WINE, I_WOUTE, I_SGUG, I_SGUW, I_SGUB, I_LBL, I_HNG, I_WINO, I_WOUTO, I_CONVW, I_QG, I_KG, I_LQ1, I_LK1, I_LQ2, I_LK2, I_DNG, I_W1, I_W2, N_IN };

constexpr size_t MiB = 1u << 20;
constexpr size_t WS_CTL = 0, CTL_ZERO_BYTES = 1 * MiB;
constexpr size_t WS_WIN = 1 * MiB, WS_WOUT = 8 * MiB, WS_W1 = 10 * MiB, WS_W2 = 18 * MiB;
constexpr size_t WS_XN = 26 * MiB;
constexpr size_t WS_Y = 58 * MiB;
constexpr size_t WS_MIX = 186 * MiB;
constexpr size_t WS_END = 218 * MiB;
constexpr int CW_TMO = 0, CW_CODE = 1, CW_BAR = 4096;

constexpr int RING_OFF = 0, RING_BYTES = 131072;
constexpr int LDSCTL_OFF = RING_BYTES, MISC_OFF = LDSCTL_OFF + 320;
constexpr int LDS_BYTES = 147456;
#define GAS __attribute__((address_space(1)))
#define LAS __attribute__((address_space(3)))
typedef unsigned short bf16;
typedef unsigned v4u __attribute__((ext_vector_type(4)));
typedef float f32x4 __attribute__((ext_vector_type(4)));
typedef short bf16x8 __attribute__((ext_vector_type(8)));
typedef GAS unsigned gu32;
typedef GAS unsigned long long gu64;
#define RLX_AGENT __ATOMIC_RELAXED, __HIP_MEMORY_SCOPE_AGENT
#define LDS_WAIT() asm volatile("s_waitcnt lgkmcnt(0)" ::: "memory")
#define VM_WAIT() asm volatile("s_waitcnt vmcnt(0)" ::: "memory")
__device__ __forceinline__ unsigned long long rt() { return __builtin_amdgcn_s_memrealtime(); }
__device__ __forceinline__ unsigned f2bf(float f) { unsigned u = __builtin_bit_cast(unsigned, f); return (u + 0x7fffu + ((u >> 16) & 1u)) >> 16; }
__device__ __forceinline__ unsigned pk2(float lo, float hi) { return f2bf(lo) | (f2bf(hi) << 16); }

#define XB_TMO      128
#define XB_XCNT(j)  (256  + 64 * (j))
#define XB_XSUB(j)  (1280 + 64 * (j))
#define XB_XGEN(j)  (2304 + 64 * (j))
#define XB_TOP      3328
#define XB_TOPGEN   3392
#define XCD_BAR_WORDS 3456
#define XB_SPIN_CAP (1u << 18)

__device__ __forceinline__ unsigned xb_ld(unsigned* p)              { return __hip_atomic_load(p, __ATOMIC_RELAXED, __HIP_MEMORY_SCOPE_AGENT); }
__device__ __forceinline__ unsigned xb_add(unsigned* p, unsigned v) { return __hip_atomic_fetch_add(p, v, __ATOMIC_RELAXED, __HIP_MEMORY_SCOPE_AGENT); }
__device__ __forceinline__ unsigned xb_xcc_id() { return (unsigned)__builtin_amdgcn_s_getreg((3 << 11) | 20) & 0xFu; }
#define XB_SPIN(cond, bar) do { unsigned _sp = 0; while (cond) { __builtin_amdgcn_s_sleep(1); \
    if ((++_sp & 255u) == 0u) { if (xb_ld(&(bar)[XB_TMO])) break; if (_sp > XB_SPIN_CAP) { atomicAdd(&(bar)[XB_TMO], 1u); break; } } } } while (0)

struct XcdBarrier {
    unsigned* bar; unsigned x;
    volatile LAS unsigned* st;
};

__device__ __forceinline__ XcdBarrier xcd_barrier_post(unsigned* bar, volatile LAS unsigned* st) {
    XcdBarrier b; b.bar = bar; b.x = xb_xcc_id(); b.st = st;
    if (threadIdx.x == 0) (void)xb_add(&bar[XB_XCNT(b.x)], 1u);
    return b;
}
__device__ __forceinline__ void xcd_barrier_complete(unsigned* bar, unsigned x, unsigned& nloc, unsigned& nx) {
    const unsigned G = gridDim.x * gridDim.y * gridDim.z;
    unsigned sum, cnt, mine, sp = 0u;
    for (;;) {
        sum = 0u; cnt = 0u; mine = 0u;
#pragma unroll
        for (unsigned j = 0; j < 16; ++j) { const unsigned c = xb_ld(&bar[XB_XCNT(j)]); sum += c; cnt += (c > 0u) ? 1u : 0u; mine = (j == x) ? c : mine; }
        if (sum == G) break;
        __builtin_amdgcn_s_sleep(1);
        if ((++sp & 255u) == 0u) { if (xb_ld(&bar[XB_TMO])) break; if (sp > XB_SPIN_CAP) { atomicAdd(&bar[XB_TMO], 1u); break; } }
    }
    nloc = mine > 0u ? mine : 1u; nx = cnt > 0u ? cnt : 1u;
}

__device__ __forceinline__ void xcd_barrier(const XcdBarrier& b) {
    asm volatile("s_waitcnt vmcnt(0)" ::: "memory");
    __syncthreads();
    if (threadIdx.x == 0) {
        unsigned* bar = b.bar;
        __builtin_amdgcn_s_waitcnt(0);
        unsigned nloc = b.st[0], nx = b.st[1];
        if (nloc == 0u) { xcd_barrier_complete(bar, b.x, nloc, nx); b.st[0] = nloc; b.st[1] = nx; }
        const unsigned old = xb_add(&bar[XB_XSUB(b.x)], 1u);
        const unsigned gen = old / nloc;
        if (old + 1u == (gen + 1u) * nloc) {
            __builtin_amdgcn_fence(__ATOMIC_RELEASE, "agent");
            asm volatile("s_waitcnt vmcnt(0)" ::: "memory");
            const unsigned og = xb_add(&bar[XB_TOP], 1u);
            const unsigned tg = og / nx;
            if (og + 1u == (tg + 1u) * nx) xb_add(&bar[XB_TOPGEN], 1u);
            else XB_SPIN(xb_ld(&bar[XB_TOPGEN]) == tg, bar);
            __builtin_amdgcn_fence(__ATOMIC_ACQUIRE, "agent");
            xb_add(&bar[XB_XGEN(b.x)], 1u);
            asm volatile("s_waitcnt vmcnt(0)" ::: "memory");
        } else {
            XB_SPIN(xb_ld(&bar[XB_XGEN(b.x)]) == gen, bar);
            __builtin_amdgcn_fence(__ATOMIC_ACQUIRE, "agent");
            asm volatile("s_waitcnt vmcnt(0)" ::: "memory");
        }
    }
    __syncthreads();
}
struct Frame {
    LAS unsigned char* lds;
    int tid, lane, wave;
    int vcu, G, bx;
    const float* const* in;
    float* out; unsigned char* ws;
};
#define F_WIN ((bf16*)(F.ws + WS_WIN))
#define F_WOUT ((bf16*)(F.ws + WS_WOUT))
#define F_W1 ((bf16*)(F.ws + WS_W1))
#define F_W2 ((bf16*)(F.ws + WS_W2))
#define F_XN ((bf16*)(F.ws + WS_XN))
#define F_Y ((bf16*)(F.ws + WS_Y))
#define F_MIX ((bf16*)(F.ws + WS_MIX))
static __device__ const double ROPE_TURNS[32] = {0.15915494309189535, 0.11934937021124886, 0.08949940160889101, 0.06711508300522726, 0.050329212104487035, 0.03774158471741977, 0.0283021958306234, 0.02122365276477766, 0.015915494309189534, 0.011934937021124886, 0.008949940160889102, 0.006711508300522725, 0.005032921210448704, 0.003774158471741977, 0.00283021958306234, 0.0021223652764777662, 0.0015915494309189536, 0.0011934937021124885, 0.0008949940160889102, 0.0006711508300522726, 0.0005032921210448703, 0.00037741584717419774, 0.00028302195830623395, 0.0002122365276477766, 0.00015915494309189535, 0.00011934937021124886, 8.949940160889102e-05, 6.711508300522725e-05, 5.0329212104487035e-05, 3.774158471741978e-05, 2.8302195830623396e-05, 2.122365276477766e-05};
typedef unsigned long long u64;
__device__ __forceinline__ float bf2f(unsigned h) { return __uint_as_float(h << 16); }
__device__ __forceinline__ float wave_sum(float v) {
#pragma unroll
    for (int o = 1; o < 64; o <<= 1) v += __shfl_xor(v, o);
    return v;
}
__device__ __forceinline__ float sigmoidf_(float a) { return 1.f / (1.f + __expf(-a)); }
__device__ __forceinline__ float gelu_tanh(float x) { const float y = 0.7978845608028654f * (x + 0.044715f * x * x * x); return x / (1.f + __expf(-2.f * y)); }
__device__ __forceinline__ void unpack8(const v4u w, float (&f)[8]) {
    f[0] = bf2f(w.x & 0xffffu); f[1] = bf2f(w.x >> 16); f[2] = bf2f(w.y & 0xffffu); f[3] = bf2f(w.y >> 16);
    f[4] = bf2f(w.z & 0xffffu); f[5] = bf2f(w.z >> 16); f[6] = bf2f(w.w & 0xffffu); f[7] = bf2f(w.w >> 16);
}
__device__ __forceinline__ v4u pack8(const float (&f)[8]) { v4u w; w.x = pk2(f[0], f[1]); w.y = pk2(f[2], f[3]); w.z = pk2(f[4], f[5]); w.w = pk2(f[6], f[7]); return w; }

__device__ __forceinline__ void transpose_item(const float* W, int K, int N, bf16* WT, const float* gain, LAS float* scr, int item, int lane) {
    const int nblk = N / 32, kb = item / nblk, nb = item % nblk, k0 = 64 * kb, n0 = 32 * nb;
#pragma unroll 8
    for (int i = 0; i < 32; ++i) { const int kk = 2 * i + (lane >> 5); float val = W[(size_t)(k0 + kk) * N + n0 + (lane & 31)]; if (gain) val *= gain[k0 + kk]; scr[kk * 33 + (lane & 31)] = val; }
    LDS_WAIT(); asm volatile("" ::: "memory");
    const int c = lane & 7;
#pragma unroll
    for (int j = 0; j < 4; ++j) { const int n = (lane >> 3) + 8 * j; const LAS float* s = scr + (8 * c) * 33 + n;
        v4u o; o.x = pk2(s[0 * 33], s[1 * 33]); o.y = pk2(s[2 * 33], s[3 * 33]); o.z = pk2(s[4 * 33], s[5 * 33]); o.w = pk2(s[6 * 33], s[7 * 33]);
        *(GAS v4u*)(WT + (size_t)(n0 + n) * K + k0 + 8 * c) = o; }
    LDS_WAIT(); asm volatile("" ::: "memory");
}
__device__ __forceinline__ void prep_weights(Frame& F, int l) {
    LAS float* scr = (LAS float*)(F.lds + RING_OFF + F.wave * 16384);
    const int gw = F.vcu * NWAVES + F.wave, NGW = F.G * NWAVES;
    const bool even = (l & 1) == 0; const int li = l >> 1, Nin = even ? EVEN_IN : ODD_IN;
    const float* Win = even ? F.in[I_WINE] + (size_t)li * DM * EVEN_IN : F.in[I_WINO] + (size_t)li * DM * ODD_IN;
    const float* Wout = (even ? F.in[I_WOUTE] : F.in[I_WOUTO]) + (size_t)li * DM * DM;
    const float* W1 = F.in[I_W1] + (size_t)l * DM * FF; const float* W2 = F.in[I_W2] + (size_t)l * FF * DM;
    const float* gmix = F.in[I_NMIX] + l * DM; const float* gmlp = F.in[I_NMLP] + l * DM;
    const int I_IN = (DM / 64) * (Nin / 32), I_OUT = (DM / 64) * (DM / 32), I_1 = (DM / 64) * (FF / 32), I_2 = (FF / 64) * (DM / 32);
    const int NITEMS = I_IN + I_OUT + I_1 + I_2;
    for (int it = gw; it < NITEMS; it += NGW) {
        int r = it;
        if (r < I_IN) { transpose_item(Win, DM, Nin, F_WIN, gmix, scr, r, F.lane); continue; } r -= I_IN;
        if (r < I_OUT) { transpose_item(Wout, DM, DM, F_WOUT, nullptr, scr, r, F.lane); continue; } r -= I_OUT;
        if (r < I_1) { transpose_item(W1, DM, FF, F_W1, gmlp, scr, r, F.lane); continue; } r -= I_1;
        transpose_item(W2, FF, DM, F_W2, nullptr, scr, r, F.lane);
    }
}
__device__ __forceinline__ void norm_rows(Frame& F, const float* src) {
    const int gw = F.vcu * NWAVES + F.wave, NGW = F.G * NWAVES;
    for (int m = gw; m < M; m += NGW) {
        const GAS f32x4* xr = (const GAS f32x4*)(src + (size_t)m * DM) + F.lane;
        f32x4 v[4]; float s = 0.f;
#pragma unroll
        for (int j = 0; j < 4; ++j) { v[j] = xr[64 * j]; s += (v[j].x * v[j].x + v[j].y * v[j].y) + (v[j].z * v[j].z + v[j].w * v[j].w); }
        const float r = 1.f / sqrtf(wave_sum(s) * (1.f / DM) + EPS);
        GAS u64* o8 = (GAS u64*)(F_XN + (size_t)m * DM) + F.lane;
#pragma unroll
        for (int j = 0; j < 4; ++j) o8[64 * j] = (u64)pk2(v[j].x * r, v[j].y * r) | ((u64)pk2(v[j].z * r, v[j].w * r) << 32);
    }
}

__device__ __forceinline__ void sgu_naive_unit(Frame& F, int e, int unit) {
    const int h = unit & 3, n = (unit >> 2) & 31, b = unit >> 7; const int row0 = b * SEQ + n * 128;
    LAS float* vn = (LAS float*)F.lds;
    const bf16* Y = F_Y; const int tid = F.tid;
    { const int q = tid >> 2, part = tid & 3; const bf16* vp = Y + (size_t)(row0 + q) * EVEN_IN + 512 + h * 128 + part * 32;
      float g[32]; float ss = 0.f;
#pragma unroll
      for (int i = 0; i < 4; ++i) { float f8[8]; unpack8(*(const GAS v4u*)(vp + 8 * i), f8);
#pragma unroll
          for (int j = 0; j < 8; ++j) { const float x = gelu_tanh(f8[j]); g[8 * i + j] = x; ss += x * x; } }
      ss += __shfl_xor(ss, 1); ss += __shfl_xor(ss, 2);
      const float r = 1.f / sqrtf(ss * (1.f / 128.f) + EPS); const float* ng = F.in[I_SGUG] + e * 512 + h * 128 + part * 32;
#pragma unroll
      for (int i = 0; i < 32; ++i) vn[q * 129 + part * 32 + i] = g[i] * r * ng[i];
    }
    __syncthreads();
    { const int c = tid & 127, pq = __builtin_amdgcn_readfirstlane(tid >> 7); const float* Ws = F.in[I_SGUW] + (size_t)((e * 4 + h) * 128) * 128; const float* bs = F.in[I_SGUB] + (e * 4 + h) * 128;
      for (int pp = 0; pp < 32; ++pp) { const int p = pq * 32 + pp; const float* wr = Ws + p * 128; float acc = 0.f;
#pragma unroll 8
          for (int q = 0; q < 128; ++q) acc += wr[q] * vn[q * 129 + c];
          const float u = bf2f(Y[(size_t)(row0 + p) * EVEN_IN + h * 128 + c]);
          F_MIX[(size_t)(row0 + p) * DM + h * 128 + c] = (bf16)f2bf(gelu_tanh(u) * (acc + bs[p])); }
    }
    __syncthreads();
}
__device__ __forceinline__ void hgrn_naive(Frame& F, int e, int bh) {
    const int b = bh >> 2, h = bh & 3, tid = F.tid, kq = __builtin_amdgcn_readfirstlane(tid >> 7), v = tid & 127;
    LAS float* red = (LAS float*)F.lds;
    const bf16* Y = F_Y; float* OF = (float*)(F.ws + WS_XN);
    const float* lbl = F.in[I_LBL]; const float* ng = F.in[I_HNG] + e * 512;
    for (int z = 0; z < 2; ++z) {
        float lbv[32], S[32];
#pragma unroll
        for (int k = 0; k < 32; ++k) { const int ch = h * 128 + kq * 32 + k; S[k] = 0.f;
            if (e == 0) lbv[k] = 0.f; else { const float L0 = lbl[(z * 2 + 0) * 512 + ch], L1 = lbl[(z * 2 + 1) * 512 + ch]; lbv[k] = 1.f / (1.f + expf(L0 - L1)); } }
        for (int step = 0; step < SEQ; ++step) {
            const int pos = z ? SEQ - 1 - step : step; const size_t row = (size_t)b * SEQ + pos; const bf16* yr = Y + row * EVEN_IN;
            const float vi = bf2f(yr[1536 + h * 128 + v]); float part = 0.f;
#pragma unroll
            for (int i = 0; i < 4; ++i) { float a8[8], q8[8]; unpack8(*(const GAS v4u*)(yr + 2560 + z * 512 + h * 128 + kq * 32 + 8 * i), a8); unpack8(*(const GAS v4u*)(yr + 1024 + h * 128 + kq * 32 + 8 * i), q8);
#pragma unroll
                for (int j = 0; j < 8; ++j) { const int k = 8 * i + j; const float sg = sigmoidf_(a8[j]); const float f = lbv[k] + (1.f - lbv[k]) * sg, kk = (1.f - lbv[k]) * (1.f - sg);
                    S[k] = f * S[k] + kk * vi; part += q8[j] * S[k]; } }
            red[kq * 128 + v] = part; __syncthreads();
            float o = 0.f;
            if (kq == 0) { o = (red[v] + red[128 + v]) + (red[256 + v] + red[384 + v]);
                if (z == 0) OF[row * 512 + h * 128 + v] = o;
                else { o += OF[row * 512 + h * 128 + v]; const float ss = wave_sum(o * o); if (F.lane == 0) red[512 + F.wave] = ss; } }
            __syncthreads();
            if (z == 1 && kq == 0) { const float tot = red[512] + red[513]; const float r = 1.f / sqrtf(tot * (1.f / 128.f) + EPS); const float gv = bf2f(yr[2048 + h * 128 + v]);
                F_MIX[row * DM + 512 + h * 128 + v] = (bf16)f2bf(o * r * ng[h * 128 + v] * gv * sigmoidf_(gv)); }
            __syncthreads();
        }
    }
}
__device__ __forceinline__ void conv_phase(Frame& F, int o) {
    const int gt = F.vcu * (NWAVES * 64) + F.tid, NT = F.G * NWAVES * 64; const float* cw = F.in[I_CONVW] + o * 3 * 512;
    for (int idx = gt; idx < M * 64; idx += NT) { const int t = idx >> 6, c = (idx & 63) * 8, pos = t & (SEQ - 1); const bf16* yr = F_Y + (size_t)t * ODD_IN;
        float z0[8], z1[8], z2[8], hh[8], cg[8], bg[8];
        unpack8(*(const GAS v4u*)(yr + c), hh); unpack8(*(const GAS v4u*)(yr + 1024 + c), cg);
#pragma unroll
        for (int j = 0; j < 8; ++j) z1[j] = hh[j] * cg[j];
        if (pos > 0) { unpack8(*(const GAS v4u*)(yr - ODD_IN + c), hh); unpack8(*(const GAS v4u*)(yr - ODD_IN + 1024 + c), cg);
#pragma unroll
            for (int j = 0; j < 8; ++j) z0[j] = hh[j] * cg[j]; } else {
#pragma unroll
            for (int j = 0; j < 8; ++j) z0[j] = 0.f; }
        if (pos < SEQ - 1) { unpack8(*(const GAS v4u*)(yr + ODD_IN + c), hh); unpack8(*(const GAS v4u*)(yr + ODD_IN + 1024 + c), cg);
#pragma unroll
            for (int j = 0; j < 8; ++j) z2[j] = hh[j] * cg[j]; } else {
#pragma unroll
            for (int j = 0; j < 8; ++j) z2[j] = 0.f; }
        unpack8(*(const GAS v4u*)(yr + 512 + c), bg); float r8[8];
#pragma unroll
        for (int j = 0; j < 8; ++j) r8[j] = bg[j] * (cw[c + j] * z0[j] + cw[512 + c + j] * z1[j] + cw[1024 + c + j] * z2[j]);
        *(GAS v4u*)(F_MIX + (size_t)t * DM + c) = pack8(r8); }
}
__device__ __forceinline__ void qk_prep_phase(Frame& F, int o) {
    const int gw = F.vcu * NWAVES + F.wave, NGW = F.G * NWAVES, lane = F.lane;
    bf16* QR = (bf16*)(F.ws + WS_XN); bf16* KR = QR + (size_t)M * 512;
    const int d0 = (lane & 7) * 8; const bool hi = d0 >= 32;
    double inv[8];
#pragma unroll
    for (int j = 0; j < 8; ++j) inv[j] = ROPE_TURNS[(d0 + j) & 31];
    for (int it = gw; it < 2 * M; it += NGW) { const int t = it >> 1, which = it & 1, pos = t & (SEQ - 1);
        const bf16* src = F_Y + (size_t)t * ODD_IN + 1536 + which * 512 + lane * 8; const float* g = F.in[which ? I_KG : I_QG] + o * 64 + d0;
        float x[8]; unpack8(*(const GAS v4u*)src, x); float ss = 0.f;
#pragma unroll
        for (int j = 0; j < 8; ++j) ss += x[j] * x[j];
        ss += __shfl_xor(ss, 1); ss += __shfl_xor(ss, 2); ss += __shfl_xor(ss, 4);
        const float r = 1.f / sqrtf(ss * (1.f / 64.f) + EPS); const float sc = which ? 1.f : 0.125f * LOG2E; float y[8];
#pragma unroll
        for (int j = 0; j < 8; ++j) { x[j] = x[j] * r * g[j]; const float p = __shfl_xor(x[j], 4); double tt = (double)pos * inv[j]; tt -= floor(tt); const float tf = (float)tt; const float cs = __builtin_amdgcn_cosf(tf), sn = __builtin_amdgcn_sinf(tf);
            y[j] = (hi ? (x[j] * cs + p * sn) : (x[j] * cs - p * sn)) * sc; }
        *(GAS v4u*)((which ? KR : QR) + (size_t)t * 512 + lane * 8) = pack8(y); }
}
__device__ __forceinline__ void attn_naive_unit(Frame& F, int o, int l_layer, int unit) {
    const int qb = unit & 31, h = (unit >> 5) & 3, b = unit >> 7, tid = F.tid; const int r = tid & 127, c = (tid >> 7) & 1, half = tid >> 8; const int qrow = b * SEQ + qb * 128 + r;
    const bf16* QR = (const bf16*)(F.ws + WS_XN); const bf16* KR = QR + (size_t)M * 512; const bf16* Y = F_Y;
    LAS float* Kt = (LAS float*)F.lds; LAS float* Vt = Kt + 64 * 128; LAS float* red = Vt + 64 * 128;
    float mq = 0.f, mk = 0.f, d1 = 0.f, d2 = 0.f;
    for (int i = 0; i < 64; ++i) { mq = fmaxf(mq, fabsf(F.in[I_QG][o * 64 + i])); mk = fmaxf(mk, fabsf(F.in[I_KG][o * 64 + i])); d1 += F.in[I_LQ1][o * 64 + i] * F.in[I_LK1][o * 64 + i]; d2 += F.in[I_LQ2][o * 64 + i] * F.in[I_LK2][o * 64 + i]; }
    const float linit = 0.8f - 0.6f * expf(-0.3f * (float)l_layer); const float lam = expf(d1) - expf(d2) + linit;
    const float m2 = 8.f * mq * mk * LOG2E;
    float q[64], O[64]; float l = 0.f;
    { const bf16* qp = QR + (size_t)qrow * 512 + h * 128 + c * 64;
#pragma unroll
      for (int i = 0; i < 8; ++i) { float f8[8]; unpack8(*(const GAS v4u*)(qp + 8 * i), f8);
#pragma unroll
          for (int j = 0; j < 8; ++j) q[8 * i + j] = f8[j]; } }
#pragma unroll
    for (int i = 0; i < 64; ++i) O[i] = 0.f;
    for (int kt = 0; kt < SEQ / 64; ++kt) {
        __syncthreads();
        { const int rr = tid >> 3, ch = tid & 7; const size_t krow = (size_t)b * SEQ + kt * 64 + rr; float f8[8];
#pragma unroll
          for (int hh = 0; hh < 2; ++hh) { unpack8(*(const GAS v4u*)(KR + krow * 512 + h * 128 + hh * 64 + ch * 8), f8);
#pragma unroll
              for (int j = 0; j < 8; ++j) Kt[rr * 128 + hh * 64 + ch * 8 + j] = f8[j];
              unpack8(*(const GAS v4u*)(Y + krow * ODD_IN + 2560 + h * 128 + hh * 64 + ch * 8), f8);
#pragma unroll
              for (int j = 0; j < 8; ++j) Vt[rr * 128 + hh * 64 + ch * 8 + j] = f8[j]; } }
        __syncthreads();
        for (int j = 0; j < 64; ++j) { float s = -m2;
#pragma unroll
            for (int d = 0; d < 64; d += 4) { const f32x4 kv = *(const LAS f32x4*)(Kt + j * 128 + c * 64 + d); s += q[d] * kv.x + q[d + 1] * kv.y + q[d + 2] * kv.z + q[d + 3] * kv.w; }
            const float p = exp2f(s); l += p;
#pragma unroll
            for (int d = 0; d < 64; d += 4) { const f32x4 vv = *(const LAS f32x4*)(Vt + j * 128 + half * 64 + d); O[d] += p * vv.x; O[d + 1] += p * vv.y; O[d + 2] += p * vv.z; O[d + 3] += p * vv.w; } }
    }
    __syncthreads();
    const float il = (c ? lam : 1.f) / l;
    if (c == 1) {
#pragma unroll
        for (int i = 0; i < 64; ++i) Kt[(half * 64 + i) * 128 + r] = O[i] * il; }
    __syncthreads();
    float ss = 0.f;
    if (c == 0) {
#pragma unroll
        for (int i = 0; i < 64; ++i) { O[i] = O[i] * il - Kt[(half * 64 + i) * 128 + r]; ss += O[i] * O[i]; }
        red[half * 128 + r] = ss; }
    __syncthreads();
    if (c == 0) { const float tot = red[r] + red[128 + r]; const float rr = (1.f - linit) / sqrtf(tot * (1.f / 128.f) + EPS); const float* sg = F.in[I_DNG] + o * 128 + half * 64;
        bf16* op = F_MIX + (size_t)qrow * DM + 512 + h * 128 + half * 64;
#pragma unroll
        for (int i = 0; i < 8; ++i) { float f8[8];
#pragma unroll
            for (int j = 0; j < 8; ++j) f8[j] = O[8 * i + j] * rr * sg[8 * i + j];
            *(GAS v4u*)(op + 8 * i) = pack8(f8); } }
    __syncthreads();
}
constexpr int NPH = 2 * 7 + 2 * 8;
struct Args { const float* in[N_IN]; float* out; unsigned char* ws; int ph_lo, ph_hi, li, pad; };
__global__ void __launch_bounds__(NWAVES * 64, 2) fwd_kernel(Args args) {
    extern __shared__ __attribute__((aligned(16))) unsigned char lds[];
    for (int u = threadIdx.x; u < (LDS_BYTES - LDSCTL_OFF) / 4; u += NWAVES * 64) ((LAS unsigned*)((LAS unsigned char*)lds + LDSCTL_OFF))[u] = 0u;
    __syncthreads();
    const int lo = args.ph_lo, hi = args.ph_hi;
    if (hi - lo > 1) (void)xcd_barrier_post((unsigned*)((gu32*)(args.ws + WS_CTL) + CW_BAR), (volatile LAS unsigned*)((LAS unsigned char*)lds + MISC_OFF) + 8);
    int pc = 0;
#define PH_BEGIN if (pc >= lo && pc < hi) { Frame F; { int bx_ = blockIdx.x, tid_ = threadIdx.x; unsigned long long ws_ = (unsigned long long)args.ws, out_ = (unsigned long long)args.out; unsigned w0 = (unsigned)ws_, w1 = (unsigned)(ws_ >> 32), o0 = (unsigned)out_, o1 = (unsigned)(out_ >> 32); \
        asm volatile("" : "+v"(bx_), "+v"(w0), "+v"(w1), "+v"(o0), "+v"(o1), "+v"(tid_)); bx_ = __builtin_amdgcn_readfirstlane(bx_); w0 = __builtin_amdgcn_readfirstlane(w0); w1 = __builtin_amdgcn_readfirstlane(w1); o0 = __builtin_amdgcn_readfirstlane(o0); o1 = __builtin_amdgcn_readfirstlane(o1); \
        F.lds = (LAS unsigned char*)lds; F.tid = tid_; F.lane = tid_ & 63; F.wave = __builtin_amdgcn_readfirstlane(tid_ >> 6); F.G = gridDim.x; F.in = args.in; \
        F.bx = bx_; F.ws = (unsigned char*)(((unsigned long long)w1 << 32) | w0); F.out = (float*)(((unsigned long long)o1 << 32) | o0); F.vcu = (F.G % 8 == 0) ? (bx_ % 8) * (F.G / 8) + bx_ / 8 : bx_; }
#define PH_END   if (pc + 1 < hi) { XcdBarrier bb; bb.bar = (unsigned*)((gu32*)(F.ws + WS_CTL) + CW_BAR); bb.x = xb_xcc_id(); bb.st = (volatile LAS unsigned*)(F.lds + MISC_OFF) + 8; xcd_barrier(bb); } } ++pc;
    for (int l = 0; l < DEPTH; ++l) {
        const bool even = (l & 1) == 0; const int li = l >> 1; const int Nin = even ? EVEN_IN : ODD_IN;
        PH_BEGIN
#ifndef NO_PREP
 prep_weights(F, l); norm_rows(F, l == 0 ? F.in[I_X] : F.out);
#endif
 PH_END
        PH_BEGIN { pg8::Gemm g{F_XN, F_WIN, M, Nin, DM}; pg8::StaticOrder S; S.init(M, Nin, F.G, F.bx);
            pg8::EpiBf16S<0> E{F_Y, Nin};
            pg8::gemm_phase<pg8::EpiBf16S<0>, pg8::StaticOrder, true, true>(F.lds + RING_OFF, g, S, E); } PH_END
        if (even) {
            PH_BEGIN
#ifndef NO_EVEN
                if (F.bx < 16) hgrn_naive(F, li, F.bx);
                else for (int u = F.bx - 16; u < 512; u += F.G - 16) sgu_naive_unit(F, li, u);
#endif
            PH_END
        } else {
            PH_BEGIN
#ifndef NO_ODDPREP
 conv_phase(F, li); qk_prep_phase(F, li);
#endif
 PH_END
            PH_BEGIN
#ifndef NO_ATTN
 for (int u = F.bx; u < 512; u += F.G) attn_naive_unit(F, li, l, u);
#endif
 PH_END
        }
        PH_BEGIN { pg8::Gemm g{F_MIX, F_WOUT, M, DM, DM}; pg8::StaticOrder S; S.init(M, DM, F.G, F.bx);
            pg8::EpiResF32 E{l == 0 ? F.in[I_X] : F.out, F.out, DM};
            pg8::gemm_phase<pg8::EpiResF32, pg8::StaticOrder, true, true>(F.lds + RING_OFF, g, S, E); } PH_END
        PH_BEGIN
#ifndef NO_PREP
 norm_rows(F, F.out);
#endif
 PH_END
        PH_BEGIN { pg8::Gemm g{F_XN, F_W1, M, FF, DM}; pg8::StaticOrder S; S.init(M, FF, F.G, F.bx);
            pg8::EpiBf16S<2> E{F_Y, FF};
            pg8::gemm_phase<pg8::EpiBf16S<2>, pg8::StaticOrder, true, true>(F.lds + RING_OFF, g, S, E); } PH_END
        PH_BEGIN { pg8::Gemm g{F_Y, F_W2, M, DM, FF}; pg8::StaticOrder S; S.init(M, DM, F.G, F.bx);
            pg8::EpiResF32 E{F.out, F.out, DM};
            pg8::gemm_phase<pg8::EpiResF32, pg8::StaticOrder, true, true>(F.lds + RING_OFF, g, S, E); } PH_END
    }
#undef PH_BEGIN
#undef PH_END
}

extern "C" void kernel_launch(void* const* d_in, const int* in_sizes, int n_in, void* d_out, int out_size, void* d_ws, size_t ws_size, hipStream_t stream) {
    static int grid = 0;
    if (grid == 0) {
        if (n_in != N_IN || in_sizes[0] != M * DM || out_size != M * DM || ws_size < WS_END) { fprintf(stderr, "kernel_launch: unexpected shapes (n_in %d, in0 %d, out %d, ws %zu)\n", n_in, n_in > 0 ? in_sizes[0] : -1, out_size, ws_size); grid = -1; return; }
        int dev = 0, cus = 0, per_cu = 0;
        if (hipGetDevice(&dev) != hipSuccess || hipDeviceGetAttribute(&cus, hipDeviceAttributeMultiprocessorCount, dev) != hipSuccess) { grid = -1; return; }
        if (hipFuncSetAttribute((const void*)fwd_kernel, hipFuncAttributeMaxDynamicSharedMemorySize, LDS_BYTES) != hipSuccess) { fprintf(stderr, "kernel_launch: hipFuncSetAttribute failed\n"); grid = -1; return; }
        if (hipOccupancyMaxActiveBlocksPerMultiprocessor(&per_cu, (const void*)fwd_kernel, NWAVES * 64, LDS_BYTES) != hipSuccess || per_cu < 1) { fprintf(stderr, "kernel_launch: occupancy query reports %d workgroups per CU\n", per_cu); per_cu = 1; }
        (void)hipGetLastError();
        grid = cus;
    }
    if (grid < 0) return;
    if (hipMemsetAsync((char*)d_ws + WS_CTL, 0, CTL_ZERO_BYTES, stream) != hipSuccess) return;
    Args a{};
    for (int i = 0; i < N_IN; ++i) a.in[i] = (const float*)d_in[i];
    a.out = (float*)d_out; a.ws = (unsigned char*)d_ws;
#if MK_ONE_LAUNCH
    a.ph_lo = 0; a.ph_hi = NPH; a.li = 0;
    hipLaunchKernelGGL(fwd_kernel, dim3(grid), dim3(NWAVES * 64), LDS_BYTES, stream, a);
#else
    for (int p = 0; p < NPH; ++p) { a.ph_lo = p; a.ph_hi = p + 1; a.li = p;
        hipLaunchKernelGGL(fwd_kernel, dim3(grid), dim3(NWAVES * 64), LDS_BYTES, stream, a); }
#endif
}
```

```cpp
#include <hip/hip_runtime.h>
#include <cstdio>
#include <cstdint>
#if defined(TPROBE) && TPROBE == 30
#define GTP_BEGIN const unsigned long long gtp0_ = __builtin_amdgcn_s_memrealtime();
#define GTP_END if (g.N == 4096 && blockIdx.x == 0 && threadIdx.x == 0) { volatile __attribute__((address_space(3))) unsigned long long* pa_ = (volatile __attribute__((address_space(3))) unsigned long long*)(lds + 131072 + 320 + 64) + 1; *pa_ = *pa_ + (__builtin_amdgcn_s_memrealtime() - gtp0_); }
#else
#define GTP_BEGIN
#define GTP_END
#endif
namespace pg8 {
#define PG8_LAS __attribute__((address_space(3)))
typedef unsigned short bf16_t;
typedef short bf16x8 __attribute__((ext_vector_type(8)));
typedef float f32x4 __attribute__((ext_vector_type(4)));
typedef unsigned u32x4 __attribute__((ext_vector_type(4)));
constexpr int BM = 256, BK = 64, HALF = 128, HTB = HALF * BK * 2  , STAGE_BYTES = 8 * HTB, NXCD = 8, WGM = 8;

__host__ __device__ __forceinline__ int lds_byte(int r, int c) { const int st = (r >> 4) * 2 + (c >> 5), rr = r & 15, cc = c & 31, ob = rr * 64 + cc * 2; return st * 1024 + (ob ^ (((ob >> 9) & 1) << 5)); }
__host__ __device__ __forceinline__ void stage_rc(int b, int& R, int& C) { const int st = b / 1024, sb = b % 1024, swz = sb ^ (((sb >> 9) & 1) << 5); R = (st >> 1) * 16 + swz / 64; C = (st & 1) * 32 + (swz % 64) / 2; }
__host__ __device__ __forceinline__ int perm32(int rho) { const int n = rho >> 4, i = rho & 15; return 8 * (i >> 2) + 4 * n + (i & 3); }

struct Unit { int pm, pn; };
struct Gemm { const bf16_t* A; const bf16_t* Bt; int M, N, K; int nt_over; int tid; };

struct StaticOrder {
    int nM, nN, nwg, G, c;
    __host__ __device__ void init(int M, int N, int G_, int c_) { nM = M / BM; nN = N / BM; nwg = nM * nN; G = G_; c = c_; }
    __host__ __device__ bool next(int i, Unit& u) const {
        const long L = (long)i * G + c; if (L >= nwg) return false;
        int wgid = (int)L; { const int q = nwg / NXCD, r = nwg % NXCD, xcd = wgid % NXCD, off = wgid / NXCD; wgid = (xcd < r ? xcd * (q + 1) : r * (q + 1) + (xcd - r) * q) + off; }
        const int nig = WGM * nN, gid = wgid / nig, fm = gid * WGM, gsz = (nM - fm) < WGM ? (nM - fm) : WGM;
        u.pm = fm + ((wgid % nig) % gsz); u.pn = (wgid % nig) / gsz; return true;
    }
    __device__ __forceinline__ void a_ready(const Unit&) const {}
    __device__ __forceinline__ void done(const Unit&) const {}
};

__device__ __forceinline__ unsigned cvt_pk_bf16(float lo, float hi) { unsigned r; asm volatile("v_cvt_pk_bf16_f32 %0, %1, %2" : "=v"(r) : "v"(lo), "v"(hi)); return r; }
typedef float f32x2 __attribute__((ext_vector_type(2)));
__device__ __forceinline__ f32x2 gelu_pk(f32x2 v) {
    const f32x2 av = __builtin_elementwise_abs(v), d = av * 0.2316418882f + 1.0f;
    f32x2 t; t.x = __builtin_amdgcn_rcpf(d.x); t.y = __builtin_amdgcn_rcpf(d.y);
    f32x2 q = t * 0.5307027145f + (-0.7265760135f); q = q * t + 0.7107068705f; q = q * t + (-0.142248368f); q = q * t + 0.127414796f; q = q * t;
    const f32x2 s = (v * v) * (-0.72134752044f);
    f32x2 e; e.x = __builtin_amdgcn_exp2f(s.x); e.y = __builtin_amdgcn_exp2f(s.y);
    const f32x2 m = v * (q * e), r = v - m;
    f32x2 o; o.x = v.x < 0.f ? m.x : r.x; o.y = v.y < 0.f ? m.y : r.y; return o;
}

template <int ACT  > struct EpiBf16 {
    static constexpr bool PERM = true, AFTER_DRAIN = false; static_assert(ACT == 0 || ACT == 1, "EpiBf16: ACT is 0 (none) or 1 (gelu_pk)");
    bf16_t* O; int ldc; const float* bias; int split_cols; size_t split_stride; float scale0;
    __device__ __forceinline__ void operator()(const f32x4 (&acc)[2][2][4][2], const Unit& u, int wr, int wc, int fr, int fq) const {
        const int row0 = u.pm * BM + wr * 64 + fr; int colt = u.pn * BM; bf16_t* base = O;
        float sc = 1.f; if (split_cols) { const int t = colt / split_cols; base += (size_t)t * split_stride; colt -= t * split_cols; if (t == 0) sc = scale0; }
        const int col0 = colt + wc * 32 + 8 * fq, bcol0 = u.pn * BM + wc * 32 + 8 * fq;
        f32x4 bv[2][2];
#pragma unroll
        for (int bj = 0; bj < 2; ++bj)
#pragma unroll
            for (int n = 0; n < 2; ++n) bv[bj][n] = bias ? *(const f32x4*)(bias + bcol0 + bj * HALF + 4 * n) : (f32x4){0.f, 0.f, 0.f, 0.f};
#pragma unroll
        for (int ai = 0; ai < 2; ++ai)
#pragma unroll
            for (int m = 0; m < 4; ++m) { bf16_t* rowp = base + (size_t)(row0 + ai * HALF + m * 16) * ldc + col0;
#pragma unroll
                for (int bj = 0; bj < 2; ++bj) { f32x4 v0 = acc[ai][bj][m][0] + bv[bj][0], v1 = acc[ai][bj][m][1] + bv[bj][1];
                    if (ACT == 1) { f32x2 a = gelu_pk((f32x2){v0[0], v0[1]}), b = gelu_pk((f32x2){v0[2], v0[3]}), c = gelu_pk((f32x2){v1[0], v1[1]}), d = gelu_pk((f32x2){v1[2], v1[3]});
                        v0 = (f32x4){a.x, a.y, b.x, b.y}; v1 = (f32x4){c.x, c.y, d.x, d.y}; }
                    v0 = v0 * sc; v1 = v1 * sc; u32x4 w; w.x = cvt_pk_bf16(v0[0], v0[1]); w.y = cvt_pk_bf16(v0[2], v0[3]); w.z = cvt_pk_bf16(v1[0], v1[1]); w.w = cvt_pk_bf16(v1[2], v1[3]);
                    *(u32x4*)(rowp + bj * HALF) = w; } }
    }
};

struct PanelStats {
    unsigned* xbuf;
    unsigned* cnt;
    unsigned* tmo;
    int ntn; float eps;
    unsigned code;
    __device__ __forceinline__ bool run(const f32x4 (&v)[2][2][4][2], const Unit& u, int wr, int wc, int fr, int fq, PG8_LAS unsigned char* lds, int wid, int lane) const {
        typedef float f32x2v __attribute__((ext_vector_type(2)));
        PG8_LAS f32x2v* P = (PG8_LAS f32x2v*)lds;
        PG8_LAS f32x2v* S = (PG8_LAS f32x2v*)(lds + 8192);
        PG8_LAS unsigned* flag = (PG8_LAS unsigned*)(lds + 8192 + 2048);
#pragma unroll
        for (int ai = 0; ai < 2; ++ai)
#pragma unroll
            for (int m = 0; m < 4; ++m) {
                float s = 0.f;
#pragma unroll
                for (int bj = 0; bj < 2; ++bj)
#pragma unroll
                    for (int n = 0; n < 2; ++n) { const f32x4 x = v[ai][bj][m][n]; s += (x[0] + x[1]) + (x[2] + x[3]); }
                s += __shfl_xor(s, 16); s += __shfl_xor(s, 32);
                const float mw = s * (1.0f / 64.0f); float q = 0.f;
#pragma unroll
                for (int bj = 0; bj < 2; ++bj)
#pragma unroll
                    for (int n = 0; n < 2; ++n) { const f32x4 d = v[ai][bj][m][n] - mw; q += (d[0] * d[0] + d[1] * d[1]) + (d[2] * d[2] + d[3] * d[3]); }
                q += __shfl_xor(q, 16); q += __shfl_xor(q, 32);
                if (fq == 0) P[(ai * HALF + wr * 64 + m * 16 + fr) * 4 + wc] = (f32x2v){mw, q};
            }
        asm volatile("s_waitcnt lgkmcnt(0)" ::: "memory"); __builtin_amdgcn_s_barrier(); asm volatile("" ::: "memory");
#if defined(BROKEN_EXCHANGE_NO_WAIT)
#warning BROKEN CONTROL BUILD: the row-statistics exchange does not wait; results are wrong by design
        if (blockIdx.x >= 64) { const long long t0_ = clock64(); while (clock64() - t0_ < 60000) __builtin_amdgcn_s_sleep(8); }
#endif
        const int row = wid * 32 + (lane & 31);
        if (lane < 32) {
            const f32x2v a = P[row * 4 + 0], b = P[row * 4 + 1], c = P[row * 4 + 2], d = P[row * 4 + 3];
            const float mt = (a.x + b.x + c.x + d.x) * 0.25f;
            const float da = a.x - mt, db = b.x - mt, dc = c.x - mt, dd = d.x - mt;
            const float m2 = (a.y + b.y) + (c.y + d.y) + 64.0f * ((da * da + db * db) + (dc * dc + dd * dd));
            unsigned long long* slot = (unsigned long long*)xbuf + ((size_t)(u.pm * BM + row) * 4 + u.pn);
            __hip_atomic_store(slot, ((unsigned long long)__float_as_uint(m2) << 32) | __float_as_uint(mt), __ATOMIC_RELAXED, __HIP_MEMORY_SCOPE_AGENT);
        }
        asm volatile("s_waitcnt vmcnt(0)" ::: "memory");
        if (lane == 0) __hip_atomic_fetch_add(cnt + 64 * u.pm, 1u, __ATOMIC_RELAXED, __HIP_MEMORY_SCOPE_AGENT);
        if (wid == 0) {
            bool dead = false; const unsigned long long t0 = __builtin_amdgcn_s_memrealtime(); const unsigned want = 8u * (unsigned)ntn;
            for (;;) {
#if defined(BROKEN_EXCHANGE_NO_WAIT)
                break;
#endif
                if ((unsigned)__builtin_amdgcn_readfirstlane(__hip_atomic_load(cnt + 64 * u.pm, __ATOMIC_RELAXED, __HIP_MEMORY_SCOPE_AGENT)) >= want) break;
                if (__builtin_amdgcn_s_memrealtime() - t0 > 2000000ull) {
                    if (lane == 0) { unsigned expect = 0u; __hip_atomic_compare_exchange_strong(tmo + 1, &expect, code | (unsigned)(u.pm & 0xff), __ATOMIC_RELAXED, __ATOMIC_RELAXED, __HIP_MEMORY_SCOPE_AGENT);
                                     __hip_atomic_store(tmo, 1u, __ATOMIC_RELAXED, __HIP_MEMORY_SCOPE_AGENT); }
                    dead = true; break; }
                __builtin_amdgcn_s_sleep(2);
            }
            __builtin_amdgcn_fence(__ATOMIC_ACQUIRE, "agent");
            if (lane == 0) flag[0] = dead ? 1u : 0u;
        }
        asm volatile("s_waitcnt vmcnt(0) lgkmcnt(0)" ::: "memory"); __builtin_amdgcn_s_barrier(); asm volatile("" ::: "memory");
        const bool bad = flag[0] != 0u;
        if (lane < 32) {
            const unsigned long long* slot = (const unsigned long long*)xbuf + (size_t)(u.pm * BM + row) * 4; float mt[4], m2[4]; float ms = 0.f;
#pragma unroll
            for (int t = 0; t < 4; ++t) { if (t < ntn) { const unsigned long long w = __hip_atomic_load(slot + t, __ATOMIC_RELAXED, __HIP_MEMORY_SCOPE_AGENT); mt[t] = __uint_as_float((unsigned)w); m2[t] = __uint_as_float((unsigned)(w >> 32)); } else { mt[t] = 0.f; m2[t] = 0.f; } ms += mt[t]; }
            const float mean = ms / (float)ntn; float q = 0.f;
#pragma unroll
            for (int t = 0; t < 4; ++t) if (t < ntn) { const float dm = mt[t] - mean; q += m2[t] + 256.0f * dm * dm; }
            S[row] = (f32x2v){mean, 1.0f / sqrtf(q / (256.0f * (float)ntn) + eps)};
        }
        asm volatile("s_waitcnt lgkmcnt(0)" ::: "memory"); __builtin_amdgcn_s_barrier(); asm volatile("" ::: "memory");
        return bad;
    }
};
struct EpiLnRes {
    static constexpr bool PERM = false, AFTER_DRAIN = true;
    const float* base; float* out; int ldc; const float* bias; PanelStats st; unsigned poison;
    __device__ __forceinline__ void fused(f32x4 (&acc)[2][2][4][2], const Unit& u, int wr, int wc, int fr, int fq, PG8_LAS unsigned char* lds, int wid, int lane) const {
        typedef float f32x2v __attribute__((ext_vector_type(2)));
        const PG8_LAS f32x2v* S = (const PG8_LAS f32x2v*)(lds + 8192);
        const int col0 = u.pn * BM + wc * 32 + 4 * fq;
#pragma unroll
        for (int bj = 0; bj < 2; ++bj)
#pragma unroll
            for (int n = 0; n < 2; ++n) { const f32x4 bv = bias ? *(const f32x4*)(bias + col0 + bj * HALF + n * 16) : (f32x4){0.f, 0.f, 0.f, 0.f};
#pragma unroll
                for (int ai = 0; ai < 2; ++ai)
#pragma unroll
                    for (int m = 0; m < 4; ++m) acc[ai][bj][m][n] += bv; }
        f32x4 pre[4][2][2];
#pragma unroll
        for (int m = 0; m < 4; ++m) { const size_t off = (size_t)(u.pm * BM + wr * 64 + m * 16 + fr) * ldc + col0;
#pragma unroll
            for (int bj = 0; bj < 2; ++bj)
#pragma unroll
                for (int n = 0; n < 2; ++n) pre[m][bj][n] = *(const f32x4*)(base + off + bj * HALF + n * 16); }
        const bool bad = st.run(acc, u, wr, wc, fr, fq, lds, wid, lane) || poison != 0u;
        const float qnan = __builtin_nanf("");
#pragma unroll
        for (int ai = 0; ai < 2; ++ai)
#pragma unroll
            for (int m = 0; m < 4; ++m) { const int r = ai * HALF + wr * 64 + m * 16 + fr; const f32x2v sr = S[r]; const size_t off = (size_t)(u.pm * BM + r) * ldc + col0;
#pragma unroll
                for (int bj = 0; bj < 2; ++bj)
#pragma unroll
                    for (int n = 0; n < 2; ++n) { const f32x4 bs = ai == 0 ? pre[m][bj][n] : *(const f32x4*)(base + off + bj * HALF + n * 16); f32x4 o = bs + (acc[ai][bj][m][n] - sr.x) * sr.y;
                        if (bad) o = (f32x4){qnan, qnan, qnan, qnan}; *(f32x4*)(out + off + bj * HALF + n * 16) = o; }
                if (m & 1) asm volatile("" ::: "memory"); }
    }
};
struct EpiLnResLn {
    static constexpr bool PERM = false, AFTER_DRAIN = true;
    const float* base; float* out; bf16_t* xn; int ldc; const float* bias; PanelStats st1, st2; unsigned poison;
    __device__ __forceinline__ void fused(f32x4 (&acc)[2][2][4][2], const Unit& u, int wr, int wc, int fr, int fq, PG8_LAS unsigned char* lds, int wid, int lane) const {
        typedef float f32x2v __attribute__((ext_vector_type(2))); typedef unsigned u32x2v __attribute__((ext_vector_type(2)));
        const PG8_LAS f32x2v* S = (const PG8_LAS f32x2v*)(lds + 8192);
        const int col0 = u.pn * BM + wc * 32 + 4 * fq;
#pragma unroll
        for (int bj = 0; bj < 2; ++bj)
#pragma unroll
            for (int n = 0; n < 2; ++n) { const f32x4 bv = bias ? *(const f32x4*)(bias + col0 + bj * HALF + n * 16) : (f32x4){0.f, 0.f, 0.f, 0.f};
#pragma unroll
                for (int ai = 0; ai < 2; ++ai)
#pragma unroll
                    for (int m = 0; m < 4; ++m) acc[ai][bj][m][n] += bv; }
        bool bad = st1.run(acc, u, wr, wc, fr, fq, lds, wid, lane) || poison != 0u;
        const float qnan = __builtin_nanf("");
#pragma unroll
        for (int ai = 0; ai < 2; ++ai)
#pragma unroll
            for (int m = 0; m < 4; ++m) { const int r = ai * HALF + wr * 64 + m * 16 + fr; const f32x2v sr = S[r]; const size_t off = (size_t)(u.pm * BM + r) * ldc + col0;
#pragma unroll
                for (int bj = 0; bj < 2; ++bj)
#pragma unroll
                    for (int n = 0; n < 2; ++n) { const f32x4 bs = *(const f32x4*)(base + off + bj * HALF + n * 16); acc[ai][bj][m][n] = bs + (acc[ai][bj][m][n] - sr.x) * sr.y; }
                asm volatile("" : "+v"(acc[ai][0][m][0]), "+v"(acc[ai][0][m][1]), "+v"(acc[ai][1][m][0]), "+v"(acc[ai][1][m][1]));
                if (m & 1) asm volatile("" ::: "memory"); }
        const bool bad1 = bad;
        bad = st2.run(acc, u, wr, wc, fr, fq, lds, wid, lane) || bad;
#pragma unroll
        for (int ai = 0; ai < 2; ++ai)
#pragma unroll
            for (int m = 0; m < 4; ++m) { const int r = ai * HALF + wr * 64 + m * 16 + fr; const f32x2v sr = S[r]; const size_t off = (size_t)(u.pm * BM + r) * ldc + col0;
#pragma unroll
                for (int bj = 0; bj < 2; ++bj)
#pragma unroll
                    for (int n = 0; n < 2; ++n) { const f32x4 x1 = acc[ai][bj][m][n]; *(f32x4*)(out + off + bj * HALF + n * 16) = bad1 ? (f32x4){qnan, qnan, qnan, qnan} : x1;
                        const f32x4 o = (x1 - sr.x) * sr.y; u32x2v w; w.x = cvt_pk_bf16(o[0], o[1]); w.y = cvt_pk_bf16(o[2], o[3]);
                        if (bad) { w.x = 0x7fc07fc0u; w.y = 0x7fc07fc0u; } *(u32x2v*)(xn + off + bj * HALF + n * 16) = w; }
                asm volatile("" ::: "memory"); }
    }
};

template <class Epi, class Sched, bool ALIGN_EPI = false, bool SP2 = false>
__device__ __forceinline__ void gemm_phase(PG8_LAS unsigned char* lds, const Gemm g, const Sched& S, const Epi& E) {
    int tid_ = g.tid; asm volatile("" : "+v"(tid_));
    const int tid = tid_, wid = __builtin_amdgcn_readfirstlane(tid >> 6), lane = tid & 63, wr = wid >> 2, wc = wid & 3, fr = lane & 15, fq = lane >> 4;
    const int K = g.K, nt = g.nt_over ? g.nt_over : K / BK;
    unsigned voffA[2], voffB[2];
#pragma unroll
    for (int i = 0; i < 2; ++i) { int R, C; stage_rc(tid * 16 + i * 8192, R, C); const int Rb = Epi::PERM ? ((R & ~31) + perm32(R & 31)) : R;
        voffA[i] = (unsigned)(R * K + C) * 2u; voffB[i] = (unsigned)(Rb * K + C) * 2u; }
    const size_t kstep = (size_t)(BK * 2);
    const size_t hstep = (size_t)HALF * K * 2;
    const size_t tstep = 2 * hstep;
    const unsigned ldsw = (unsigned)wid * 1024u;
    const int aoff = lds_byte(wr * 64 + fr, fq * 8), boff = lds_byte(wc * 32 + fr, fq * 8);
#define PG8_SA(b, h) (((b) * 2 + (h)) * HTB)
#define PG8_SB(b, h) ((4 + (b) * 2 + (h)) * HTB)
#define PG8_STAGE(bufoff, gbase, voff) do { _Pragma("unroll") for (int _i = 0; _i < 2; ++_i) \
        __builtin_amdgcn_global_load_lds((const unsigned*)((const char*)(gbase) + (voff)[_i]), (PG8_LAS unsigned*)(lds + (bufoff) + ldsw + _i * 8192), 16, 0, 0); } while (0)
#define PG8_LDA(dst, b, h) do { _Pragma("unroll") for (int m = 0; m < 4; ++m) _Pragma("unroll") for (int k = 0; k < 2; ++k) dst[m][k] = *(const PG8_LAS bf16x8*)(lds + PG8_SA(b, h) + aoff + m * 2048 + k * 1024); } while (0)
#define PG8_LDB(dst, b, h) do { _Pragma("unroll") for (int n = 0; n < 2; ++n) _Pragma("unroll") for (int k = 0; k < 2; ++k) dst[n][k] = *(const PG8_LAS bf16x8*)(lds + PG8_SB(b, h) + boff + n * 2048 + k * 1024); } while (0)
#define PG8_MMA(ai, bj, At, Bt) do { __builtin_amdgcn_s_setprio(1); _Pragma("unroll") for (int m = 0; m < 4; ++m) _Pragma("unroll") for (int n = 0; n < 2; ++n) _Pragma("unroll") for (int k = 0; k < 2; ++k) \
        acc[ai][bj][m][n] = __builtin_amdgcn_mfma_f32_16x16x32_bf16(Bt[n][k], At[m][k], acc[ai][bj][m][n], 0, 0, 0); __builtin_amdgcn_s_setprio(0); } while (0)
#define PG8_WAIT_V(n) asm volatile("s_waitcnt vmcnt(" #n ")" ::: "memory")
#define PG8_WAIT_L(n) asm volatile("s_waitcnt lgkmcnt(" #n ")" ::: "memory")
#define PG8_BAR __builtin_amdgcn_s_barrier()
#define PG8_SCHED __builtin_amdgcn_sched_barrier(0)
    Unit cur, nxt; int ui = 0;
    if (!S.next(0, cur)) return;
    f32x4 acc[2][2][4][2];
#pragma unroll
    for (int a = 0; a < 2; ++a)
#pragma unroll
        for (int b = 0; b < 2; ++b)
#pragma unroll
            for (int m = 0; m < 4; ++m)
#pragma unroll
                for (int n = 0; n < 2; ++n) acc[a][b][m][n] = (f32x4){0.f, 0.f, 0.f, 0.f};
    bf16x8 At[4][2], B0[2][2], B1[2][2];
    const char* cA = (const char*)g.A + (size_t)cur.pm * tstep; const char* cB = (const char*)g.Bt + (size_t)cur.pn * tstep;
    S.a_ready(cur);
    if constexpr (SP2) {
        PG8_STAGE(PG8_SB(0, 0), cB, voffB); PG8_STAGE(PG8_SB(0, 1), cB + hstep, voffB); PG8_STAGE(PG8_SA(0, 0), cA, voffA); PG8_STAGE(PG8_SA(0, 1), cA + hstep, voffA);
        if (wr == 1) PG8_BAR;
        PG8_WAIT_V(2); PG8_BAR;
        PG8_STAGE(PG8_SB(1, 0), cB + kstep, voffB); PG8_STAGE(PG8_SA(1, 0), cA + kstep, voffA); PG8_STAGE(PG8_SB(1, 1), cB + hstep + kstep, voffB);
        PG8_WAIT_V(6); PG8_BAR;
    } else {
        PG8_STAGE(PG8_SB(0, 0), cB, voffB); PG8_STAGE(PG8_SA(0, 0), cA, voffA); PG8_STAGE(PG8_SB(0, 1), cB + hstep, voffB); PG8_STAGE(PG8_SA(0, 1), cA + hstep, voffA);
        if (wr == 1) PG8_BAR;
        PG8_WAIT_V(4); PG8_BAR;
        PG8_STAGE(PG8_SB(1, 0), cB + kstep, voffB); PG8_STAGE(PG8_SA(1, 0), cA + kstep, voffA); PG8_STAGE(PG8_SB(1, 1), cB + hstep + kstep, voffB);
        PG8_WAIT_V(6); PG8_BAR;
    }
    for (;;) {
        const bool has_next = S.next(ui + 1, nxt);
        const char* nA = has_next ? (const char*)g.A + (size_t)nxt.pm * tstep : cA; const char* nB = has_next ? (const char*)g.Bt + (size_t)nxt.pn * tstep : cB;
        for (int t = 0; t < nt; t += 2) {
            const bool last = (t == nt - 2);
            const char* a1 = cA + (size_t)(t + 1) * kstep;
            const char* a2 = last ? nA : cA + (size_t)(t + 2) * kstep; const char* b2 = last ? nB : cB + (size_t)(t + 2) * kstep;
            const char* a3 = a2 + kstep; const char* b3 = b2 + kstep;
            if (last && has_next) S.a_ready(nxt);
            if constexpr (SP2) {
            PG8_LDB(B0, 0, 0); PG8_LDB(B1, 0, 1); PG8_SCHED; PG8_LDA(At, 0, 0); PG8_STAGE(PG8_SA(1, 1), a1 + hstep, voffA);
            PG8_WAIT_V(8); PG8_WAIT_L(0); PG8_BAR; PG8_MMA(0, 0, At, B0); PG8_MMA(0, 1, At, B1); PG8_BAR; PG8_SCHED;
            PG8_LDA(At, 0, 1); PG8_STAGE(PG8_SB(0, 0), b2, voffB); PG8_STAGE(PG8_SB(0, 1), b2 + hstep, voffB); PG8_STAGE(PG8_SA(0, 0), a2, voffA);
            PG8_WAIT_V(8); PG8_WAIT_L(0); PG8_BAR; PG8_MMA(1, 0, At, B0); PG8_MMA(1, 1, At, B1); PG8_BAR; PG8_SCHED;
            PG8_LDB(B0, 1, 0); PG8_LDB(B1, 1, 1); PG8_SCHED; PG8_LDA(At, 1, 0); PG8_STAGE(PG8_SA(0, 1), a2 + hstep, voffA);
            PG8_WAIT_V(8); PG8_WAIT_L(0); PG8_BAR; PG8_MMA(0, 0, At, B0); PG8_MMA(0, 1, At, B1); PG8_BAR; PG8_SCHED;
            PG8_LDA(At, 1, 1); PG8_STAGE(PG8_SB(1, 0), b3, voffB); PG8_STAGE(PG8_SB(1, 1), b3 + hstep, voffB); PG8_STAGE(PG8_SA(1, 0), a3, voffA);
            PG8_WAIT_V(8); PG8_WAIT_L(0); PG8_BAR; PG8_MMA(1, 0, At, B0); PG8_MMA(1, 1, At, B1); PG8_BAR; PG8_SCHED;
            } else {
            PG8_LDB(B0, 0, 0); PG8_SCHED; PG8_LDA(At, 0, 0); PG8_STAGE(PG8_SA(1, 1), a1 + hstep, voffA);
            PG8_WAIT_L(8); PG8_BAR; PG8_WAIT_L(0); PG8_MMA(0, 0, At, B0); PG8_BAR; PG8_SCHED;
            PG8_LDB(B1, 0, 1); PG8_STAGE(PG8_SB(0, 0), b2, voffB);
            PG8_BAR; PG8_WAIT_L(0); PG8_MMA(0, 1, At, B1); PG8_BAR;
            PG8_LDA(At, 0, 1); PG8_STAGE(PG8_SA(0, 0), a2, voffA);
            PG8_BAR; PG8_WAIT_L(0); PG8_MMA(1, 0, At, B0); PG8_BAR; PG8_SCHED;
            PG8_STAGE(PG8_SB(0, 1), b2 + hstep, voffB);
            PG8_WAIT_V(6); PG8_BAR; PG8_MMA(1, 1, At, B1); PG8_BAR;
            PG8_LDB(B0, 1, 0); PG8_SCHED; PG8_LDA(At, 1, 0); PG8_STAGE(PG8_SA(0, 1), a2 + hstep, voffA);
            PG8_WAIT_L(8); PG8_BAR; PG8_WAIT_L(0); PG8_MMA(0, 0, At, B0); PG8_BAR; PG8_SCHED;
            PG8_LDB(B1, 1, 1); PG8_STAGE(PG8_SB(1, 0), b3, voffB);
            PG8_BAR; PG8_WAIT_L(0); PG8_MMA(0, 1, At, B1); PG8_BAR;
            PG8_LDA(At, 1, 1); PG8_STAGE(PG8_SA(1, 0), a3, voffA);
            PG8_BAR; PG8_WAIT_L(0); PG8_MMA(1, 0, At, B0); PG8_BAR; PG8_SCHED;
            PG8_STAGE(PG8_SB(1, 1), b3 + hstep, voffB);
            PG8_WAIT_V(6); PG8_BAR; PG8_MMA(1, 1, At, B1); PG8_BAR;
            }
        }
        if constexpr (ALIGN_EPI) { if (wr == 0) PG8_BAR; }
        if constexpr (!Epi::AFTER_DRAIN) { GTP_BEGIN E(acc, cur, wr, wc, fr, fq); GTP_END S.done(cur); }
        if (!has_next) break;
#pragma unroll
        for (int a = 0; a < 2; ++a)
#pragma unroll
            for (int b = 0; b < 2; ++b)
#pragma unroll
                for (int m = 0; m < 4; ++m)
#pragma unroll
                    for (int n = 0; n < 2; ++n) acc[a][b][m][n] = (f32x4){0.f, 0.f, 0.f, 0.f};
        cur = nxt; cA = nA; cB = nB; ++ui;
        if constexpr (ALIGN_EPI) { if (wr == 1) PG8_BAR; }
    }
    PG8_WAIT_V(0);
    if constexpr (!ALIGN_EPI) { if (wr == 0) PG8_BAR; }
    PG8_BAR;
    if constexpr (Epi::AFTER_DRAIN) { E.fused(acc, cur, wr, wc, fr, fq, lds, wid, lane); S.done(cur); }
#undef PG8_SA
#undef PG8_SB
#undef PG8_STAGE
#undef PG8_LDA
#undef PG8_LDB
#undef PG8_MMA
#undef PG8_WAIT_V
#undef PG8_WAIT_L
#undef PG8_BAR
#undef PG8_SCHED
}
}
namespace pg8 {
template <int ACT  > struct EpiBf16S {
    static constexpr bool PERM = true, AFTER_DRAIN = false;
    bf16_t* O; int ldc; const PG8_LAS float* rst; const PG8_LAS int* pmt; bool nostore;
    __device__ __forceinline__ void operator()(const f32x4 (&acc)[2][2][4][2], const Unit& u, int wr, int wc, int fr, int fq) const {
        const int row0 = u.pm * BM + wr * 64 + fr, col0 = u.pn * BM + wc * 32 + 8 * fq;
        int ti = 0;
#pragma unroll
        for (int i = 1; i < 4; ++i) if (pmt[i] == u.pm) ti = i;
        const PG8_LAS float* rt = rst + ti * 256 + wr * 64 + fr;
#pragma unroll
        for (int ai = 0; ai < 2; ++ai)
#pragma unroll
            for (int m = 0; m < 4; ++m) { bf16_t* rowp = O + (size_t)(row0 + ai * HALF + m * 16) * ldc + col0; const float r = rt[ai * HALF + m * 16];
#pragma unroll
                for (int bj = 0; bj < 2; ++bj) { f32x4 v0 = acc[ai][bj][m][0] * r, v1 = acc[ai][bj][m][1] * r;
                    if (ACT == 2) {
#pragma unroll
                        for (int i = 0; i < 4; ++i) { const float a = v0[i] > 0.f ? v0[i] : 0.f, b = v1[i] > 0.f ? v1[i] : 0.f; v0[i] = a * a; v1[i] = b * b; } }
                    u32x4 w; w.x = cvt_pk_bf16(v0[0], v0[1]); w.y = cvt_pk_bf16(v0[2], v0[3]); w.z = cvt_pk_bf16(v1[0], v1[1]); w.w = cvt_pk_bf16(v1[2], v1[3]);
                    if (!nostore) *(u32x4*)(rowp + bj * HALF) = w; else asm volatile("" :: "v"(w)); } }
    }
};
template <bool BASE_F32, bool OUT_F32> struct EpiRes {
    static constexpr bool PERM = true, AFTER_DRAIN = false;
    const void* base; void* out; int ldc; float* ss;
    __device__ __forceinline__ void operator()(const f32x4 (&acc)[2][2][4][2], const Unit& u, int wr, int wc, int fr, int fq) const {
        const int row0 = u.pm * BM + wr * 64 + fr, col0 = u.pn * BM + wc * 32 + 8 * fq;
        f32x4 pf[3][2][2];
        u32x4 pb[3][2];
#define RES_LOAD(gi_, slot_) do { const int ai2_ = (gi_) >> 2, m2_ = (gi_) & 3; const size_t off2_ = (size_t)(row0 + ai2_ * HALF + m2_ * 16) * ldc + col0; \
            _Pragma("unroll") for (int bj = 0; bj < 2; ++bj) { if (BASE_F32) { pf[slot_][bj][0] = *(const f32x4*)((const float*)base + off2_ + bj * HALF); pf[slot_][bj][1] = *(const f32x4*)((const float*)base + off2_ + bj * HALF + 4); } \
                else pb[slot_][bj] = *(const u32x4*)((const bf16_t*)base + off2_ + bj * HALF); } } while (0)
        RES_LOAD(0, 0); RES_LOAD(1, 1);
#pragma unroll
        for (int gi = 0; gi < 8; ++gi) { const int ai = gi >> 2, m = gi & 3; const size_t off = (size_t)(row0 + ai * HALF + m * 16) * ldc + col0;
            if (gi + 2 < 8) RES_LOAD(gi + 2, (gi + 2) % 3);
            float sq = 0.f;
#pragma unroll
            for (int bj = 0; bj < 2; ++bj) { f32x4 b0, b1;
                if (BASE_F32) { b0 = pf[gi % 3][bj][0]; b1 = pf[gi % 3][bj][1]; }
                else { const u32x4 w = pb[gi % 3][bj]; b0 = (f32x4){__uint_as_float(w.x << 16), __uint_as_float(w.x & 0xffff0000u), __uint_as_float(w.y << 16), __uint_as_float(w.y & 0xffff0000u)};
                    b1 = (f32x4){__uint_as_float(w.z << 16), __uint_as_float(w.z & 0xffff0000u), __uint_as_float(w.w << 16), __uint_as_float(w.w & 0xffff0000u)}; }
                const f32x4 o0 = b0 + acc[ai][bj][m][0], o1 = b1 + acc[ai][bj][m][1];
                sq += ((o0[0] * o0[0] + o0[1] * o0[1]) + (o0[2] * o0[2] + o0[3] * o0[3])) + ((o1[0] * o1[0] + o1[1] * o1[1]) + (o1[2] * o1[2] + o1[3] * o1[3]));
                if (OUT_F32) { *(f32x4*)((float*)out + off + bj * HALF) = o0; *(f32x4*)((float*)out + off + bj * HALF + 4) = o1; }
                else { u32x4 w; w.x = cvt_pk_bf16(o0[0], o0[1]); w.y = cvt_pk_bf16(o0[2], o0[3]); w.z = cvt_pk_bf16(o1[0], o1[1]); w.w = cvt_pk_bf16(o1[2], o1[3]); *(u32x4*)((bf16_t*)out + off + bj * HALF) = w; } }
            if (ss) { sq += __shfl_xor(sq, 16); sq += __shfl_xor(sq, 32); if (fq == 0) ss[(size_t)(row0 + ai * HALF + m * 16) * 16 + u.pn * 4 + wc] = sq; } }
#undef RES_LOAD
    }
};
}
#ifndef PG8_SP2
#define PG8_SP2 true
#endif
constexpr int NWAVES = 8;
constexpr int BATCH = 4, SEQ = 4096, DM = 1024, DEPTH = 4, FF = 4096, EVEN_IN = 3584, ODD_IN = 3072;
constexpr int M = BATCH * SEQ;
constexpr float EPS = 1e-6f;
constexpr float LOG2E = 1.4426950408889634f;
#ifndef MK_ONE_LAUNCH
#define MK_ONE_LAUNCH 1
#endif
enum { I_X = 0, I_NMIX, I_NMLP, I_WINE, I_WOUTE, I_SGUG, I_SGUW, I_SGUB, I_LBL, I_HNG, I_WINO, I_WOUTO, I_CONVW, I_QG, I_KG, I_LQ1, I_LK1, I_LQ2, I_LK2, I_DNG, I_W1, I_W2, N_IN };

constexpr size_t MiB = 1u << 20;
constexpr size_t WS_CTL = 0, CTL_ZERO_BYTES = 1 * MiB;
constexpr size_t WS_WIN = 1 * MiB, WS_WOUT = 8 * MiB, WS_W1 = 10 * MiB, WS_W2 = 18 * MiB;
constexpr size_t WS_XN = 26 * MiB;
constexpr size_t WS_Y = 58 * MiB;
constexpr size_t WS_MIX = 186 * MiB;
constexpr size_t WS_END = 218 * MiB;
constexpr int CW_TMO = 0, CW_CODE = 1, CW_BAR = 4096;
constexpr int CW_CENSUS = 8192, CW_GCNT = 12288, CW_DONE = 20480;

constexpr int RING_OFF = 0, RING_BYTES = 131072;
constexpr int LDSCTL_OFF = RING_BYTES, MISC_OFF = LDSCTL_OFF + 320;
constexpr int LDS_BYTES = 163840;
#define GAS __attribute__((address_space(1)))
#define LAS __attribute__((address_space(3)))
typedef unsigned short bf16;
typedef unsigned v4u __attribute__((ext_vector_type(4)));
typedef float f32x4 __attribute__((ext_vector_type(4)));
typedef short bf16x8 __attribute__((ext_vector_type(8)));
typedef GAS unsigned gu32;
typedef GAS unsigned long long gu64;
#define RLX_AGENT __ATOMIC_RELAXED, __HIP_MEMORY_SCOPE_AGENT
#define LDS_WAIT() asm volatile("s_waitcnt lgkmcnt(0)" ::: "memory")
#define VM_WAIT() asm volatile("s_waitcnt vmcnt(0)" ::: "memory")
__device__ __forceinline__ unsigned long long rt() { return __builtin_amdgcn_s_memrealtime(); }
__device__ __forceinline__ unsigned f2bf(float f) { unsigned u = __builtin_bit_cast(unsigned, f); return (u + 0x7fffu + ((u >> 16) & 1u)) >> 16; }
__device__ __forceinline__ unsigned pk2(float lo, float hi) { typedef float f32x2_ __attribute__((ext_vector_type(2))); typedef __bf16 bf16x2_ __attribute__((ext_vector_type(2))); const f32x2_ v = {lo, hi}; return __builtin_bit_cast(unsigned, __builtin_convertvector(v, bf16x2_)); }

#define XB_TMO      128
#define XB_XCNT(j)  (256  + 64 * (j))
#define XB_XSUB(j)  (1280 + 64 * (j))
#define XB_XGEN(j)  (2304 + 64 * (j))
#define XB_TOP      3328
#define XB_TOPGEN   3392
#define XCD_BAR_WORDS 3456
#define XB_SPIN_CAP (1u << 18)

__device__ __forceinline__ unsigned xb_ld(unsigned* p)              { return __hip_atomic_load(p, __ATOMIC_RELAXED, __HIP_MEMORY_SCOPE_AGENT); }
__device__ __forceinline__ unsigned xb_add(unsigned* p, unsigned v) { return __hip_atomic_fetch_add(p, v, __ATOMIC_RELAXED, __HIP_MEMORY_SCOPE_AGENT); }
__device__ __forceinline__ unsigned xb_xcc_id() { return (unsigned)__builtin_amdgcn_s_getreg((3 << 11) | 20) & 0xFu; }
#define XB_SPIN(cond, bar) do { unsigned _sp = 0; while (cond) { __builtin_amdgcn_s_sleep(1); \
    if ((++_sp & 255u) == 0u) { if (xb_ld(&(bar)[XB_TMO])) break; if (_sp > XB_SPIN_CAP) { atomicAdd(&(bar)[XB_TMO], 1u); break; } } } } while (0)

struct XcdBarrier {
    unsigned* bar; unsigned x; bool lead;
    volatile LAS unsigned* st;
};

__device__ __forceinline__ XcdBarrier xcd_barrier_post(unsigned* bar, volatile LAS unsigned* st, bool lead) {
    XcdBarrier b; b.bar = bar; b.x = xb_xcc_id(); b.st = st; b.lead = lead;
    if (lead) (void)xb_add(&bar[XB_XCNT(b.x)], 1u);
    return b;
}
__device__ __forceinline__ void xcd_barrier_complete(unsigned* bar, unsigned x, unsigned& nloc, unsigned& nx) {
    const unsigned G = gridDim.x * gridDim.y * gridDim.z;
    unsigned sum, cnt, mine, sp = 0u;
    for (;;) {
        sum = 0u; cnt = 0u; mine = 0u;
#pragma unroll
        for (unsigned j = 0; j < 16; ++j) { const unsigned c = xb_ld(&bar[XB_XCNT(j)]); sum += c; cnt += (c > 0u) ? 1u : 0u; mine = (j == x) ? c : mine; }
        if (sum == G) break;
        __builtin_amdgcn_s_sleep(1);
        if ((++sp & 255u) == 0u) { if (xb_ld(&bar[XB_TMO])) break; if (sp > XB_SPIN_CAP) { atomicAdd(&bar[XB_TMO], 1u); break; } }
    }
    nloc = mine > 0u ? mine : 1u; nx = cnt > 0u ? cnt : 1u;
}

__device__ __forceinline__ void xcd_barrier(const XcdBarrier& b) {
    asm volatile("s_waitcnt vmcnt(0)" ::: "memory");
    __syncthreads();
    if (b.lead) {
        unsigned* bar = b.bar;
        __builtin_amdgcn_s_waitcnt(0);
        unsigned nloc = b.st[0], nx = b.st[1];
        if (nloc == 0u) { xcd_barrier_complete(bar, b.x, nloc, nx); b.st[0] = nloc; b.st[1] = nx; }
        const unsigned old = xb_add(&bar[XB_XSUB(b.x)], 1u);
        const unsigned gen = old / nloc;
        if (old + 1u == (gen + 1u) * nloc) {
            __builtin_amdgcn_fence(__ATOMIC_RELEASE, "agent");
            asm volatile("s_waitcnt vmcnt(0)" ::: "memory");
            const unsigned og = xb_add(&bar[XB_TOP], 1u);
            const unsigned tg = og / nx;
            if (og + 1u == (tg + 1u) * nx) xb_add(&bar[XB_TOPGEN], 1u);
            else XB_SPIN(xb_ld(&bar[XB_TOPGEN]) == tg, bar);
            __builtin_amdgcn_fence(__ATOMIC_ACQUIRE, "agent");
            xb_add(&bar[XB_XGEN(b.x)], 1u);
            asm volatile("s_waitcnt vmcnt(0)" ::: "memory");
        } else {
            XB_SPIN(xb_ld(&bar[XB_XGEN(b.x)]) == gen, bar);
            __builtin_amdgcn_fence(__ATOMIC_ACQUIRE, "agent");
            asm volatile("s_waitcnt vmcnt(0)" ::: "memory");
        }
    }
    __syncthreads();
}

__device__ __forceinline__ void group_barrier(const XcdBarrier& b, unsigned* ctl, unsigned G, unsigned blk, int tid, int arrive_on = -1, int wait_on = -1, unsigned wait_target = 0u, int also_lo = -1, int also_hi = -1) {
    asm volatile("s_waitcnt vmcnt(0)" ::: "memory");
    unsigned mode = b.st[5];
    if (mode == 0u) {
        bool ok = (G == 256u);
#ifdef FORCE_GRID_FALLBACK
        ok = false;
#endif
        if (ok && tid < 256) { const unsigned c = xb_ld(&ctl[CW_CENSUS + tid]), r = xb_ld(&ctl[CW_CENSUS + (tid & 7)]); ok = (c != 0u) && (c == r); }
        if (b.lead) b.st[7] = 1u;
        __syncthreads();
        if (!ok) b.st[7] = 0u;
        __syncthreads();
        mode = b.st[7] ? 1u : 2u;
        __syncthreads();
        if (b.lead) b.st[5] = mode;
    }
    __syncthreads();
    if (mode == 1u) {
        if (b.lead) {
            unsigned* cnt = &ctl[CW_GCNT + 64 * (blk & 63u)];
            const unsigned k = b.st[6] + 1u; b.st[6] = k;
            if (arrive_on >= 0) (void)xb_add(&ctl[CW_DONE + 64 * arrive_on], 1u);
            (void)xb_add(cnt, 1u);
            unsigned* c_lo = also_lo >= 0 ? &ctl[CW_GCNT + 64 * ((also_lo >> 3) + 8 * (also_lo & 7))] : nullptr;
            unsigned* c_hi = (also_hi >= 0 && also_hi != also_lo) ? &ctl[CW_GCNT + 64 * ((also_hi >> 3) + 8 * (also_hi & 7))] : nullptr;
            unsigned* c_w = wait_on >= 0 ? &ctl[CW_DONE + 64 * wait_on] : nullptr;
            const unsigned need = (G / 64u) * k;
            { unsigned sp_ = 0;
              for (;;) {
                  const unsigned v0 = xb_ld(cnt), v1 = c_lo ? xb_ld(c_lo) : need, v2 = c_hi ? xb_ld(c_hi) : need, v3 = c_w ? xb_ld(c_w) : wait_target;
                  if (((v0 >= need) & (v1 >= need) & (v2 >= need) & (v3 >= wait_target)) != 0) break;
                  __builtin_amdgcn_s_sleep(1);
                  if ((++sp_ & 255u) == 0u) { if (xb_ld(&b.bar[XB_TMO])) break; if (sp_ > XB_SPIN_CAP) { atomicAdd(&b.bar[XB_TMO], 1u); break; } } } }
            __builtin_amdgcn_fence(__ATOMIC_ACQUIRE, "agent");
            asm volatile("s_waitcnt vmcnt(0)" ::: "memory");
        }
        __syncthreads();
    } else xcd_barrier(b);
}

__device__ __forceinline__ void guard_wait(const XcdBarrier& b, unsigned* ctl, int idx, unsigned target) {
    if (b.st[5] == 1u) { if (b.lead) XB_SPIN(xb_ld(&ctl[CW_DONE + 64 * idx]) < target, b.bar); __syncthreads(); }
}
struct Frame {
    LAS unsigned char* lds;
    int tid, lane, wave;
    int vcu, G, bx;
    const float* const* in;
    float* out; unsigned char* ws;
};
#define F_WIN ((bf16*)(F.ws + WS_WIN))
#define F_WOUT ((bf16*)(F.ws + WS_WOUT))
#define F_W1 ((bf16*)(F.ws + WS_W1))
#define F_W2 ((bf16*)(F.ws + WS_W2))
#define F_XN ((bf16*)(F.ws + WS_XN))
#define F_Y ((bf16*)(F.ws + WS_Y))
#define F_MIX ((bf16*)(F.ws + WS_MIX))
static __device__ const double ROPE_TURNS[32] = {0.15915494309189535, 0.11934937021124886, 0.08949940160889101, 0.06711508300522726, 0.050329212104487035, 0.03774158471741977, 0.0283021958306234, 0.02122365276477766, 0.015915494309189534, 0.011934937021124886, 0.008949940160889102, 0.006711508300522725, 0.005032921210448704, 0.003774158471741977, 0.00283021958306234, 0.0021223652764777662, 0.0015915494309189536, 0.0011934937021124885, 0.0008949940160889102, 0.0006711508300522726, 0.0005032921210448703, 0.00037741584717419774, 0.00028302195830623395, 0.0002122365276477766, 0.00015915494309189535, 0.00011934937021124886, 8.949940160889102e-05, 6.711508300522725e-05, 5.0329212104487035e-05, 3.774158471741978e-05, 2.8302195830623396e-05, 2.122365276477766e-05};
typedef unsigned long long u64;
#ifdef TPROBE
#define TP_BEGIN(id) unsigned long long tp0_##id = 0; if (TPROBE < 100 && ((id) == 1 || TPROBE == (id))) tp0_##id = __builtin_amdgcn_s_memrealtime();
#define TP_END(id) if (TPROBE < 100 && ((id) == 1 || TPROBE == (id)) && blockIdx.x == 0 && threadIdx.x == 0) { volatile LAS unsigned long long* pa_ = (volatile LAS unsigned long long*)(F.lds + MISC_OFF + 64) + ((id) == 1 ? 0 : 1); *pa_ = *pa_ + (__builtin_amdgcn_s_memrealtime() - tp0_##id); }
#else
#define TP_BEGIN(id)
#define TP_END(id)
#endif
typedef short v4i16_t __attribute__((ext_vector_type(4)));
__device__ __forceinline__ v4i16_t tr_read16(const LAS unsigned char* p) { return __builtin_amdgcn_ds_read_tr16_b64_v4i16((LAS v4i16_t*)p); }
__device__ __forceinline__ void lds_barrier() { asm volatile("s_waitcnt lgkmcnt(0)" ::: "memory"); __builtin_amdgcn_s_barrier(); asm volatile("" ::: "memory"); }
__device__ __forceinline__ float bf2f(unsigned h) { return __uint_as_float(h << 16); }
__device__ __forceinline__ float wave_sum(float v) {
#pragma unroll
    for (int o = 1; o < 64; o <<= 1) v += __shfl_xor(v, o);
    return v;
}
__device__ __forceinline__ float sigmoidf_(float a) { return __builtin_amdgcn_rcpf(1.f + __expf(-a)); }
__device__ __forceinline__ float gelu_tanh(float x) { const float y = 0.7978845608028654f * (x + 0.044715f * x * x * x); return x * __builtin_amdgcn_rcpf(1.f + __expf(-2.f * y)); }
__device__ __forceinline__ void unpack8(const v4u w, float (&f)[8]) {
    f[0] = bf2f(w.x & 0xffffu); f[1] = bf2f(w.x >> 16); f[2] = bf2f(w.y & 0xffffu); f[3] = bf2f(w.y >> 16);
    f[4] = bf2f(w.z & 0xffffu); f[5] = bf2f(w.z >> 16); f[6] = bf2f(w.w & 0xffffu); f[7] = bf2f(w.w >> 16);
}
__device__ __forceinline__ v4u pack8(const float (&f)[8]) { v4u w; w.x = pk2(f[0], f[1]); w.y = pk2(f[2], f[3]); w.z = pk2(f[4], f[5]); w.w = pk2(f[6], f[7]); return w; }

__device__ __forceinline__ void transpose_item(const float* W, int K, int N, bf16* WT, const float* gain, LAS float* scr, int item, int lane) {
    const int nblk = N / 32, kb = item / nblk, nb = item % nblk, k0 = 64 * kb, n0 = 32 * nb;
    float wv[32];
#pragma unroll
    for (int i = 0; i < 32; ++i) { const int kk = 2 * i + (lane >> 5); wv[i] = __builtin_nontemporal_load((const GAS float*)(W + (size_t)(k0 + kk) * N + n0 + (lane & 31))); }
    if (gain) {
#pragma unroll
        for (int i = 0; i < 32; ++i) wv[i] *= gain[k0 + 2 * i + (lane >> 5)]; }
#pragma unroll
    for (int i = 0; i < 32; ++i) scr[(2 * i + (lane >> 5)) * 33 + (lane & 31)] = wv[i];
    LDS_WAIT(); asm volatile("" ::: "memory");
    const int c = lane & 7;
#pragma unroll
    for (int j = 0; j < 4; ++j) { const int n = (lane >> 3) + 8 * j; const LAS float* s = scr + (8 * c) * 33 + n;
        v4u o; o.x = pk2(s[0 * 33], s[1 * 33]); o.y = pk2(s[2 * 33], s[3 * 33]); o.z = pk2(s[4 * 33], s[5 * 33]); o.w = pk2(s[6 * 33], s[7 * 33]);
        *(GAS v4u*)(WT + (size_t)(n0 + n) * K + k0 + 8 * c) = o; }
    LDS_WAIT(); asm volatile("" ::: "memory");
}
__device__ __forceinline__ void prep_weights(Frame& F, int l, int part, int wg0, int nwg) {
    LAS float* scr = (LAS float*)(F.lds + RING_OFF + F.wave * 16384);
    if (F.vcu < wg0 || F.vcu >= wg0 + nwg) return;
    const int gw = (F.vcu - wg0) * NWAVES + F.wave, NGW = nwg * NWAVES;
    const bool even = (l & 1) == 0; const int li = l >> 1, Nin = even ? EVEN_IN : ODD_IN;
    const float* Win = even ? F.in[I_WINE] + (size_t)li * DM * EVEN_IN : F.in[I_WINO] + (size_t)li * DM * ODD_IN;
    const float* Wout = (even ? F.in[I_WOUTE] : F.in[I_WOUTO]) + (size_t)li * DM * DM;
    const float* W1 = F.in[I_W1] + (size_t)l * DM * FF; const float* W2 = F.in[I_W2] + (size_t)l * FF * DM;
    const float* gmix = F.in[I_NMIX] + l * DM; const float* gmlp = F.in[I_NMLP] + l * DM;
    const int I_IN = (DM / 64) * (Nin / 32), I_OUT = (DM / 64) * (DM / 32), I_1 = (DM / 64) * (FF / 32), I_2 = (FF / 64) * (DM / 32);
    if (part == 0) { for (int it = gw; it < I_IN; it += NGW) transpose_item(Win, DM, Nin, F_WIN, gmix, scr, it, F.lane); return; }
    const int NITEMS = I_OUT + I_1 + I_2;
    for (int it = gw; it < NITEMS; it += NGW) {
        int r = it;
        if (r < I_OUT) { transpose_item(Wout, DM, DM, F_WOUT, nullptr, scr, r, F.lane); continue; } r -= I_OUT;
        if (r < I_1) { transpose_item(W1, DM, FF, F_W1, gmlp, scr, r, F.lane); continue; } r -= I_1;
        transpose_item(W2, FF, DM, F_W2, nullptr, scr, r, F.lane);
    }
}
constexpr size_t WS_XB = 220 * MiB;
constexpr size_t WS_SSA = 252 * MiB, WS_SSB = 253 * MiB;
#define F_XB ((bf16*)(F.ws + WS_XB))
constexpr int RST_OFF = RING_BYTES + 1024;
__device__ __forceinline__ void x_to_bf16(Frame& F, const float* src) {
    const int gw = F.vcu * NWAVES + F.wave, NGW = F.G * NWAVES; float* ss = (float*)(F.ws + WS_SSB);
    for (int m = gw; m < M; m += NGW) {
        const GAS f32x4* xr = (const GAS f32x4*)(src + (size_t)m * DM) + F.lane;
        f32x4 v[4]; float s = 0.f;
#pragma unroll
        for (int j = 0; j < 4; ++j) { v[j] = xr[64 * j]; s += (v[j].x * v[j].x + v[j].y * v[j].y) + (v[j].z * v[j].z + v[j].w * v[j].w); }
        s = wave_sum(s); if (F.lane < 16) ss[(size_t)m * 16 + F.lane] = (F.lane == 0) ? s : 0.f;
        GAS u64* o8 = (GAS u64*)(F_XB + (size_t)m * DM) + F.lane;
#pragma unroll
        for (int j = 0; j < 4; ++j) o8[64 * j] = (u64)pk2(v[j].x, v[j].y) | ((u64)pk2(v[j].z, v[j].w) << 32);
    }
}
template <class Sched>
__device__ __forceinline__ void fill_rstd(Frame& F, const Sched& S, const float* ss) {
    LAS float* rst = (LAS float*)(F.lds + RST_OFF); LAS int* pmt = (LAS int*)(F.lds + RST_OFF + 4096);
    const int r = F.tid & 255, half = F.tid >> 8;
#pragma unroll
    for (int j = 0; j < 2; ++j) { const int i = 2 * j + half; pg8::Unit u; const bool ok = S.next(i, u);
        if (ok) { const GAS f32x4* p = (const GAS f32x4*)(ss + (size_t)(u.pm * 256 + r) * 16); const f32x4 a = p[0], b = p[1], c = p[2], d = p[3];
            const float t = ((a[0] + a[1]) + (a[2] + a[3])) + ((b[0] + b[1]) + (b[2] + b[3])) + ((c[0] + c[1]) + (c[2] + c[3])) + ((d[0] + d[1]) + (d[2] + d[3]));
            rst[i * 256 + r] = __builtin_amdgcn_rsqf(t * (1.f / DM) + EPS); }
        if (r == 0) pmt[i] = ok ? u.pm : -1; }
    asm volatile("s_waitcnt vmcnt(0) lgkmcnt(0)" ::: "memory"); __syncthreads();
}

__device__ __forceinline__ void sgu_naive_unit(Frame& F, int e, int unit) {
    const int h = unit & 3, n = (unit >> 2) & 31, b = unit >> 7; const int row0 = b * SEQ + n * 128;
    LAS float* vn = (LAS float*)F.lds;
    const bf16* Y = F_Y; const int tid = F.tid;
    { const int q = tid >> 2, part = tid & 3; const bf16* vp = Y + (size_t)(row0 + q) * EVEN_IN + 512 + h * 128 + part * 32;
      float g[32]; float ss = 0.f;
#pragma unroll
      for (int i = 0; i < 4; ++i) { float f8[8]; unpack8(*(const GAS v4u*)(vp + 8 * i), f8);
#pragma unroll
          for (int j = 0; j < 8; ++j) { const float x = gelu_tanh(f8[j]); g[8 * i + j] = x; ss += x * x; } }
      ss += __shfl_xor(ss, 1); ss += __shfl_xor(ss, 2);
      const float r = __builtin_amdgcn_rsqf(ss * (1.f / 128.f) + EPS); const float* ng = F.in[I_SGUG] + e * 512 + h * 128 + part * 32;
#pragma unroll
      for (int i = 0; i < 32; ++i) vn[q * 129 + part * 32 + i] = g[i] * r * ng[i];
    }
    __syncthreads();
    { const int c = tid & 127, pq = __builtin_amdgcn_readfirstlane(tid >> 7); const float* Ws = F.in[I_SGUW] + (size_t)((e * 4 + h) * 128) * 128; const float* bs = F.in[I_SGUB] + (e * 4 + h) * 128;
      for (int pp = 0; pp < 32; ++pp) { const int p = pq * 32 + pp; const float* wr = Ws + p * 128; float acc = 0.f;
#pragma unroll 8
          for (int q = 0; q < 128; ++q) acc += wr[q] * vn[q * 129 + c];
          const float u = bf2f(Y[(size_t)(row0 + p) * EVEN_IN + h * 128 + c]);
          F_MIX[(size_t)(row0 + p) * DM + h * 128 + c] = (bf16)f2bf(gelu_tanh(u) * (acc + bs[p])); }
    }
    __syncthreads();
}
__device__ __forceinline__ void hgrn_naive(Frame& F, int e, int bh) {
    const int b = bh >> 2, h = bh & 3, tid = F.tid, kq = __builtin_amdgcn_readfirstlane(tid >> 7), v = tid & 127;
    LAS float* red = (LAS float*)F.lds;
    const bf16* Y = F_Y; float* OF = (float*)(F.ws + WS_XN);
    const float* lbl = F.in[I_LBL]; const float* ng = F.in[I_HNG] + e * 512;
    for (int z = 0; z < 2; ++z) {
        float lbv[32], S[32];
#pragma unroll
        for (int k = 0; k < 32; ++k) { const int ch = h * 128 + kq * 32 + k; S[k] = 0.f;
            if (e == 0) lbv[k] = 0.f; else { const float L0 = lbl[(z * 2 + 0) * 512 + ch], L1 = lbl[(z * 2 + 1) * 512 + ch]; lbv[k] = 1.f / (1.f + expf(L0 - L1)); } }
        for (int step = 0; step < SEQ; ++step) {
            const int pos = z ? SEQ - 1 - step : step; const size_t row = (size_t)b * SEQ + pos; const bf16* yr = Y + row * EVEN_IN;
            const float vi = bf2f(yr[1536 + h * 128 + v]); float part = 0.f;
#pragma unroll
            for (int i = 0; i < 4; ++i) { float a8[8], q8[8]; unpack8(*(const GAS v4u*)(yr + 2560 + z * 512 + h * 128 + kq * 32 + 8 * i), a8); unpack8(*(const GAS v4u*)(yr + 1024 + h * 128 + kq * 32 + 8 * i), q8);
#pragma unroll
                for (int j = 0; j < 8; ++j) { const int k = 8 * i + j; const float sg = sigmoidf_(a8[j]); const float f = lbv[k] + (1.f - lbv[k]) * sg, kk = (1.f - lbv[k]) * (1.f - sg);
                    S[k] = f * S[k] + kk * vi; part += q8[j] * S[k]; } }
            red[kq * 128 + v] = part; __syncthreads();
            float o = 0.f;
            if (kq == 0) { o = (red[v] + red[128 + v]) + (red[256 + v] + red[384 + v]);
                if (z == 0) OF[row * 512 + h * 128 + v] = o;
                else { o += OF[row * 512 + h * 128 + v]; const float ss = wave_sum(o * o); if (F.lane == 0) red[512 + F.wave] = ss; } }
            __syncthreads();
            if (z == 1 && kq == 0) { const float tot = red[512] + red[513]; const float r = __builtin_amdgcn_rsqf(tot * (1.f / 128.f) + EPS); const float gv = bf2f(yr[2048 + h * 128 + v]);
                F_MIX[row * DM + 512 + h * 128 + v] = (bf16)f2bf(o * r * ng[h * 128 + v] * gv * sigmoidf_(gv)); }
            __syncthreads();
        }
    }
}
__device__ __forceinline__ void conv_phase(Frame& F, int o) {
    const int gt = F.vcu * (NWAVES * 64) + F.tid, NT = F.G * NWAVES * 64; const float* cw = F.in[I_CONVW] + o * 3 * 512;
    for (int idx = gt; idx < (M / 4) * 64; idx += NT) { const int t0 = (idx >> 6) * 4, c = (idx & 63) * 8, pos0 = t0 & (SEQ - 1); const bf16* yr = F_Y + (size_t)t0 * ODD_IN;
        v4u hr[6], cr[6], br[4];
#pragma unroll
        for (int r = 0; r < 6; ++r) { const bool ok = (pos0 + r - 1 >= 0) && (pos0 + r - 1 < SEQ); const bf16* rp = yr + (ptrdiff_t)(ok ? r - 1 : 0) * ODD_IN; hr[r] = *(const GAS v4u*)(rp + c); cr[r] = *(const GAS v4u*)(rp + 1024 + c); }
#pragma unroll
        for (int r = 0; r < 4; ++r) br[r] = *(const GAS v4u*)(yr + (size_t)r * ODD_IN + 512 + c);
        float w0[8], w1[8], w2[8];
#pragma unroll
        for (int j = 0; j < 8; ++j) { w0[j] = cw[c + j]; w1[j] = cw[512 + c + j]; w2[j] = cw[1024 + c + j]; }
        float z[6][8];
#pragma unroll
        for (int r = 0; r < 6; ++r) { const bool ok = (pos0 + r - 1 >= 0) && (pos0 + r - 1 < SEQ); float hh[8], cg[8]; unpack8(hr[r], hh); unpack8(cr[r], cg);
#pragma unroll
            for (int j = 0; j < 8; ++j) z[r][j] = ok ? hh[j] * cg[j] : 0.f; }
#pragma unroll
        for (int r = 0; r < 4; ++r) { float bg[8], r8[8]; unpack8(br[r], bg);
#pragma unroll
            for (int j = 0; j < 8; ++j) r8[j] = bg[j] * (w0[j] * z[r][j] + w1[j] * z[r + 1][j] + w2[j] * z[r + 2][j]);
            *(GAS v4u*)(F_MIX + (size_t)(t0 + r) * DM + c) = pack8(r8); } }
}
__device__ __forceinline__ void qk_prep_phase(Frame& F, int o) {
    const int gw = F.vcu * NWAVES + F.wave, NGW = F.G * NWAVES, lane = F.lane;
    bf16* QR = (bf16*)(F.ws + WS_XN); bf16* KR = QR + (size_t)M * 512;
    const int d0 = (lane & 7) * 8; const bool hi = d0 >= 32;
    double inv[8];
#pragma unroll
    for (int j = 0; j < 8; ++j) inv[j] = ROPE_TURNS[(d0 + j) & 31];
    float gq[8], gk[8];
#pragma unroll
    for (int j = 0; j < 8; ++j) { gq[j] = F.in[I_QG][o * 64 + d0 + j]; gk[j] = F.in[I_KG][o * 64 + d0 + j]; }
    for (int it0 = gw * 4; it0 < 2 * M; it0 += NGW * 4) {
        v4u raw[4];
#pragma unroll
        for (int u = 0; u < 4; ++u) { const int it = it0 + u, t = it >> 1, which = it & 1; raw[u] = *(const GAS v4u*)(F_Y + (size_t)t * ODD_IN + 1536 + which * 512 + lane * 8); }
#pragma unroll
        for (int u = 0; u < 4; ++u) { const int it = it0 + u, t = it >> 1, which = it & 1, pos = t & (SEQ - 1);
            float x[8]; unpack8(raw[u], x); float ss = 0.f;
#pragma unroll
            for (int j = 0; j < 8; ++j) ss += x[j] * x[j];
            ss += __shfl_xor(ss, 1); ss += __shfl_xor(ss, 2); ss += __shfl_xor(ss, 4);
            const float r = __builtin_amdgcn_rsqf(ss * (1.f / 64.f) + EPS); const float sc = which ? 1.f : 0.125f * LOG2E; float y[8];
#pragma unroll
            for (int j = 0; j < 8; ++j) { x[j] = x[j] * r * (which ? gk[j] : gq[j]); const float p = __shfl_xor(x[j], 4); double tt = (double)pos * inv[j]; tt -= floor(tt); const float tf = (float)tt; const float cs = __builtin_amdgcn_cosf(tf), sn = __builtin_amdgcn_sinf(tf);
                y[j] = (hi ? (x[j] * cs + p * sn) : (x[j] * cs - p * sn)) * sc; }
            *(GAS v4u*)((which ? KR : QR) + (size_t)t * 512 + lane * 8) = pack8(y); }
    }
}
constexpr size_t WS_VT = WS_Y + 96 * MiB;
__device__ __forceinline__ void vt_phase(Frame& F) {
    LAS unsigned short* T = (LAS unsigned short*)F.lds;
    const int tid = F.tid;
    for (int it = F.vcu; it < 16 * 64; it += F.G) { const int bh = it >> 6, tt = it & 63, b = bh >> 2, h = bh & 3; const size_t tok0 = (size_t)b * SEQ + tt * 64;
        lds_barrier();
#pragma unroll
        for (int i = 0; i < 2; ++i) { const int idx = tid + 512 * i, row = idx >> 4, c16 = idx & 15; const v4u w = *(const GAS v4u*)(F_Y + (tok0 + row) * ODD_IN + 2560 + h * 128 + c16 * 8);
            LAS unsigned* d = (LAS unsigned*)(T + row * 130 + c16 * 8); d[0] = w.x; d[1] = w.y; d[2] = w.z; d[3] = w.w; }
        lds_barrier();
        { const int dv = tid >> 2, part = tid & 3;
          unsigned short v[16];
#pragma unroll
          for (int sl = 0; sl < 16; ++sl) { const int hi_ = sl >> 3, j = sl & 7; const int key = 16 * part + (j & 3) + 8 * (j >> 2) + 4 * hi_; v[sl] = T[key * 130 + dv]; }
          v4u o0, o1; o0.x = v[0] | ((unsigned)v[1] << 16); o0.y = v[2] | ((unsigned)v[3] << 16); o0.z = v[4] | ((unsigned)v[5] << 16); o0.w = v[6] | ((unsigned)v[7] << 16);
          o1.x = v[8] | ((unsigned)v[9] << 16); o1.y = v[10] | ((unsigned)v[11] << 16); o1.z = v[12] | ((unsigned)v[13] << 16); o1.w = v[14] | ((unsigned)v[15] << 16);
          bf16* dst = (bf16*)(F.ws + WS_VT) + ((size_t)(bh * 128 + dv)) * SEQ + tt * 64 + 16 * part;
          *(GAS v4u*)dst = o0; *(GAS v4u*)(dst + 8) = o1; }
    }
    lds_barrier();
}
__device__ __forceinline__ void attn_naive_unit(Frame& F, int o, int l_layer, int unit) {
    const int qb = unit & 31, h = (unit >> 5) & 3, b = unit >> 7, tid = F.tid; const int r = tid & 127, c = (tid >> 7) & 1, half = tid >> 8; const int qrow = b * SEQ + qb * 128 + r;
    const bf16* QR = (const bf16*)(F.ws + WS_XN); const bf16* KR = QR + (size_t)M * 512; const bf16* Y = F_Y;
    LAS float* Kt = (LAS float*)F.lds; LAS float* Vt = Kt + 64 * 128; LAS float* red = Vt + 64 * 128;
    float mq = 0.f, mk = 0.f, d1 = 0.f, d2 = 0.f;
    for (int i = 0; i < 64; ++i) { mq = fmaxf(mq, fabsf(F.in[I_QG][o * 64 + i])); mk = fmaxf(mk, fabsf(F.in[I_KG][o * 64 + i])); d1 += F.in[I_LQ1][o * 64 + i] * F.in[I_LK1][o * 64 + i]; d2 += F.in[I_LQ2][o * 64 + i] * F.in[I_LK2][o * 64 + i]; }
    const float linit = 0.8f - 0.6f * expf(-0.3f * (float)l_layer); const float lam = expf(d1) - expf(d2) + linit;
    const float m2 = 8.f * mq * mk * LOG2E;
    float q[64], O[64]; float l = 0.f;
    { const bf16* qp = QR + (size_t)qrow * 512 + h * 128 + c * 64;
#pragma unroll
      for (int i = 0; i < 8; ++i) { float f8[8]; unpack8(*(const GAS v4u*)(qp + 8 * i), f8);
#pragma unroll
          for (int j = 0; j < 8; ++j) q[8 * i + j] = f8[j]; } }
#pragma unroll
    for (int i = 0; i < 64; ++i) O[i] = 0.f;
    for (int kt = 0; kt < SEQ / 64; ++kt) {
        __syncthreads();
        { const int rr = tid >> 3, ch = tid & 7; const size_t krow = (size_t)b * SEQ + kt * 64 + rr; float f8[8];
#pragma unroll
          for (int hh = 0; hh < 2; ++hh) { unpack8(*(const GAS v4u*)(KR + krow * 512 + h * 128 + hh * 64 + ch * 8), f8);
#pragma unroll
              for (int j = 0; j < 8; ++j) Kt[rr * 128 + hh * 64 + ch * 8 + j] = f8[j];
              unpack8(*(const GAS v4u*)(Y + krow * ODD_IN + 2560 + h * 128 + hh * 64 + ch * 8), f8);
#pragma unroll
              for (int j = 0; j < 8; ++j) Vt[rr * 128 + hh * 64 + ch * 8 + j] = f8[j]; } }
        __syncthreads();
        for (int j = 0; j < 64; ++j) { float s = -m2;
#pragma unroll
            for (int d = 0; d < 64; d += 4) { const f32x4 kv = *(const LAS f32x4*)(Kt + j * 128 + c * 64 + d); s += q[d] * kv.x + q[d + 1] * kv.y + q[d + 2] * kv.z + q[d + 3] * kv.w; }
            const float p = exp2f(s); l += p;
#pragma unroll
            for (int d = 0; d < 64; d += 4) { const f32x4 vv = *(const LAS f32x4*)(Vt + j * 128 + half * 64 + d); O[d] += p * vv.x; O[d + 1] += p * vv.y; O[d + 2] += p * vv.z; O[d + 3] += p * vv.w; } }
    }
    __syncthreads();
    const float il = (c ? lam : 1.f) / l;
    if (c == 1) {
#pragma unroll
        for (int i = 0; i < 64; ++i) Kt[(half * 64 + i) * 128 + r] = O[i] * il; }
    __syncthreads();
    float ss = 0.f;
    if (c == 0) {
#pragma unroll
        for (int i = 0; i < 64; ++i) { O[i] = O[i] * il - Kt[(half * 64 + i) * 128 + r]; ss += O[i] * O[i]; }
        red[half * 128 + r] = ss; }
    __syncthreads();
    if (c == 0) { const float tot = red[r] + red[128 + r]; const float rr = (1.f - linit) * __builtin_amdgcn_rsqf(tot * (1.f / 128.f) + EPS); const float* sg = F.in[I_DNG] + o * 128 + half * 64;
        bf16* op = F_MIX + (size_t)qrow * DM + 512 + h * 128 + half * 64;
#pragma unroll
        for (int i = 0; i < 8; ++i) { float f8[8];
#pragma unroll
            for (int j = 0; j < 8; ++j) f8[j] = O[8 * i + j] * rr * sg[8 * i + j];
            *(GAS v4u*)(op + 8 * i) = pack8(f8); } }
    __syncthreads();
}
typedef float f32x16 __attribute__((ext_vector_type(16)));
constexpr size_t WS_APARK = WS_Y + 112 * MiB;
__device__ __forceinline__ void attn_params(Frame& F, int o, int l_layer, float& m2, float& lam, float& linit) {
    float mq = 0.f, mk = 0.f, d1 = 0.f, d2 = 0.f;
    for (int i = 0; i < 64; ++i) { mq = fmaxf(mq, fabsf(F.in[I_QG][o * 64 + i])); mk = fmaxf(mk, fabsf(F.in[I_KG][o * 64 + i])); d1 += F.in[I_LQ1][o * 64 + i] * F.in[I_LK1][o * 64 + i]; d2 += F.in[I_LQ2][o * 64 + i] * F.in[I_LK2][o * 64 + i]; }
    linit = 0.8f - 0.6f * expf(-0.3f * (float)l_layer); lam = expf(d1) - expf(d2) + linit; m2 = 8.f * mq * mk * LOG2E;
}
__device__ __forceinline__ int attn_lane(const Frame& F) { int t = F.tid; asm volatile("" : "+v"(t)); return t & 63; }
#define ATT_SB() __builtin_amdgcn_sched_barrier(0)
#define ATT_EXP4(P, i) do { P[4 * (i)] = __builtin_amdgcn_exp2f(P[4 * (i)]); P[4 * (i) + 1] = __builtin_amdgcn_exp2f(P[4 * (i) + 1]); P[4 * (i) + 2] = __builtin_amdgcn_exp2f(P[4 * (i) + 2]); P[4 * (i) + 3] = __builtin_amdgcn_exp2f(P[4 * (i) + 3]); } while (0)
#define ATT_ADD4(acc, P, i) do { acc += P[4 * (i)]; acc += P[4 * (i) + 1]; acc += P[4 * (i) + 2]; acc += P[4 * (i) + 3]; } while (0)
#define ATT_PIN() asm volatile("" : "+v"(N0), "+v"(N1), "+v"(O[0]), "+v"(O[1]), "+v"(O[2]), "+v"(O[3]), "+v"(l0), "+v"(l1), "+v"(pa[0]), "+v"(pa[1]), "+v"(pa[2]), "+v"(pa[3]))
#define ATT_CVT8(dst, P, q) do { v4u w_; w_.x = pg8::cvt_pk_bf16(P[8 * (q) + 0], P[8 * (q) + 1]); w_.y = pg8::cvt_pk_bf16(P[8 * (q) + 2], P[8 * (q) + 3]); w_.z = pg8::cvt_pk_bf16(P[8 * (q) + 4], P[8 * (q) + 5]); w_.w = pg8::cvt_pk_bf16(P[8 * (q) + 6], P[8 * (q) + 7]); dst = __builtin_bit_cast(bf16x8, w_); } while (0)
#define ATT_MFMA(a, b, c) __builtin_amdgcn_mfma_f32_32x32x16_bf16(a, b, c, 0, 0, 0)
template <class Dma>
__device__ __forceinline__ void attn_step(const LAS unsigned char* Kn, const LAS unsigned char* Vt, const int (&kofs)[4], const bf16x8 (&qf)[4], const f32x16& cm2, float& l0, float& l1,
                                          f32x16 (&O)[4], bf16x8 (&pa)[4], const Dma& dma) {
    bf16x8 kf0[4], kf1[4], va[4], vb[4];
#pragma unroll
    for (int ds = 0; ds < 4; ++ds) kf0[ds] = *(const LAS bf16x8*)(Kn + kofs[ds]);
#pragma unroll
    for (int ds = 0; ds < 4; ++ds) kf1[ds] = *(const LAS bf16x8*)(Kn + 4096 + kofs[ds]);
    f32x16 N0, N1;
    N0 = ATT_MFMA(kf0[0], qf[0], cm2);
    N0 = ATT_MFMA(kf0[1], qf[1], N0);
    N0 = ATT_MFMA(kf0[2], qf[2], N0);
    N0 = ATT_MFMA(kf0[3], qf[3], N0);
    N1 = ATT_MFMA(kf1[0], qf[0], cm2);
#pragma unroll
    for (int db = 0; db < 4; ++db) va[db] = *(const LAS bf16x8*)(Vt + db * 4096 + kofs[0]);
    ATT_PIN();
    N1 = ATT_MFMA(kf1[1], qf[1], N1); ATT_EXP4(N0, 0); ATT_PIN();
    N1 = ATT_MFMA(kf1[2], qf[2], N1); ATT_EXP4(N0, 1); ATT_PIN();
    N1 = ATT_MFMA(kf1[3], qf[3], N1); ATT_EXP4(N0, 2); ATT_PIN();
    dma();
    O[0] = ATT_MFMA(va[0], pa[0], O[0]);
#pragma unroll
    for (int db = 0; db < 4; ++db) vb[db] = *(const LAS bf16x8*)(Vt + db * 4096 + kofs[1]);
    ATT_EXP4(N0, 3); ATT_PIN();
    O[1] = ATT_MFMA(va[1], pa[0], O[1]); ATT_EXP4(N1, 0); ATT_PIN();
    O[2] = ATT_MFMA(va[2], pa[0], O[2]); ATT_EXP4(N1, 1); ATT_PIN();
    O[3] = ATT_MFMA(va[3], pa[0], O[3]);
#pragma unroll
    for (int db = 0; db < 4; ++db) va[db] = *(const LAS bf16x8*)(Vt + db * 4096 + kofs[2]);
    ATT_ADD4(l0, N0, 0); ATT_ADD4(l0, N0, 1); ATT_PIN();
    O[0] = ATT_MFMA(vb[0], pa[1], O[0]); ATT_EXP4(N1, 2); ATT_PIN();
    O[1] = ATT_MFMA(vb[1], pa[1], O[1]); ATT_EXP4(N1, 3); ATT_PIN();
    O[2] = ATT_MFMA(vb[2], pa[1], O[2]); ATT_CVT8(pa[0], N0, 0); ATT_ADD4(l0, N0, 2); ATT_PIN();
    O[3] = ATT_MFMA(vb[3], pa[1], O[3]);
#pragma unroll
    for (int db = 0; db < 4; ++db) vb[db] = *(const LAS bf16x8*)(Vt + db * 4096 + kofs[3]);
    ATT_ADD4(l0, N0, 3); ATT_PIN();
    O[0] = ATT_MFMA(va[0], pa[2], O[0]); ATT_CVT8(pa[1], N0, 1); ATT_PIN();
    O[1] = ATT_MFMA(va[1], pa[2], O[1]); ATT_ADD4(l1, N1, 0); ATT_ADD4(l1, N1, 1); ATT_PIN();
    O[2] = ATT_MFMA(va[2], pa[2], O[2]); ATT_ADD4(l1, N1, 2); ATT_ADD4(l1, N1, 3); ATT_PIN();
    O[3] = ATT_MFMA(va[3], pa[2], O[3]); ATT_PIN();
    O[0] = ATT_MFMA(vb[0], pa[3], O[0]); ATT_CVT8(pa[2], N1, 0); ATT_PIN();
    O[1] = ATT_MFMA(vb[1], pa[3], O[1]); ATT_PIN();
    O[2] = ATT_MFMA(vb[2], pa[3], O[2]); ATT_PIN();
    O[3] = ATT_MFMA(vb[3], pa[3], O[3]); ATT_PIN();
    ATT_CVT8(pa[3], N1, 1);
}
__device__ __forceinline__ void attn_step_last(const LAS unsigned char* Vt, const int (&kofs)[4], f32x16 (&O)[4], const bf16x8 (&pa)[4]) {
    bf16x8 va[4], vb[4];
#pragma unroll
    for (int db = 0; db < 4; ++db) va[db] = *(const LAS bf16x8*)(Vt + db * 4096 + kofs[0]);
#pragma unroll
    for (int db = 0; db < 4; ++db) vb[db] = *(const LAS bf16x8*)(Vt + db * 4096 + kofs[1]);
    ATT_SB();
#pragma unroll
    for (int db = 0; db < 4; ++db) O[db] = ATT_MFMA(va[db], pa[0], O[db]);
#pragma unroll
    for (int db = 0; db < 4; ++db) va[db] = *(const LAS bf16x8*)(Vt + db * 4096 + kofs[2]);
    ATT_SB();
#pragma unroll
    for (int db = 0; db < 4; ++db) O[db] = ATT_MFMA(vb[db], pa[1], O[db]);
#pragma unroll
    for (int db = 0; db < 4; ++db) vb[db] = *(const LAS bf16x8*)(Vt + db * 4096 + kofs[3]);
    ATT_SB();
#pragma unroll
    for (int db = 0; db < 4; ++db) O[db] = ATT_MFMA(va[db], pa[2], O[db]);
#pragma unroll
    for (int db = 0; db < 4; ++db) O[db] = ATT_MFMA(vb[db], pa[3], O[db]);
    ATT_SB();
}
__device__ __forceinline__ void attn_pass32(Frame& F, int b, int h, int c, int row0, float m2, f32x16 (&O)[4], float& l) {
    const int lane = attn_lane(F), wave = F.wave, r32 = lane & 31, hi = lane >> 5;
    const bf16* QR = (const bf16*)(F.ws + WS_XN); const bf16* KR = QR + (size_t)M * 512;
    LAS unsigned char* Kb = F.lds; LAS unsigned char* Vb = F.lds + 32768;
    bf16x8 qf[4];
#pragma unroll
    for (int ds = 0; ds < 4; ++ds) qf[ds] = *(const GAS bf16x8*)(QR + (size_t)(row0 + r32) * 512 + h * 128 + c * 64 + ds * 16 + hi * 8);
#pragma unroll
    for (int db = 0; db < 4; ++db)
#pragma unroll
        for (int r = 0; r < 16; ++r) O[db][r] = 0.f;
    const int kr = 8 * wave + (lane >> 3), cs = lane & 7;
    const char* ksrc = (const char*)(KR + (size_t)(b * SEQ + kr) * 512 + h * 128 + c * 64 + ((cs ^ ((kr >> 1) & 7)) * 8));
    const char* vsrc[2];
#pragma unroll
    for (int i = 0; i < 2; ++i) { const int vr = 16 * wave + 8 * i + (lane >> 3); vsrc[i] = (const char*)((const bf16*)(F.ws + WS_VT) + ((size_t)((b * 4 + h) * 128 + vr)) * SEQ + ((cs ^ ((vr >> 1) & 7)) * 8)); }
    const unsigned kdst = (unsigned)(size_t)(Kb + wave * 1024), vdst = (unsigned)(size_t)(Vb + wave * 2048);
#define ATT_GLDS(gsrc, ldsdst) do { unsigned keep_; asm volatile("s_mov_b32 %0, m0\n\ts_mov_b32 m0, %2\n\ts_nop 0\n\tglobal_load_lds_dwordx4 %1, off\n\ts_mov_b32 m0, %0" : "=&s"(keep_) : "v"(gsrc), "s"(ldsdst) : "memory"); } while (0)
#define ATT_DMA(t, slot) do { ATT_GLDS(ksrc + (size_t)(t) * (64 * 512 * 2), (unsigned)__builtin_amdgcn_readfirstlane(kdst + (slot) * 8192)); \
        ATT_GLDS(vsrc[0] + (size_t)(t) * (64 * 2), (unsigned)__builtin_amdgcn_readfirstlane(vdst + (slot) * 16384)); ATT_GLDS(vsrc[1] + (size_t)(t) * (64 * 2), (unsigned)__builtin_amdgcn_readfirstlane(vdst + (slot) * 16384 + 1024)); } while (0)
    asm volatile("s_waitcnt vmcnt(0)" : "+v"(qf[0]), "+v"(qf[1]), "+v"(qf[2]), "+v"(qf[3]) :: "memory");
    ATT_DMA(0, 0); ATT_DMA(1, 1); ATT_DMA(2, 2);
    int kofs[4];
#pragma unroll
    for (int i = 0; i < 4; ++i) kofs[i] = r32 * 128 + (((2 * i + hi) ^ ((r32 >> 1) & 7)) << 4);
    f32x16 cm2;
#pragma unroll
    for (int r = 0; r < 16; ++r) cm2[r] = -m2;
    asm volatile("s_waitcnt vmcnt(6)" ::: "memory"); __builtin_amdgcn_s_barrier(); asm volatile("" ::: "memory");
    bf16x8 pa[4]; float l0 = 0.f, l1 = 0.f;
    { bf16x8 kf[2][4]; f32x16 P0, P1;
#pragma unroll
      for (int kh = 0; kh < 2; ++kh)
#pragma unroll
          for (int ds = 0; ds < 4; ++ds) kf[kh][ds] = *(const LAS bf16x8*)(Kb + kh * 4096 + kofs[ds]);
      P0 = ATT_MFMA(kf[0][0], qf[0], cm2); P1 = ATT_MFMA(kf[1][0], qf[0], cm2);
#pragma unroll
      for (int ds = 1; ds < 4; ++ds) { P0 = ATT_MFMA(kf[0][ds], qf[ds], P0); P1 = ATT_MFMA(kf[1][ds], qf[ds], P1); }
#pragma unroll
      for (int i = 0; i < 4; ++i) { ATT_EXP4(P0, i); ATT_EXP4(P1, i); }
#pragma unroll
      for (int i = 0; i < 4; ++i) { ATT_ADD4(l0, P0, i); ATT_ADD4(l1, P1, i); }
      ATT_CVT8(pa[0], P0, 0); ATT_CVT8(pa[1], P0, 1); ATT_CVT8(pa[2], P1, 0); ATT_CVT8(pa[3], P1, 1); }
    asm volatile("s_waitcnt vmcnt(5) lgkmcnt(0)" ::: "memory"); __builtin_amdgcn_s_barrier(); asm volatile("" ::: "memory");
    int cur = 0, nxt1 = 1, nxt3 = 3;
    for (int kt = 0; kt < SEQ / 64 - 1; ++kt) {
        const int left = SEQ / 64 - 1 - kt;
        attn_step(Kb + nxt1 * 8192, Vb + cur * 16384, kofs, qf, cm2, l0, l1, O, pa, [&]() { if (left >= 3) ATT_DMA(kt + 3, nxt3); });
        if (left >= 3) asm volatile("s_waitcnt vmcnt(5) lgkmcnt(0)" ::: "memory"); else if (left == 2) asm volatile("s_waitcnt vmcnt(2) lgkmcnt(0)" ::: "memory"); else asm volatile("s_waitcnt vmcnt(0) lgkmcnt(0)" ::: "memory");
        __builtin_amdgcn_s_barrier(); asm volatile("" ::: "memory");
        nxt3 = cur; cur = nxt1; nxt1 = (nxt1 + 1) & 3;
    }
    attn_step_last(Vb + cur * 16384, kofs, O, pa);
    l = l0 + l1;
    asm volatile("s_waitcnt lgkmcnt(0)" ::: "memory"); __builtin_amdgcn_s_barrier(); asm volatile("" ::: "memory");
#undef ATT_DMA
#undef ATT_GLDS
}
__device__ __forceinline__ void attn_unit(Frame& F, int o, int unit, float m2, float lam, float linit) {
    TP_BEGIN(23)
    const int qb = unit & 15, h = (unit >> 4) & 3, b = unit >> 6;
    const int wave = F.wave;
    const int row0 = b * SEQ + qb * 256 + wave * 32;
    f32x16 O[4]; float l;
    attn_pass32(F, b, h, 0, row0, m2, O, l);
    { v4u* park = (v4u*)(F.ws + WS_APARK) + ((size_t)unit * NWAVES + wave) * 8 * 64 + attn_lane(F);
      l += __shfl_xor(l, 32); const float il = __builtin_amdgcn_rcpf(l);
#pragma unroll
      for (int db = 0; db < 4; ++db)
#pragma unroll
          for (int i = 0; i < 2; ++i) { v4u w; w.x = pg8::cvt_pk_bf16(O[db][8 * i] * il, O[db][8 * i + 1] * il); w.y = pg8::cvt_pk_bf16(O[db][8 * i + 2] * il, O[db][8 * i + 3] * il);
              w.z = pg8::cvt_pk_bf16(O[db][8 * i + 4] * il, O[db][8 * i + 5] * il); w.w = pg8::cvt_pk_bf16(O[db][8 * i + 6] * il, O[db][8 * i + 7] * il); *(GAS v4u*)(park + (2 * db + i) * 64) = w; } }
    attn_pass32(F, b, h, 1, row0, m2, O, l);
    const int lane = attn_lane(F), r32 = lane & 31, hi = lane >> 5;
    const v4u* park = (const v4u*)(F.ws + WS_APARK) + ((size_t)unit * NWAVES + wave) * 8 * 64 + lane;
    v4u pk[8];
#pragma unroll
    for (int i = 0; i < 8; ++i) pk[i] = *(const GAS v4u*)(park + i * 64);
    l += __shfl_xor(l, 32); const float il1 = lam * __builtin_amdgcn_rcpf(l);
    float ss = 0.f;
#pragma unroll
    for (int db = 0; db < 4; ++db)
#pragma unroll
        for (int i = 0; i < 2; ++i) { const v4u w4 = pk[2 * db + i];
#pragma unroll
            for (int j = 0; j < 4; ++j) { const unsigned w = w4[j]; const int r = 8 * i + 2 * j; const float a0 = __uint_as_float(w << 16) - O[db][r] * il1, a1 = __uint_as_float(w & 0xffff0000u) - O[db][r + 1] * il1; O[db][r] = a0; O[db][r + 1] = a1; ss += a0 * a0 + a1 * a1; } }
    ss += __shfl_xor(ss, 32);
    const float rr = (1.f - linit) * __builtin_amdgcn_rsqf(ss * (1.f / 128.f) + EPS);
    const float* sg = F.in[I_DNG] + o * 128;
    bf16* op = F_MIX + (size_t)(row0 + r32) * DM + 512 + h * 128;
    typedef unsigned u32x2 __attribute__((ext_vector_type(2)));
#pragma unroll
    for (int db = 0; db < 4; ++db)
#pragma unroll
        for (int i = 0; i < 4; ++i) { const int dv = 32 * db + 8 * i + 4 * hi; const f32x4 g4 = *(const GAS f32x4*)(sg + dv);
            u32x2 w; w.x = pg8::cvt_pk_bf16(O[db][4 * i] * rr * g4[0], O[db][4 * i + 1] * rr * g4[1]); w.y = pg8::cvt_pk_bf16(O[db][4 * i + 2] * rr * g4[2], O[db][4 * i + 3] * rr * g4[3]);
            *(GAS u32x2*)(op + dv) = w; }
    TP_END(23)
}
#if defined(P3_PROBE) && (P3_PROBE == 1)
#define P3_DRYLOADS 1
#else
#define P3_DRYLOADS 0
#endif
#ifndef P3_PROBE
#define P3_PROBE 0
#endif
constexpr int HS_QH = 0, HS_KH = 16384, HS_VV = 32768, HS_PL = 49152, HS_VEC = 57344, HS_SEG = 58880, HS_SET = 65536;
constexpr size_t WS_HST = WS_XN;
constexpr size_t WS_HD = WS_CTL + 512 * 1024;
constexpr size_t WS_OFB = WS_Y + 112 * MiB;
constexpr int HG_GT = RING_BYTES + 8192;
__device__ __forceinline__ float row16_sum(float v) {
    v += __builtin_bit_cast(float, __builtin_amdgcn_update_dpp(0, __builtin_bit_cast(int, v), 0x128, 0xf, 0xf, false));
    v += __builtin_bit_cast(float, __builtin_amdgcn_update_dpp(0, __builtin_bit_cast(int, v), 0x124, 0xf, 0xf, false));
    v += __builtin_bit_cast(float, __builtin_amdgcn_update_dpp(0, __builtin_bit_cast(int, v), 0x122, 0xf, 0xf, false));
    v += __builtin_bit_cast(float, __builtin_amdgcn_update_dpp(0, __builtin_bit_cast(int, v), 0x121, 0xf, 0xf, false));
    return v;
}
__device__ __forceinline__ void hgrn_glds(const void* gsrc, unsigned ldsdst) { unsigned keep_; asm volatile("s_mov_b32 %0, m0\n\ts_mov_b32 m0, %2\n\ts_nop 0\n\tglobal_load_lds_dwordx4 %1, off\n\ts_mov_b32 m0, %0" : "=&s"(keep_) : "v"(gsrc), "s"(ldsdst) : "memory"); }
__device__ __forceinline__ int hsw(int row, int byte) { return row * 256 + ((((byte >> 4) ^ (((row & 3) << 2) | ((row >> 2) & 3))) << 4) | (byte & 15)); }
__device__ __forceinline__ int psw(int row, int byte) { return row * 128 + ((((byte >> 4) ^ ((row >> 1) & 7)) << 4) | (byte & 15)); }
typedef short bf16x4 __attribute__((ext_vector_type(4)));
typedef float f32x2 __attribute__((ext_vector_type(2)));
__device__ __forceinline__ float hgrn_lb(Frame& F, int e, int z, int ch) { if (e == 0) return 0.f; const float* lbl = F.in[I_LBL]; return 1.f / (1.f + __expf(lbl[(z * 2 + 0) * 512 + ch] - lbl[(z * 2 + 1) * 512 + ch])); }

struct HgrnRegs { unsigned a2[8], q2[8]; v4u vv[2]; };
template <int MODE, int z>
__device__ __forceinline__ void hgrn_prep_load(Frame& F, int tid, size_t tok0, int h, HgrnRegs& R) {
    const int k2 = tid & 63, seg = F.wave; const bf16* Y = F_Y;
#pragma unroll
    for (int i = 0; i < 8; ++i) { const bf16* yr = Y + (tok0 + 8 * seg + i) * EVEN_IN + h * 128 + 2 * k2;
        R.a2[i] = __builtin_nontemporal_load((const GAS unsigned*)(yr + 2560 + z * 512)); R.q2[i] = (MODE == 3) ? __builtin_nontemporal_load((const GAS unsigned*)(yr + 1024)) : 0u; }
#pragma unroll
    for (int i = 0; i < 2; ++i) { const int idx = tid + 512 * i, row = idx >> 4, c16 = idx & 15; R.vv[i] = *(const GAS v4u*)(Y + (tok0 + row) * EVEN_IN + 1536 + h * 128 + c16 * 8); }
}
template <int MODE, int z>
__device__ __forceinline__ void hgrn_prep(Frame& F, int tid, LAS unsigned char* set, const HgrnRegs& R, float lb0, float lb1, float& tot0, float& tot1) {
    const int k2 = tid & 63, seg = F.wave;
    LAS float* SEG = (LAS float*)(set + HS_SEG); LAS float* VEC = (LAS float*)(set + HS_VEC);
    const unsigned (&a2)[8] = R.a2; const unsigned (&q2)[8] = R.q2; const v4u (&vv)[2] = R.vv;
    float lf[8][2], kk[8][2], qv[8][2];
#pragma unroll
    for (int i = 0; i < 8; ++i) {
        const float a0 = bf2f(a2[i] & 0xffffu), a1 = bf2f(a2[i] >> 16);
        const float s0 = sigmoidf_(a0), s1 = sigmoidf_(a1);
        lf[i][0] = 0.6931471805599453f * __builtin_amdgcn_logf(lb0 + (1.f - lb0) * s0); lf[i][1] = 0.6931471805599453f * __builtin_amdgcn_logf(lb1 + (1.f - lb1) * s1);
        kk[i][0] = (1.f - lb0) * (1.f - s0); kk[i][1] = (1.f - lb1) * (1.f - s1);
        qv[i][0] = bf2f(q2[i] & 0xffffu); qv[i][1] = bf2f(q2[i] >> 16); }
#pragma unroll
    for (int i = 0; i < 2; ++i) { const int idx = tid + 512 * i, row = idx >> 4, c16 = idx & 15; *(LAS v4u*)(set + HS_VV + hsw(row, c16 * 16)) = vv[i]; }
    float bl[8][2]; float t0 = 0.f, t1 = 0.f;
#pragma unroll
    for (int ii = 0; ii < 8; ++ii) { const int i = z ? 7 - ii : ii; t0 += lf[i][0]; t1 += lf[i][1]; bl[i][0] = t0; bl[i][1] = t1; }
    *(LAS f32x2*)(SEG + seg * 128 + 2 * k2) = (f32x2){t0, t1};
    lds_barrier();
    float base0 = 0.f, base1 = 0.f, r0 = 0.f, r1 = 0.f, e0 = 0.f, e1 = 0.f;
#pragma unroll
    for (int s = 0; s < 8; ++s) { const f32x2 sv = *(const LAS f32x2*)(SEG + s * 128 + 2 * k2);
        const bool before = z ? (s > seg) : (s < seg); if (before) { base0 += sv.x; base1 += sv.y; }
        const bool inref = z ? (s >= 4) : (s <= 3); if (inref) { r0 += sv.x; r1 += sv.y; }
        e0 += sv.x; e1 += sv.y; }
    if (MODE == 3) {
#pragma unroll
        for (int i = 0; i < 8; ++i) { const int row = 8 * seg + i;
            const float b0 = base0 + bl[i][0], b1 = base1 + bl[i][1];
            const float E0 = __expf(fminf(b0 - r0, 80.f)), E1 = __expf(fminf(b1 - r1, 80.f)), G0 = __expf(fminf(r0 - b0, 80.f)), G1 = __expf(fminf(r1 - b1, 80.f));
            *(LAS unsigned*)(set + HS_QH + hsw(row, 4 * k2)) = pk2(qv[i][0] * E0, qv[i][1] * E1);
            *(LAS unsigned*)(set + HS_KH + hsw(row, 4 * k2)) = pk2(kk[i][0] * G0, kk[i][1] * G1); }
        if (seg == 0) { *(LAS f32x2*)(VEC + 2 * k2) = (f32x2){__expf(r0), __expf(r1)}; *(LAS f32x2*)(VEC + 128 + 2 * k2) = (f32x2){__expf(e0 - r0), __expf(e1 - r1)}; *(LAS f32x2*)(VEC + 256 + 2 * k2) = (f32x2){__expf(e0), __expf(e1)}; }
    } else {
#pragma unroll
        for (int i = 0; i < 8; ++i) { const int row = 8 * seg + i;
            const float b0 = base0 + bl[i][0], b1 = base1 + bl[i][1];
            *(LAS unsigned*)(set + HS_KH + hsw(row, 4 * k2)) = pk2(kk[i][0] * __expf(e0 - b0 + tot0), kk[i][1] * __expf(e1 - b1 + tot1)); }
        tot0 += e0; tot1 += e1;
    }
}
__device__ __forceinline__ void hgrn_vfrags(LAS unsigned char* set, int w, int g, int qp, int pp, bf16x8 (&Vf)[2]) {
#pragma unroll
    for (int s = 0; s < 2; ++s) { const int row = 32 * s + 8 * g + qp;
        const v4i16_t lo = tr_read16(set + HS_VV + hsw(row, 32 * w + 8 * pp)), hi = tr_read16(set + HS_VV + hsw(row + 4, 32 * w + 8 * pp));
        Vf[s] = (bf16x8){lo[0], lo[1], lo[2], lo[3], hi[0], hi[1], hi[2], hi[3]}; }
}
template <bool PLAIN = false>
__device__ __forceinline__ void hgrn_ktv(LAS unsigned char* set, int g, int qp, int pp, const bf16x8 (&Vf)[2], f32x4 (&T)[8]) {
#pragma unroll
    for (int kb = 0; kb < 8; ++kb)
#pragma unroll
        for (int s = 0; s < 2; ++s) { const int row = 32 * s + 8 * g + qp;
            const v4i16_t lo = PLAIN ? *(const LAS v4i16_t*)(set + HS_KH + hsw(row, 32 * kb + 8 * pp)) : tr_read16(set + HS_KH + hsw(row, 32 * kb + 8 * pp)), hi = PLAIN ? *(const LAS v4i16_t*)(set + HS_KH + hsw(row + 4, 32 * kb + 8 * pp)) : tr_read16(set + HS_KH + hsw(row + 4, 32 * kb + 8 * pp));
            const bf16x8 kf = (bf16x8){lo[0], lo[1], lo[2], lo[3], hi[0], hi[1], hi[2], hi[3]};
            T[kb] = __builtin_amdgcn_mfma_f32_16x16x32_bf16(kf, Vf[s], T[kb], 0, 0, 0); }
}
template <int z>
__device__ __forceinline__ void hgrn_p1_dir(Frame& F, int e, int item) {
    const int gI = item & 15, h = (item >> 4) & 3, b = (item >> 6) & 3;
    const int w = F.wave, k2 = F.tid & 63;
    const float lb0 = hgrn_lb(F, e, z, h * 128 + 2 * k2), lb1 = hgrn_lb(F, e, z, h * 128 + 2 * k2 + 1);
    float tot0 = 0.f, tot1 = 0.f;
    f32x4 U[8];
#pragma unroll
    for (int kb = 0; kb < 8; ++kb) U[kb] = (f32x4){0.f, 0.f, 0.f, 0.f};
    HgrnRegs R; hgrn_prep_load<1, z>(F, F.tid, (size_t)b * SEQ + gI * 256 + (z ? 0 : 3) * 64, h, R);
#pragma unroll 1
    for (int ci = 0; ci < 4; ++ci) { const int cI = z ? ci : 3 - ci; (void)cI;
        int tid_l = F.tid; asm volatile("" : "+v"(tid_l));
        const int fr = tid_l & 15, g = (tid_l >> 4) & 3, qp = fr >> 2, pp = fr & 3;
        LAS unsigned char* set = F.lds + (ci & 1) * HS_SET;
        hgrn_prep<1, z>(F, tid_l, set, R, lb0, lb1, tot0, tot1);
        if (ci + 1 < 4) hgrn_prep_load<1, z>(F, tid_l, (size_t)b * SEQ + gI * 256 + (z ? ci + 1 : 2 - ci) * 64, h, R);
        lds_barrier();
        bf16x8 Vf[2]; hgrn_vfrags(set, w, g, qp, pp, Vf);
        hgrn_ktv(set, g, qp, pp, Vf, U); }
    float* Ug = (float*)(F.ws + WS_HST) + (size_t)item * 16384;
#pragma unroll
    for (int kb = 0; kb < 8; ++kb) *(GAS f32x4*)(Ug + ((w * 8 + kb) * 64 + F.lane) * 4) = U[kb];
    if (w == 0) { float* Dg = (float*)(F.ws + WS_HD) + (size_t)item * 128; Dg[2 * k2] = __expf(tot0); Dg[2 * k2 + 1] = __expf(tot1); }
    lds_barrier();
}
__device__ __forceinline__ void hgrn_p1_item(Frame& F, int e, int item) { if (item >> 8) hgrn_p1_dir<1>(F, e, item); else hgrn_p1_dir<0>(F, e, item); }
__device__ __forceinline__ void hgrn_scan(Frame& F) {
    const int gt = F.vcu * (NWAVES * 64) + F.tid, NT = F.G * NWAVES * 64;
    float* ST = (float*)(F.ws + WS_HST); const float* Dg = (const float*)(F.ws + WS_HD);
    for (int i = gt; i < 32 * 4096; i += NT) {
        const int seq = i >> 12, el = (i & 4095) * 4, k = 16 * ((i >> 6) & 7) + 4 * ((i & 63) >> 4), z = seq >> 4;
        f32x4 uv[16], dv[16];
#pragma unroll
        for (int gi = 0; gi < 16; ++gi) { const int gI = z ? 15 - gi : gi; const size_t it = (size_t)seq * 16 + gI; uv[gi] = *(const GAS f32x4*)(ST + it * 16384 + el); dv[gi] = *(const GAS f32x4*)(Dg + it * 128 + k); }
        f32x4 S = (f32x4){0.f, 0.f, 0.f, 0.f}; asm volatile("" : "+v"(S));
#pragma unroll
        for (int gi = 0; gi < 16; ++gi) { const int gI = z ? 15 - gi : gi; const size_t it = (size_t)seq * 16 + gI; *(GAS f32x4*)(ST + it * 16384 + el) = S; S = dv[gi] * S + uv[gi]; }
    }
}
__device__ __forceinline__ void hgrn_scan_issue(Frame& F, f32x4 (&uv)[16]) {
    const int i = F.vcu * (NWAVES * 64) + F.tid; const float* ST = (const float*)(F.ws + WS_HST);
    const int seq = i >> 12, el = (i & 4095) * 4, z = seq >> 4;
#pragma unroll
    for (int gi = 0; gi < 16; ++gi) { const int gI = z ? 15 - gi : gi; const size_t it = (size_t)seq * 16 + gI; uv[gi] = *(const GAS f32x4*)(ST + it * 16384 + el); }
}
__device__ __forceinline__ void hgrn_scan_finish(Frame& F, f32x4 (&uv)[16]) {
    int tid = F.tid; asm volatile("" : "+v"(tid));
    const int i = F.vcu * (NWAVES * 64) + tid; float* ST = (float*)(F.ws + WS_HST); const float* Dg = (const float*)(F.ws + WS_HD);
    const int seq = i >> 12, el = (i & 4095) * 4, k = 16 * ((i >> 6) & 7) + 4 * ((i & 63) >> 4), z = seq >> 4;
    f32x4 dv[16];
#pragma unroll
    for (int gi = 0; gi < 16; ++gi) { const int gI = z ? 15 - gi : gi; const size_t it = (size_t)seq * 16 + gI; dv[gi] = *(const GAS f32x4*)(Dg + it * 128 + k); }
    f32x4 S = (f32x4){0.f, 0.f, 0.f, 0.f}; asm volatile("" : "+v"(S));
#pragma unroll
    for (int gi = 0; gi < 16; ++gi) { const int gI = z ? 15 - gi : gi; const size_t it = (size_t)seq * 16 + gI; *(GAS f32x4*)(ST + it * 16384 + el) = S; S = dv[gi] * S + uv[gi]; }
}
template <int z>
__device__ __forceinline__ void hgrn_p3_dir(Frame& F, int e, int b, int h, int gI, bool dry) {
    const int w = F.wave, k2 = F.tid & 63; const int unit_ = (b * 4 + h) * 16 + gI;
    const float lb0 = hgrn_lb(F, e, z, h * 128 + 2 * k2), lb1 = hgrn_lb(F, e, z, h * 128 + 2 * k2 + 1);
    v4u* OFB = (v4u*)(F.ws + WS_OFB);
    const float ngv = F.in[I_HNG][e * 512 + h * 128 + 16 * w + (F.lane & 15)];
    f32x4 S[8];
    TP_BEGIN(12)
    { const float* Sin = (const float*)(F.ws + WS_HST) + (size_t)(((z * 4 + b) * 4 + h) * 16 + gI) * 16384;
#pragma unroll
      for (int kb = 0; kb < 8; ++kb) S[kb] = *(const GAS f32x4*)(Sin + ((w * 8 + kb) * 64 + F.lane) * 4); }
    HgrnRegs R; hgrn_prep_load<3, z>(F, F.tid, (size_t)b * SEQ + gI * 256 + (z ? 3 : 0) * 64, h, R);
    asm volatile("s_waitcnt vmcnt(0)" : "+v"(S[0]), "+v"(S[7]) :: "memory"); TP_END(12)
#pragma unroll 1
    for (int ci = 0; ci < 4; ++ci) { const int cI = z ? 3 - ci : ci; const size_t tok0 = (size_t)b * SEQ + gI * 256 + cI * 64;
        int tid_l = F.tid; asm volatile("" : "+v"(tid_l));
        const int fr = tid_l & 15, g = (tid_l >> 4) & 3, qp = fr >> 2, pp = fr & 3;
        LAS unsigned char* set = F.lds + (ci & 1) * HS_SET;
        float dm0 = 0.f, dm1 = 0.f;
        TP_BEGIN(4) hgrn_prep<3, z>(F, tid_l, set, R, lb0, lb1, dm0, dm1); TP_END(4)
        v4u pk[2];
        if (z == 1) { const v4u* pp_ = OFB + ((size_t)((unit_ * 4 + cI) * NWAVES + w) * 2) * 64 + (tid_l & 63); pk[0] = *(const GAS v4u*)pp_; pk[1] = *(const GAS v4u*)(pp_ + 64); }
        if (ci + 1 < 4) hgrn_prep_load<3, z>(F, tid_l, (size_t)b * SEQ + gI * 256 + (z ? 2 - ci : ci + 1) * 64, h, R);
        lds_barrier();
        if (z == 1) {
#pragma unroll
            for (int i = 0; i < 2; ++i) { const int p = 2 * w + i, row = 4 * p + ((tid_l & 63) >> 4), c16 = ((tid_l & 63) & 15) ^ ((row >> 2) & 3);
                hgrn_glds(F_Y + (tok0 + row) * EVEN_IN + 2048 + h * 128 + c16 * 8, (unsigned)__builtin_amdgcn_readfirstlane((unsigned)(size_t)(F.lds + HG_GT) + p * 1024)); } }
        TP_BEGIN(5)
        { const int tb = w >> 1;
#pragma unroll
          for (int jj = 0; jj < 2; ++jj) { const int jb = 2 * (w & 1) + jj; f32x4 acc = (f32x4){0.f, 0.f, 0.f, 0.f};
              const bool live = z ? (jb >= tb) : (jb <= tb);
              if (live) {
#pragma unroll
                  for (int s = 0; s < 4; ++s) { const bf16x8 kf = *(const LAS bf16x8*)(set + HS_KH + hsw(16 * jb + fr, 64 * s + 16 * g)); const bf16x8 qf = *(const LAS bf16x8*)(set + HS_QH + hsw(16 * tb + fr, 64 * s + 16 * g));
                      acc = __builtin_amdgcn_mfma_f32_16x16x32_bf16(kf, qf, acc, 0, 0, 0); }
#pragma unroll
                  for (int r = 0; r < 4; ++r) { const int j = 16 * jb + 4 * g + r, t = 16 * tb + fr; const bool keep = z ? (j >= t) : (j <= t); acc[r] = keep ? acc[r] : 0.f; } }
              typedef unsigned u32x2 __attribute__((ext_vector_type(2)));
              u32x2 pw; pw.x = pg8::cvt_pk_bf16(acc[0], acc[1]); pw.y = pg8::cvt_pk_bf16(acc[2], acc[3]);
              *(LAS u32x2*)(set + HS_PL + psw(16 * tb + fr, 32 * jb + 8 * g)) = pw; } }
        const LAS float* VEC = (const LAS float*)(set + HS_VEC);
        bf16x8 Sb[4];
#pragma unroll
        for (int s = 0; s < 4; ++s) { const f32x4 ea = *(const LAS f32x4*)(VEC + 32 * s + 4 * g), eb = *(const LAS f32x4*)(VEC + 32 * s + 16 + 4 * g); const f32x4 x = S[2 * s] * ea, y = S[2 * s + 1] * eb;
            v4u pw; pw.x = pg8::cvt_pk_bf16(x[0], x[1]); pw.y = pg8::cvt_pk_bf16(x[2], x[3]); pw.z = pg8::cvt_pk_bf16(y[0], y[1]); pw.w = pg8::cvt_pk_bf16(y[2], y[3]); Sb[s] = __builtin_bit_cast(bf16x8, pw); }
        bf16x8 Vf[2]; hgrn_vfrags(set, w, g, qp, pp, Vf);
        lds_barrier();
        TP_END(5) TP_BEGIN(6)
        f32x4 o[4];
#pragma unroll
        for (int tb = 0; tb < 4; ++tb) { f32x4 acc = (f32x4){0.f, 0.f, 0.f, 0.f}; const int row = 16 * tb + fr;
#pragma unroll
            for (int s = 0; s < 4; ++s) { const bf16x4 lo = *(const LAS bf16x4*)(set + HS_QH + hsw(row, 64 * s + 8 * g)), hi = *(const LAS bf16x4*)(set + HS_QH + hsw(row, 64 * s + 32 + 8 * g));
                const bf16x8 qf = (bf16x8){lo[0], lo[1], lo[2], lo[3], hi[0], hi[1], hi[2], hi[3]};
                acc = __builtin_amdgcn_mfma_f32_16x16x32_bf16(qf, Sb[s], acc, 0, 0, 0); }
#pragma unroll
            for (int s = 0; s < 2; ++s) { const bf16x8 pf = *(const LAS bf16x8*)(set + HS_PL + psw(row, 64 * s + 16 * g));
                acc = __builtin_amdgcn_mfma_f32_16x16x32_bf16(pf, Vf[s], acc, 0, 0, 0); }
            o[tb] = acc; }
        TP_END(6) TP_BEGIN(7)
        { f32x4 T[8];
#pragma unroll
          for (int kb = 0; kb < 8; ++kb) T[kb] = (f32x4){0.f, 0.f, 0.f, 0.f};
          if (P3_PROBE == 4 && dry) hgrn_ktv<true>(set, g, qp, pp, Vf, T); else if (!(P3_PROBE == 3 && dry)) hgrn_ktv(set, g, qp, pp, Vf, T);
#pragma unroll
          for (int kb = 0; kb < 8; ++kb) { const f32x4 dd = *(const LAS f32x4*)(VEC + 256 + 16 * kb + 4 * g), ee = *(const LAS f32x4*)(VEC + 128 + 16 * kb + 4 * g); S[kb] = dd * S[kb] + ee * T[kb]; } }
        TP_END(7) TP_BEGIN(8) TP_BEGIN(10)
        if (z == 0) {
            v4u* pp_ = OFB + ((size_t)((unit_ * 4 + cI) * NWAVES + w) * 2) * 64 + (tid_l & 63);
#pragma unroll
            for (int i = 0; i < 2; ++i) { v4u pw; pw.x = pg8::cvt_pk_bf16(o[2 * i][0], o[2 * i][1]); pw.y = pg8::cvt_pk_bf16(o[2 * i][2], o[2 * i][3]); pw.z = pg8::cvt_pk_bf16(o[2 * i + 1][0], o[2 * i + 1][1]); pw.w = pg8::cvt_pk_bf16(o[2 * i + 1][2], o[2 * i + 1][3]);
                *(GAS v4u*)(pp_ + 64 * i) = pw; }
        } else {
            LAS float* red = (LAS float*)(set + HS_SEG);
            TP_BEGIN(40)
#pragma unroll
            for (int tb = 0; tb < 4; ++tb)
#pragma unroll
                for (int r = 0; r < 4; ++r) { { const unsigned w2_ = pk[tb >> 1][2 * (tb & 1) + (r >> 1)]; o[tb][r] += (r & 1) ? __uint_as_float(w2_ & 0xffff0000u) : __uint_as_float(w2_ << 16); }
                    float ss = row16_sum(o[tb][r] * o[tb][r]);
                    if (fr == 0) red[(tb * 16 + 4 * g + r) * 8 + w] = ss; }
            TP_END(40) TP_BEGIN(41)
            asm volatile("s_waitcnt vmcnt(0)" ::: "memory");
            lds_barrier();
            TP_END(41) TP_BEGIN(42)
#pragma unroll
            for (int tb = 0; tb < 4; ++tb)
#pragma unroll
                for (int r = 0; r < 4; ++r) { const int t = tb * 16 + 4 * g + r; const f32x4 a = *(const LAS f32x4*)(red + t * 8), bq = *(const LAS f32x4*)(red + t * 8 + 4);
                    const float tot = (a[0] + a[1]) + (a[2] + a[3]) + (bq[0] + bq[1]) + (bq[2] + bq[3]); const float rr = __builtin_amdgcn_rsqf(tot * (1.f / 128.f) + EPS);
                    const size_t row = tok0 + t; const float gv = bf2f(*(const LAS unsigned short*)(F.lds + HG_GT + t * 256 + ((((2 * w + (fr >> 3)) ^ ((t >> 2) & 3)) << 4) | ((2 * fr) & 15))));
                    { const float ov_ = o[tb][r] * rr * ngv * gv * sigmoidf_(gv); if (!(P3_PROBE == 1 && dry)) F_MIX[row * DM + 512 + h * 128 + 16 * w + fr] = (bf16)f2bf(ov_); else asm volatile("" :: "v"(ov_)); } }
            TP_END(42)
        }
    if (z == 0) { TP_END(8) } else { TP_END(10) } }
    lds_barrier();
}
__device__ __forceinline__ void hgrn_p3_unit(Frame& F, int e, int unit, bool dry = false) {
    const int gI = unit & 15, h = (unit >> 4) & 3, b = unit >> 6;
    TP_BEGIN(9) hgrn_p3_dir<0>(F, e, b, h, gI, dry);
    asm volatile("s_waitcnt vmcnt(0)" ::: "memory"); __syncthreads();
    hgrn_p3_dir<1>(F, e, b, h, gI, dry); TP_END(9)
}
__device__ __forceinline__ void sgu_load_w(Frame& F, int e, int h) {
    const float* Ws = F.in[I_SGUW] + (size_t)((e * 4 + h) * 128) * 128; const int tid = F.tid;
#pragma unroll
    for (int i = 0; i < 4; ++i) { const int idx = tid + 512 * i, row = idx >> 4, c16 = idx & 15;
        const f32x4 a = *(const GAS f32x4*)(Ws + row * 128 + c16 * 8), bq = *(const GAS f32x4*)(Ws + row * 128 + c16 * 8 + 4);
        v4u w; w.x = pk2(a[0], a[1]); w.y = pk2(a[2], a[3]); w.z = pk2(bq[0], bq[1]); w.w = pk2(bq[2], bq[3]);
        *(LAS v4u*)(F.lds + hsw(row, c16 * 16)) = w; }
    if (tid < 128) ((LAS float*)(F.lds + 65536))[tid] = F.in[I_SGUB][(e * 4 + h) * 128 + tid];
}
__device__ __forceinline__ void sgu_unit(Frame& F, int e, int unit) {
    const int h = unit & 3, n = (unit >> 2) & 31, b = unit >> 7; const size_t row0 = (size_t)b * SEQ + n * 128;
    LAS unsigned char* WT = F.lds; LAS unsigned char* VN = F.lds + 32768;
    const bf16* Y = F_Y; int tid = F.tid; asm volatile("" : "+v"(tid));
    const int lane = tid & 63, w = F.wave, fr = lane & 15, g = lane >> 4, qp = fr >> 2, pp = fr & 3;
    { const int q = tid >> 2, part = tid & 3; const bf16* vp = Y + (row0 + q) * EVEN_IN + 512 + h * 128 + part * 32;
      float gl[32]; float ss = 0.f;
#pragma unroll
      for (int i = 0; i < 4; ++i) { float f8[8]; unpack8(*(const GAS v4u*)(vp + 8 * i), f8);
#pragma unroll
          for (int j = 0; j < 8; ++j) { const float x = gelu_tanh(f8[j]); gl[8 * i + j] = x; ss += x * x; } }
      ss += __shfl_xor(ss, 1); ss += __shfl_xor(ss, 2);
      const float r = __builtin_amdgcn_rsqf(ss * (1.f / 128.f) + EPS); const float* ng = F.in[I_SGUG] + e * 512 + h * 128 + part * 32;
#pragma unroll
      for (int i = 0; i < 4; ++i) { float f8[8];
#pragma unroll
          for (int j = 0; j < 8; ++j) f8[j] = gl[8 * i + j] * r * ng[8 * i + j];
          *(LAS v4u*)(VN + hsw(q, part * 64 + i * 16)) = pack8(f8); } }
    lds_barrier();
    bf16x8 Bf[4];
#pragma unroll
    for (int s = 0; s < 4; ++s) { const int row = 32 * s + 8 * g + qp;
        const v4i16_t lo = tr_read16(VN + hsw(row, 32 * w + 8 * pp)), hi = tr_read16(VN + hsw(row + 4, 32 * w + 8 * pp));
        Bf[s] = (bf16x8){lo[0], lo[1], lo[2], lo[3], hi[0], hi[1], hi[2], hi[3]}; }
    const LAS float* bs = (const LAS float*)(F.lds + 65536);
    unsigned short ur[32];
#pragma unroll
    for (int i = 0; i < 32; ++i) { const int p = 16 * (i >> 2) + 4 * g + (i & 3); ur[i] = Y[(row0 + p) * EVEN_IN + h * 128 + 16 * w + fr]; }
#pragma unroll
    for (int pb = 0; pb < 8; ++pb) { f32x4 acc = (f32x4){0.f, 0.f, 0.f, 0.f};
#pragma unroll
        for (int s = 0; s < 4; ++s) { const bf16x8 af = *(const LAS bf16x8*)(WT + hsw(16 * pb + fr, 64 * s + 16 * g)); acc = __builtin_amdgcn_mfma_f32_16x16x32_bf16(af, Bf[s], acc, 0, 0, 0); }
        const f32x4 b4 = *(const LAS f32x4*)(bs + 16 * pb + 4 * g);
#pragma unroll
        for (int r = 0; r < 4; ++r) { const int p = 16 * pb + 4 * g + r; const float u = bf2f(ur[pb * 4 + r]);
            F_MIX[(row0 + p) * DM + h * 128 + 16 * w + fr] = (bf16)f2bf(gelu_tanh(u) * (acc[r] + b4[r])); } }
    lds_barrier();
}
__device__ __forceinline__ void sgu_own_w(Frame& F, int e) { lds_barrier(); sgu_load_w(F, e, (F.bx >> 3) & 3); }
__device__ __forceinline__ void sgu_own_units(Frame& F, int e) {
    const int x = F.bx & 7, j = F.bx >> 3, b = x >> 1, h = j & 3, n0 = 16 * (x & 1) + (j >> 2);
    sgu_unit(F, e, b * 128 + n0 * 4 + h); sgu_unit(F, e, b * 128 + (n0 + 8) * 4 + h);
}
__device__ __forceinline__ void sgu_phase(Frame& F, int e) {
    int hprev = -1;
    if (F.G == 256) { sgu_own_w(F, e); sgu_own_units(F, e); return; }
    for (int u = F.bx; u < 512; u += F.G) { const int h = u & 3; if (h != hprev) { lds_barrier(); sgu_load_w(F, e, h); hprev = h; } sgu_unit(F, e, u); }
}
#ifndef TP_SCALE
#define TP_SCALE 32.f
#define TP_OFFS 0.f
#endif
#ifndef TP_BLK
#define TP_BLK 0
#endif
#ifndef SCAN_OVERLAP
#define SCAN_OVERLAP 1
#endif
#ifndef BARCAT
#define BARCAT -1
#endif
constexpr int NPH = 1 + 2 * 7 + 2 * 6;
struct Args { const float* in[N_IN]; float* out; unsigned char* ws; int ph_lo, ph_hi, li, pad; };
__global__ void __launch_bounds__(NWAVES * 64, 2) fwd_kernel(Args args) {
    extern __shared__ __attribute__((aligned(16))) unsigned char lds[];
    const int wv_ = __builtin_amdgcn_readfirstlane((int)threadIdx.x >> 6);
#define MK_TID(dst) do { int ln_; asm volatile("v_mbcnt_lo_u32_b32 %0, -1, 0\n\tv_mbcnt_hi_u32_b32 %0, -1, %0" : "=v"(ln_)); (dst) = wv_ * 64 + ln_; } while (0)
    { int t0_; MK_TID(t0_);
      for (int u = t0_; u < (LDS_BYTES - LDSCTL_OFF) / 4; u += NWAVES * 64) ((LAS unsigned*)((LAS unsigned char*)lds + LDSCTL_OFF))[u] = 0u;
      __syncthreads();
      if (t0_ == 0) ((gu32*)(args.ws + WS_CTL))[CW_CENSUS + blockIdx.x] = xb_xcc_id() + 1u;
      if (args.ph_hi - args.ph_lo > 1) (void)xcd_barrier_post((unsigned*)((gu32*)(args.ws + WS_CTL) + CW_BAR), (volatile LAS unsigned*)((LAS unsigned char*)lds + MISC_OFF) + 8, t0_ == 0); }
    const int lo = args.ph_lo, hi = args.ph_hi; const int cat_ = -1; (void)cat_;
    int pc = 0;
#if defined(TPROBE) && TPROBE >= 100
    const unsigned long long tk0_ = __builtin_amdgcn_s_memrealtime();
#define TPH_T0 const unsigned long long tph0_ = __builtin_amdgcn_s_memrealtime(); const unsigned long long tpc0_ = __builtin_amdgcn_s_memtime();
#define TPH_T1 if (TPROBE == 200 + cat_ && blockIdx.x == 0 && threadIdx.x == 0) { volatile LAS unsigned long long* pa_ = (volatile LAS unsigned long long*)((LAS unsigned char*)lds + MISC_OFF + 64); pa_[2] = pa_[2] + (__builtin_amdgcn_s_memrealtime() - tph0_); pa_[1] = pa_[1] + (__builtin_amdgcn_s_memtime() - tpc0_); } \
    if (TPROBE == 100 + cat_ && blockIdx.x == 0 && threadIdx.x == 0) { volatile LAS unsigned long long* pa_ = (volatile LAS unsigned long long*)((LAS unsigned char*)lds + MISC_OFF + 64) + 1; *pa_ = *pa_ + (__builtin_amdgcn_s_memrealtime() - tph0_); }
#else
#define TPH_T0
#define TPH_T1
#endif
#if defined(TPROBE) && TPROBE == 150
#define GB_T0 const unsigned long long gb0_ = __builtin_amdgcn_s_memrealtime();
#define GB_T1 if (blockIdx.x == TP_BLK && bb.lead && (BARCAT < 0 || cat_ == BARCAT)) { volatile LAS unsigned long long* pa_ = (volatile LAS unsigned long long*)((LAS unsigned char*)lds + MISC_OFF + 64) + 1; *pa_ = *pa_ + (__builtin_amdgcn_s_memrealtime() - gb0_); }
#else
#define GB_T0
#define GB_T1
#endif
#define GRID_BARRIER() do { unsigned long long wsb_ = (unsigned long long)args.ws; unsigned b0_ = (unsigned)wsb_, b1_ = (unsigned)(wsb_ >> 32); asm volatile("" : "+v"(b0_), "+v"(b1_)); b0_ = __builtin_amdgcn_readfirstlane(b0_); b1_ = __builtin_amdgcn_readfirstlane(b1_);   \
        XcdBarrier bb; bb.bar = (unsigned*)((gu32*)((unsigned char*)(((unsigned long long)b1_ << 32) | b0_) + WS_CTL) + CW_BAR); bb.x = xb_xcc_id(); bb.st = (volatile LAS unsigned*)((LAS unsigned char*)lds + MISC_OFF) + 8; { int tb_; MK_TID(tb_); bb.lead = tb_ == 0; } GB_T0 xcd_barrier(bb); GB_T1 } while (0)
#define GROUP_BARRIER_X(ARR, WON, WTG, ALO, AHI) do { unsigned long long wsb_ = (unsigned long long)args.ws; unsigned b0_ = (unsigned)wsb_, b1_ = (unsigned)(wsb_ >> 32); asm volatile("" : "+v"(b0_), "+v"(b1_)); b0_ = __builtin_amdgcn_readfirstlane(b0_); b1_ = __builtin_amdgcn_readfirstlane(b1_); \
        unsigned* ctl_ = (unsigned*)((gu32*)((unsigned char*)(((unsigned long long)b1_ << 32) | b0_) + WS_CTL)); XcdBarrier bb; bb.bar = ctl_ + CW_BAR; bb.x = xb_xcc_id(); bb.st = (volatile LAS unsigned*)((LAS unsigned char*)lds + MISC_OFF) + 8; int tb_; MK_TID(tb_); bb.lead = tb_ == 0; \
        group_barrier(bb, ctl_, gridDim.x, blockIdx.x, tb_, (ARR), (WON), (WTG), (ALO), (AHI)); } while (0)
#define GROUP_BARRIER() GROUP_BARRIER_X(-1, -1, 0u, -1, -1)
#define GUARD_WAIT(IDX, TGT) do { unsigned long long wsb_ = (unsigned long long)args.ws; unsigned b0_ = (unsigned)wsb_, b1_ = (unsigned)(wsb_ >> 32); asm volatile("" : "+v"(b0_), "+v"(b1_)); b0_ = __builtin_amdgcn_readfirstlane(b0_); b1_ = __builtin_amdgcn_readfirstlane(b1_); \
        unsigned* ctl_ = (unsigned*)((gu32*)((unsigned char*)(((unsigned long long)b1_ << 32) | b0_) + WS_CTL)); XcdBarrier bb; bb.bar = ctl_ + CW_BAR; bb.x = 0u; bb.st = (volatile LAS unsigned*)((LAS unsigned char*)lds + MISC_OFF) + 8; int tb_; MK_TID(tb_); bb.lead = tb_ == 0; \
        guard_wait(bb, ctl_, (IDX), (TGT)); } while (0)
#ifdef PROBE_DUP
#define PH_REP_OPEN for (int rep_ = 0; rep_ < ((cat_ == PROBE_DUP) ? 2 : 1); ++rep_) { if (rep_) GRID_BARRIER();
#define PH_REP_CLOSE }
#define PH_FIRST(x) if (!rep_) { x; }
#define PH_ISDUP (cat_ == PROBE_DUP && rep_ == 0)
#else
#define PH_REP_OPEN {
#define PH_REP_CLOSE }
#define PH_FIRST(x) x;
#define PH_ISDUP false
#endif
#define PH_BEGIN(CAT) if (pc >= lo && pc < hi) { const int cat_ = (CAT); (void)cat_; TPH_T0 PH_REP_OPEN Frame F; { int bx_ = blockIdx.x, tid_; MK_TID(tid_); unsigned long long ws_ = (unsigned long long)args.ws, out_ = (unsigned long long)args.out; unsigned w0 = (unsigned)ws_, w1 = (unsigned)(ws_ >> 32), o0 = (unsigned)out_, o1 = (unsigned)(out_ >> 32); \
        asm volatile("" : "+v"(bx_), "+v"(w0), "+v"(w1), "+v"(o0), "+v"(o1), "+v"(tid_)); bx_ = __builtin_amdgcn_readfirstlane(bx_); w0 = __builtin_amdgcn_readfirstlane(w0); w1 = __builtin_amdgcn_readfirstlane(w1); o0 = __builtin_amdgcn_readfirstlane(o0); o1 = __builtin_amdgcn_readfirstlane(o1); \
        F.lds = (LAS unsigned char*)lds; F.tid = tid_; F.lane = tid_ & 63; F.wave = __builtin_amdgcn_readfirstlane(tid_ >> 6); F.G = gridDim.x; F.in = args.in; \
        F.bx = bx_; F.ws = (unsigned char*)(((unsigned long long)w1 << 32) | w0); F.out = (float*)(((unsigned long long)o1 << 32) | o0); F.vcu = (F.G % 8 == 0) ? (bx_ % 8) * (F.G / 8) + bx_ / 8 : bx_; }
#ifdef PROBE_XBAR
#define PH_XBAR if (cat_ == 9) for (int xb_ = 0; xb_ < PROBE_XBAR; ++xb_) GRID_BARRIER();
#else
#define PH_XBAR
#endif
#define PH_END   PH_REP_CLOSE if (pc + 1 < hi) GRID_BARRIER(); PH_XBAR TPH_T1 } ++pc;
#ifndef NO_GROUP_BARRIER
#define PH_END_G PH_REP_CLOSE if (pc + 1 < hi) GROUP_BARRIER(); PH_XBAR TPH_T1 } ++pc;
#define PH_END_C(cond) PH_REP_CLOSE if (pc + 1 < hi) { if (cond) GROUP_BARRIER(); else GRID_BARRIER(); } PH_XBAR TPH_T1 } ++pc;
#define PH_END_GX(ARR, WON, WTG) PH_REP_CLOSE if (pc + 1 < hi) GROUP_BARRIER_X(ARR, WON, WTG, -1, -1); PH_XBAR TPH_T1 } ++pc;
#define PH_END_GP(ALO, AHI) PH_REP_CLOSE if (pc + 1 < hi) GROUP_BARRIER_X(1, -1, 0u, ALO, AHI); PH_XBAR TPH_T1 } ++pc;
#else
#define PH_END_G PH_END
#define PH_END_C(cond) PH_END
#define PH_END_GX(ARR, WON, WTG) PH_END
#define PH_END_GP(ALO, AHI) PH_END
#endif
#define OWN_UNIT(bx_) ((((((bx_) & 7) >> 1) * 4 + ((bx_) >> 6)) * 16) + 8 * ((bx_) & 1) + (((bx_) >> 3) & 7))
    for (int l = 0; l < DEPTH; ++l) {
        const bool even = (l & 1) == 0; const int li = l >> 1; const int Nin = even ? EVEN_IN : ODD_IN;
        if (l == 0) { PH_BEGIN(0) prep_weights(F, 0, 0, 0, F.G); x_to_bf16(F, F.in[I_X]); PH_END }
        PH_BEGIN(1) { pg8::Gemm g{F_XB, F_WIN, M, Nin, DM, 0, F.tid}; pg8::StaticOrder S; S.init(M, Nin, F.G, F.bx);
            fill_rstd(F, S, (const float*)(F.ws + WS_SSB));
            pg8::EpiBf16S<0> E{F_Y, Nin, (const LAS float*)(F.lds + RST_OFF), (const LAS int*)(F.lds + RST_OFF + 4096), false};
            pg8::gemm_phase<pg8::EpiBf16S<0>, pg8::StaticOrder, true, true>(F.lds + RING_OFF, g, S, E); }
            GUARD_WAIT(1, gridDim.x * (unsigned)l);
            if (even && F.G == 256) { if (F.bx >= 128) { const int sv = F.vcu; F.vcu = F.bx - 128; prep_weights(F, l, 1, 0, 128); F.vcu = sv; } } else prep_weights(F, l, 1, 0, F.G);
        PH_END_C(even)
        if (even) {
            PH_BEGIN(2) { TP_BEGIN(32) if (F.G == 256) { hgrn_p1_item(F, li, OWN_UNIT(F.bx)); hgrn_p1_item(F, li, 256 + OWN_UNIT(F.bx)); } else for (int u = F.bx; u < 512; u += F.G) hgrn_p1_item(F, li, u); TP_END(32) }
            PH_END
            PH_BEGIN(3) { TP_BEGIN(30)
#ifndef PROBE_DUP
              if (SCAN_OVERLAP && F.G * NWAVES * 64 == 32 * 4096) { f32x4 uv_[16]; sgu_own_w(F, li); hgrn_scan_issue(F, uv_); sgu_own_units(F, li); hgrn_scan_finish(F, uv_); } else
#endif
              { PH_FIRST(hgrn_scan(F)) sgu_phase(F, li); } TP_END(30) }
              if (l + 1 < DEPTH) { lds_barrier(); prep_weights(F, l + 1, 0, 0, F.G); }
            PH_END
            PH_BEGIN(4) for (int u0_ = F.bx; u0_ < 256; u0_ += F.G) { const int u = (F.G == 256) ? OWN_UNIT(u0_) : u0_;
#if defined(P3_X) && P3_X == 7
                _Pragma("unroll 1") for (int r2_ = 0; r2_ < 2; ++r2_)
#endif
                { int uu_ = u, tt_ = F.tid; asm volatile("" : "+v"(uu_), "+v"(tt_)); uu_ = __builtin_amdgcn_readfirstlane(uu_); F.tid = tt_; F.lane = tt_ & 63; hgrn_p3_unit(F, li, uu_, PH_ISDUP); } } PH_END_GX(0, -1, 0u)
        } else {
            PH_BEGIN(5)
#ifndef NO_ODDPREP
 { TP_BEGIN(33) conv_phase(F, li); TP_END(33) } { TP_BEGIN(34) qk_prep_phase(F, li); TP_END(34) } { TP_BEGIN(35) vt_phase(F); TP_END(35) }
                if (l + 1 < DEPTH) { lds_barrier(); prep_weights(F, l + 1, 0, 0, F.G); }
#endif
 PH_END
            PH_BEGIN(6)
#ifndef NO_ATTN
 { float m2_, lam_, linit_; attn_params(F, li, l, m2_, lam_, linit_); if (F.G == 256) attn_unit(F, li, OWN_UNIT(F.bx), m2_, lam_, linit_); else for (int u = F.vcu; u < 256; u += F.G) attn_unit(F, li, u, m2_, lam_, linit_);     }
#endif
 PH_END_GX(0, -1, 0u)
        }
        PH_BEGIN(7) { pg8::Gemm g{F_MIX, F_WOUT, M, DM, DM, 0, F.tid}; pg8::StaticOrder S; S.init(M, DM, F.G, F.bx);
            { pg8::EpiRes<false, false> E{F_XB, F_XB, DM, (float*)(F.ws + WS_SSA)}; pg8::gemm_phase<pg8::EpiRes<false, false>, pg8::StaticOrder, true, true>(F.lds + RING_OFF, g, S, E); } } PH_END_GX(-1, 0, gridDim.x * (unsigned)(l + 1))
        PH_BEGIN(9) { pg8::Gemm g{F_XB, F_W1, M, FF, DM, 0, F.tid};
#if defined(PROBE_DUP) && defined(PROBE_SHORTK)
            if (rep_ == 0) g.nt_over = PROBE_SHORTK;
#endif
            pg8::StaticOrder S; S.init(M, FF, F.G, F.bx);
            fill_rstd(F, S, (const float*)(F.ws + WS_SSA));
            pg8::EpiBf16S<2> E{F_Y, FF, (const LAS float*)(F.lds + RST_OFF), (const LAS int*)(F.lds + RST_OFF + 4096), false};
#if defined(PROBE_DUP) && defined(PROBE_NOSTORE)
            if (rep_ == 0) E.nostore = true;
#endif
            { TP_BEGIN(1) pg8::gemm_phase<pg8::EpiBf16S<2>, pg8::StaticOrder, true, true>(F.lds + RING_OFF, g, S, E); TP_END(1) } } PH_END_G
        PH_BEGIN(10) { pg8::Gemm g{F_Y, F_W2, M, DM, FF, 0, F.tid}; pg8::StaticOrder S; S.init(M, DM, F.G, F.bx);
            if (l == DEPTH - 1) { pg8::EpiRes<false, true> E{F_XB, F.out, DM, nullptr}; pg8::gemm_phase<pg8::EpiRes<false, true>, pg8::StaticOrder, true, true>(F.lds + RING_OFF, g, S, E); }
            else { pg8::EpiRes<false, false> E{F_XB, F_XB, DM, (float*)(F.ws + WS_SSB)}; pg8::gemm_phase<pg8::EpiRes<false, false>, pg8::StaticOrder, true, true>(F.lds + RING_OFF, g, S, E); } }
        PH_END_GP((int)(((unsigned)(8 * (blockIdx.x & 7) + ((blockIdx.x >> 3) & 7)) * 256u * (unsigned)(even ? ODD_IN : EVEN_IN) * 2u) >> 21), (int)((((unsigned)(8 * (blockIdx.x & 7) + ((blockIdx.x >> 3) & 7)) + 1u) * 256u * (unsigned)(even ? ODD_IN : EVEN_IN) * 2u - 1u) >> 21))
    }
#if defined(TPROBE) && TPROBE >= 100
    if (blockIdx.x == TP_BLK && threadIdx.x == 0) { volatile LAS unsigned long long* pa_ = (volatile LAS unsigned long long*)((LAS unsigned char*)lds + MISC_OFF + 64); *pa_ = __builtin_amdgcn_s_memrealtime() - tk0_; }
#endif
#ifdef TPROBE
    GRID_BARRIER();
    if (blockIdx.x == TP_BLK && threadIdx.x == 0) { volatile LAS unsigned long long* pa = (volatile LAS unsigned long long*)((LAS unsigned char*)lds + MISC_OFF + 64); const float a0 = (float)pa[0], a1 = (float)pa[1];
        args.out[0] = (TPROBE >= 200) ? 10.f + floorf(4.f * a1 / (float)pa[2] + 0.5f) : 10.f + floorf((TPROBE >= 100 ? 200.f : TP_SCALE) * a1 / a0 + 0.5f) - TP_OFFS; }
#endif
#undef PH_BEGIN
#undef PH_END
}

extern "C" void kernel_launch(void* const* d_in, const int* in_sizes, int n_in, void* d_out, int out_size, void* d_ws, size_t ws_size, hipStream_t stream) {
    static int grid = 0;
    if (grid == 0) {
        if (n_in != N_IN || in_sizes[0] != M * DM || out_size != M * DM || ws_size < 255 * MiB) { fprintf(stderr, "kernel_launch: unexpected shapes (n_in %d, in0 %d, out %d, ws %zu)\n", n_in, n_in > 0 ? in_sizes[0] : -1, out_size, ws_size); grid = -1; return; }
        int dev = 0, cus = 0, per_cu = 0;
        if (hipGetDevice(&dev) != hipSuccess || hipDeviceGetAttribute(&cus, hipDeviceAttributeMultiprocessorCount, dev) != hipSuccess) { grid = -1; return; }
        if (hipFuncSetAttribute((const void*)fwd_kernel, hipFuncAttributeMaxDynamicSharedMemorySize, LDS_BYTES) != hipSuccess) { fprintf(stderr, "kernel_launch: hipFuncSetAttribute failed\n"); grid = -1; return; }
        if (hipOccupancyMaxActiveBlocksPerMultiprocessor(&per_cu, (const void*)fwd_kernel, NWAVES * 64, LDS_BYTES) != hipSuccess || per_cu < 1) { fprintf(stderr, "kernel_launch: occupancy query reports %d workgroups per CU\n", per_cu); per_cu = 1; }
        (void)hipGetLastError();
        grid = cus;
    }
    if (grid < 0) return;
    if (hipMemsetAsync((char*)d_ws + WS_CTL, 0, CTL_ZERO_BYTES, stream) != hipSuccess) return;
    Args a{};
    for (int i = 0; i < N_IN; ++i) a.in[i] = (const float*)d_in[i];
    a.out = (float*)d_out; a.ws = (unsigned char*)d_ws;
#if MK_ONE_LAUNCH
    a.ph_lo = 0; a.ph_hi = NPH; a.li = 0;
    hipLaunchKernelGGL(fwd_kernel, dim3(grid), dim3(NWAVES * 64), LDS_BYTES, stream, a);
#else
    for (int p = 0; p < NPH; ++p) { a.ph_lo = p; a.ph_hi = p + 1; a.li = p;
        hipLaunchKernelGGL(fwd_kernel, dim3(grid), dim3(NWAVES * 64), LDS_BYTES, stream, a); }
#endif
}
```

```cpp
#include <hip/hip_runtime.h>
#include <cstdio>
#include <cstdint>
#if defined(TPROBE) && TPROBE == 30
#define GTP_BEGIN const unsigned long long gtp0_ = __builtin_amdgcn_s_memrealtime();
#define GTP_END if (g.N == 4096 && blockIdx.x == 0 && threadIdx.x == 0) { volatile __attribute__((address_space(3))) unsigned long long* pa_ = (volatile __attribute__((address_space(3))) unsigned long long*)(lds + 131072 + 320 + 64) + 1; *pa_ = *pa_ + (__builtin_amdgcn_s_memrealtime() - gtp0_); }
#else
#define GTP_BEGIN
#define GTP_END
#endif
namespace pg8 {
#define PG8_LAS __attribute__((address_space(3)))
typedef unsigned short bf16_t;
typedef short bf16x8 __attribute__((ext_vector_type(8)));
typedef float f32x4 __attribute__((ext_vector_type(4)));
typedef unsigned u32x4 __attribute__((ext_vector_type(4)));
constexpr int BM = 256, BK = 64, HALF = 128, HTB = HALF * BK * 2  , STAGE_BYTES = 8 * HTB, NXCD = 8, WGM = 8;

__host__ __device__ __forceinline__ int lds_byte(int r, int c) { const int st = (r >> 4) * 2 + (c >> 5), rr = r & 15, cc = c & 31, ob = rr * 64 + cc * 2; return st * 1024 + (ob ^ (((ob >> 9) & 1) << 5)); }
__host__ __device__ __forceinline__ void stage_rc(int b, int& R, int& C) { const int st = b / 1024, sb = b % 1024, swz = sb ^ (((sb >> 9) & 1) << 5); R = (st >> 1) * 16 + swz / 64; C = (st & 1) * 32 + (swz % 64) / 2; }
__host__ __device__ __forceinline__ int perm32(int rho) { const int n = rho >> 4, i = rho & 15; return 8 * (i >> 2) + 4 * n + (i & 3); }

struct Unit { int pm, pn; };
struct Gemm { const bf16_t* A; const bf16_t* Bt; int M, N, K; int nt_over; int tid; };

struct StaticOrder {
    int nM, nN, nwg, G, c;
    __host__ __device__ void init(int M, int N, int G_, int c_) { nM = M / BM; nN = N / BM; nwg = nM * nN; G = G_; c = c_; }
    __host__ __device__ bool next(int i, Unit& u) const {
        const long L = (long)i * G + c; if (L >= nwg) return false;
        int wgid = (int)L; { const int q = nwg / NXCD, r = nwg % NXCD, xcd = wgid % NXCD, off = wgid / NXCD; wgid = (xcd < r ? xcd * (q + 1) : r * (q + 1) + (xcd - r) * q) + off; }
        const int nig = WGM * nN, gid = wgid / nig, fm = gid * WGM, gsz = (nM - fm) < WGM ? (nM - fm) : WGM;
        u.pm = fm + ((wgid % nig) % gsz); u.pn = (wgid % nig) / gsz; return true;
    }
    __device__ __forceinline__ void a_ready(const Unit&) const {}
    __device__ __forceinline__ void done(const Unit&) const {}
};

__device__ __forceinline__ unsigned cvt_pk_bf16(float lo, float hi) { unsigned r; asm volatile("v_cvt_pk_bf16_f32 %0, %1, %2" : "=v"(r) : "v"(lo), "v"(hi)); return r; }
typedef float f32x2 __attribute__((ext_vector_type(2)));
__device__ __forceinline__ f32x2 gelu_pk(f32x2 v) {
    const f32x2 av = __builtin_elementwise_abs(v), d = av * 0.2316418882f + 1.0f;
    f32x2 t; t.x = __builtin_amdgcn_rcpf(d.x); t.y = __builtin_amdgcn_rcpf(d.y);
    f32x2 q = t * 0.5307027145f + (-0.7265760135f); q = q * t + 0.7107068705f; q = q * t + (-0.142248368f); q = q * t + 0.127414796f; q = q * t;
    const f32x2 s = (v * v) * (-0.72134752044f);
    f32x2 e; e.x = __builtin_amdgcn_exp2f(s.x); e.y = __builtin_amdgcn_exp2f(s.y);
    const f32x2 m = v * (q * e), r = v - m;
    f32x2 o; o.x = v.x < 0.f ? m.x : r.x; o.y = v.y < 0.f ? m.y : r.y; return o;
}

template <int ACT  > struct EpiBf16 {
    static constexpr bool PERM = true, AFTER_DRAIN = false; static_assert(ACT == 0 || ACT == 1, "EpiBf16: ACT is 0 (none) or 1 (gelu_pk)");
    bf16_t* O; int ldc; const float* bias; int split_cols; size_t split_stride; float scale0;
    __device__ __forceinline__ void operator()(const f32x4 (&acc)[2][2][4][2], const Unit& u, int wr, int wc, int fr, int fq) const {
        const int row0 = u.pm * BM + wr * 64 + fr; int colt = u.pn * BM; bf16_t* base = O;
        float sc = 1.f; if (split_cols) { const int t = colt / split_cols; base += (size_t)t * split_stride; colt -= t * split_cols; if (t == 0) sc = scale0; }
        const int col0 = colt + wc * 32 + 8 * fq, bcol0 = u.pn * BM + wc * 32 + 8 * fq;
        f32x4 bv[2][2];
#pragma unroll
        for (int bj = 0; bj < 2; ++bj)
#pragma unroll
            for (int n = 0; n < 2; ++n) bv[bj][n] = bias ? *(const f32x4*)(bias + bcol0 + bj * HALF + 4 * n) : (f32x4){0.f, 0.f, 0.f, 0.f};
#pragma unroll
        for (int ai = 0; ai < 2; ++ai)
#pragma unroll
            for (int m = 0; m < 4; ++m) { bf16_t* rowp = base + (size_t)(row0 + ai * HALF + m * 16) * ldc + col0;
#pragma unroll
                for (int bj = 0; bj < 2; ++bj) { f32x4 v0 = acc[ai][bj][m][0] + bv[bj][0], v1 = acc[ai][bj][m][1] + bv[bj][1];
                    if (ACT == 1) { f32x2 a = gelu_pk((f32x2){v0[0], v0[1]}), b = gelu_pk((f32x2){v0[2], v0[3]}), c = gelu_pk((f32x2){v1[0], v1[1]}), d = gelu_pk((f32x2){v1[2], v1[3]});
                        v0 = (f32x4){a.x, a.y, b.x, b.y}; v1 = (f32x4){c.x, c.y, d.x, d.y}; }
                    v0 = v0 * sc; v1 = v1 * sc; u32x4 w; w.x = cvt_pk_bf16(v0[0], v0[1]); w.y = cvt_pk_bf16(v0[2], v0[3]); w.z = cvt_pk_bf16(v1[0], v1[1]); w.w = cvt_pk_bf16(v1[2], v1[3]);
                    *(u32x4*)(rowp + bj * HALF) = w; } }
    }
};

struct PanelStats {
    unsigned* xbuf;
    unsigned* cnt;
    unsigned* tmo;
    int ntn; float eps;
    unsigned code;
    __device__ __forceinline__ bool run(const f32x4 (&v)[2][2][4][2], const Unit& u, int wr, int wc, int fr, int fq, PG8_LAS unsigned char* lds, int wid, int lane) const {
        typedef float f32x2v __attribute__((ext_vector_type(2)));
        PG8_LAS f32x2v* P = (PG8_LAS f32x2v*)lds;
        PG8_LAS f32x2v* S = (PG8_LAS f32x2v*)(lds + 8192);
        PG8_LAS unsigned* flag = (PG8_LAS unsigned*)(lds + 8192 + 2048);
#pragma unroll
        for (int ai = 0; ai < 2; ++ai)
#pragma unroll
            for (int m = 0; m < 4; ++m) {
                float s = 0.f;
#pragma unroll
                for (int bj = 0; bj < 2; ++bj)
#pragma unroll
                    for (int n = 0; n < 2; ++n) { const f32x4 x = v[ai][bj][m][n]; s += (x[0] + x[1]) + (x[2] + x[3]); }
                s += __shfl_xor(s, 16); s += __shfl_xor(s, 32);
                const float mw = s * (1.0f / 64.0f); float q = 0.f;
#pragma unroll
                for (int bj = 0; bj < 2; ++bj)
#pragma unroll
                    for (int n = 0; n < 2; ++n) { const f32x4 d = v[ai][bj][m][n] - mw; q += (d[0] * d[0] + d[1] * d[1]) + (d[2] * d[2] + d[3] * d[3]); }
                q += __shfl_xor(q, 16); q += __shfl_xor(q, 32);
                if (fq == 0) P[(ai * HALF + wr * 64 + m * 16 + fr) * 4 + wc] = (f32x2v){mw, q};
            }
        asm volatile("s_waitcnt lgkmcnt(0)" ::: "memory"); __builtin_amdgcn_s_barrier(); asm volatile("" ::: "memory");
#if defined(BROKEN_EXCHANGE_NO_WAIT)
#warning BROKEN CONTROL BUILD: the row-statistics exchange does not wait; results are wrong by design
        if (blockIdx.x >= 64) { const long long t0_ = clock64(); while (clock64() - t0_ < 60000) __builtin_amdgcn_s_sleep(8); }
#endif
        const int row = wid * 32 + (lane & 31);
        if (lane < 32) {
            const f32x2v a = P[row * 4 + 0], b = P[row * 4 + 1], c = P[row * 4 + 2], d = P[row * 4 + 3];
            const float mt = (a.x + b.x + c.x + d.x) * 0.25f;
            const float da = a.x - mt, db = b.x - mt, dc = c.x - mt, dd = d.x - mt;
            const float m2 = (a.y + b.y) + (c.y + d.y) + 64.0f * ((da * da + db * db) + (dc * dc + dd * dd));
            unsigned long long* slot = (unsigned long long*)xbuf + ((size_t)(u.pm * BM + row) * 4 + u.pn);
            __hip_atomic_store(slot, ((unsigned long long)__float_as_uint(m2) << 32) | __float_as_uint(mt), __ATOMIC_RELAXED, __HIP_MEMORY_SCOPE_AGENT);
        }
        asm volatile("s_waitcnt vmcnt(0)" ::: "memory");
        if (lane == 0) __hip_atomic_fetch_add(cnt + 64 * u.pm, 1u, __ATOMIC_RELAXED, __HIP_MEMORY_SCOPE_AGENT);
        if (wid == 0) {
            bool dead = false; const unsigned long long t0 = __builtin_amdgcn_s_memrealtime(); const unsigned want = 8u * (unsigned)ntn;
            for (;;) {
#if defined(BROKEN_EXCHANGE_NO_WAIT)
                break;
#endif
                if ((unsigned)__builtin_amdgcn_readfirstlane(__hip_atomic_load(cnt + 64 * u.pm, __ATOMIC_RELAXED, __HIP_MEMORY_SCOPE_AGENT)) >= want) break;
                if (__builtin_amdgcn_s_memrealtime() - t0 > 2000000ull) {
                    if (lane == 0) { unsigned expect = 0u; __hip_atomic_compare_exchange_strong(tmo + 1, &expect, code | (unsigned)(u.pm & 0xff), __ATOMIC_RELAXED, __ATOMIC_RELAXED, __HIP_MEMORY_SCOPE_AGENT);
                                     __hip_atomic_store(tmo, 1u, __ATOMIC_RELAXED, __HIP_MEMORY_SCOPE_AGENT); }
                    dead = true; break; }
                __builtin_amdgcn_s_sleep(2);
            }
            __builtin_amdgcn_fence(__ATOMIC_ACQUIRE, "agent");
            if (lane == 0) flag[0] = dead ? 1u : 0u;
        }
        asm volatile("s_waitcnt vmcnt(0) lgkmcnt(0)" ::: "memory"); __builtin_amdgcn_s_barrier(); asm volatile("" ::: "memory");
        const bool bad = flag[0] != 0u;
        if (lane < 32) {
            const unsigned long long* slot = (const unsigned long long*)xbuf + (size_t)(u.pm * BM + row) * 4; float mt[4], m2[4]; float ms = 0.f;
#pragma unroll
            for (int t = 0; t < 4; ++t) { if (t < ntn) { const unsigned long long w = __hip_atomic_load(slot + t, __ATOMIC_RELAXED, __HIP_MEMORY_SCOPE_AGENT); mt[t] = __uint_as_float((unsigned)w); m2[t] = __uint_as_float((unsigned)(w >> 32)); } else { mt[t] = 0.f; m2[t] = 0.f; } ms += mt[t]; }
            const float mean = ms / (float)ntn; float q = 0.f;
#pragma unroll
            for (int t = 0; t < 4; ++t) if (t < ntn) { const float dm = mt[t] - mean; q += m2[t] + 256.0f * dm * dm; }
            S[row] = (f32x2v){mean, 1.0f / sqrtf(q / (256.0f * (float)ntn) + eps)};
        }
        asm volatile("s_waitcnt lgkmcnt(0)" ::: "memory"); __builtin_amdgcn_s_barrier(); asm volatile("" ::: "memory");
        return bad;
    }
};
struct EpiLnRes {
    static constexpr bool PERM = false, AFTER_DRAIN = true;
    const float* base; float* out; int ldc; const float* bias; PanelStats st; unsigned poison;
    __device__ __forceinline__ void fused(f32x4 (&acc)[2][2][4][2], const Unit& u, int wr, int wc, int fr, int fq, PG8_LAS unsigned char* lds, int wid, int lane) const {
        typedef float f32x2v __attribute__((ext_vector_type(2)));
        const PG8_LAS f32x2v* S = (const PG8_LAS f32x2v*)(lds + 8192);
        const int col0 = u.pn * BM + wc * 32 + 4 * fq;
#pragma unroll
        for (int bj = 0; bj < 2; ++bj)
#pragma unroll
            for (int n = 0; n < 2; ++n) { const f32x4 bv = bias ? *(const f32x4*)(bias + col0 + bj * HALF + n * 16) : (f32x4){0.f, 0.f, 0.f, 0.f};
#pragma unroll
                for (int ai = 0; ai < 2; ++ai)
#pragma unroll
                    for (int m = 0; m < 4; ++m) acc[ai][bj][m][n] += bv; }
        f32x4 pre[4][2][2];
#pragma unroll
        for (int m = 0; m < 4; ++m) { const size_t off = (size_t)(u.pm * BM + wr * 64 + m * 16 + fr) * ldc + col0;
#pragma unroll
            for (int bj = 0; bj < 2; ++bj)
#pragma unroll
                for (int n = 0; n < 2; ++n) pre[m][bj][n] = *(const f32x4*)(base + off + bj * HALF + n * 16); }
        const bool bad = st.run(acc, u, wr, wc, fr, fq, lds, wid, lane) || poison != 0u;
        const float qnan = __builtin_nanf("");
#pragma unroll
        for (int ai = 0; ai < 2; ++ai)
#pragma unroll
            for (int m = 0; m < 4; ++m) { const int r = ai * HALF + wr * 64 + m * 16 + fr; const f32x2v sr = S[r]; const size_t off = (size_t)(u.pm * BM + r) * ldc + col0;
#pragma unroll
                for (int bj = 0; bj < 2; ++bj)
#pragma unroll
                    for (int n = 0; n < 2; ++n) { const f32x4 bs = ai == 0 ? pre[m][bj][n] : *(const f32x4*)(base + off + bj * HALF + n * 16); f32x4 o = bs + (acc[ai][bj][m][n] - sr.x) * sr.y;
                        if (bad) o = (f32x4){qnan, qnan, qnan, qnan}; *(f32x4*)(out + off + bj * HALF + n * 16) = o; }
                if (m & 1) asm volatile("" ::: "memory"); }
    }
};
struct EpiLnResLn {
    static constexpr bool PERM = false, AFTER_DRAIN = true;
    const float* base; float* out; bf16_t* xn; int ldc; const float* bias; PanelStats st1, st2; unsigned poison;
    __device__ __forceinline__ void fused(f32x4 (&acc)[2][2][4][2], const Unit& u, int wr, int wc, int fr, int fq, PG8_LAS unsigned char* lds, int wid, int lane) const {
        typedef float f32x2v __attribute__((ext_vector_type(2))); typedef unsigned u32x2v __attribute__((ext_vector_type(2)));
        const PG8_LAS f32x2v* S = (const PG8_LAS f32x2v*)(lds + 8192);
        const int col0 = u.pn * BM + wc * 32 + 4 * fq;
#pragma unroll
        for (int bj = 0; bj < 2; ++bj)
#pragma unroll
            for (int n = 0; n < 2; ++n) { const f32x4 bv = bias ? *(const f32x4*)(bias + col0 + bj * HALF + n * 16) : (f32x4){0.f, 0.f, 0.f, 0.f};
#pragma unroll
                for (int ai = 0; ai < 2; ++ai)
#pragma unroll
                    for (int m = 0; m < 4; ++m) acc[ai][bj][m][n] += bv; }
        bool bad = st1.run(acc, u, wr, wc, fr, fq, lds, wid, lane) || poison != 0u;
        const float qnan = __builtin_nanf("");
#pragma unroll
        for (int ai = 0; ai < 2; ++ai)
#pragma unroll
            for (int m = 0; m < 4; ++m) { const int r = ai * HALF + wr * 64 + m * 16 + fr; const f32x2v sr = S[r]; const size_t off = (size_t)(u.pm * BM + r) * ldc + col0;
#pragma unroll
                for (int bj = 0; bj < 2; ++bj)
#pragma unroll
                    for (int n = 0; n < 2; ++n) { const f32x4 bs = *(const f32x4*)(base + off + bj * HALF + n * 16); acc[ai][bj][m][n] = bs + (acc[ai][bj][m][n] - sr.x) * sr.y; }
                asm volatile("" : "+v"(acc[ai][0][m][0]), "+v"(acc[ai][0][m][1]), "+v"(acc[ai][1][m][0]), "+v"(acc[ai][1][m][1]));
                if (m & 1) asm volatile("" ::: "memory"); }
        const bool bad1 = bad;
        bad = st2.run(acc, u, wr, wc, fr, fq, lds, wid, lane) || bad;
#pragma unroll
        for (int ai = 0; ai < 2; ++ai)
#pragma unroll
            for (int m = 0; m < 4; ++m) { const int r = ai * HALF + wr * 64 + m * 16 + fr; const f32x2v sr = S[r]; const size_t off = (size_t)(u.pm * BM + r) * ldc + col0;
#pragma unroll
                for (int bj = 0; bj < 2; ++bj)
#pragma unroll
                    for (int n = 0; n < 2; ++n) { const f32x4 x1 = acc[ai][bj][m][n]; *(f32x4*)(out + off + bj * HALF + n * 16) = bad1 ? (f32x4){qnan, qnan, qnan, qnan} : x1;
                        const f32x4 o = (x1 - sr.x) * sr.y; u32x2v w; w.x = cvt_pk_bf16(o[0], o[1]); w.y = cvt_pk_bf16(o[2], o[3]);
                        if (bad) { w.x = 0x7fc07fc0u; w.y = 0x7fc07fc0u; } *(u32x2v*)(xn + off + bj * HALF + n * 16) = w; }
                asm volatile("" ::: "memory"); }
    }
};

template <class Epi, class Sched, bool ALIGN_EPI = false, bool SP2 = false>
__device__ __forceinline__ void gemm_phase(PG8_LAS unsigned char* lds, const Gemm g, const Sched& S, const Epi& E) {
    int tid_ = g.tid; asm volatile("" : "+v"(tid_));
    const int tid = tid_, wid = __builtin_amdgcn_readfirstlane(tid >> 6), lane = tid & 63, wr = wid >> 2, wc = wid & 3, fr = lane & 15, fq = lane >> 4;
    const int K = g.K, nt = g.nt_over ? g.nt_over : K / BK;
    unsigned voffA[2], voffB[2];
#pragma unroll
    for (int i = 0; i < 2; ++i) { int R, C; stage_rc(tid * 16 + i * 8192, R, C); const int Rb = Epi::PERM ? ((R & ~31) + perm32(R & 31)) : R;
        voffA[i] = (unsigned)(R * K + C) * 2u; voffB[i] = (unsigned)(Rb * K + C) * 2u; }
    const size_t kstep = (size_t)(BK * 2);
    const size_t hstep = (size_t)HALF * K * 2;
    const size_t tstep = 2 * hstep;
    const unsigned ldsw = (unsigned)wid * 1024u;
    const int aoff = lds_byte(wr * 64 + fr, fq * 8), boff = lds_byte(wc * 32 + fr, fq * 8);
#define PG8_SA(b, h) (((b) * 2 + (h)) * HTB)
#define PG8_SB(b, h) ((4 + (b) * 2 + (h)) * HTB)
#define PG8_STAGE(bufoff, gbase, voff) do { _Pragma("unroll") for (int _i = 0; _i < 2; ++_i) \
        __builtin_amdgcn_global_load_lds((const unsigned*)((const char*)(gbase) + (voff)[_i]), (PG8_LAS unsigned*)(lds + (bufoff) + ldsw + _i * 8192), 16, 0, 0); } while (0)
#define PG8_LDA(dst, b, h) do { _Pragma("unroll") for (int m = 0; m < 4; ++m) _Pragma("unroll") for (int k = 0; k < 2; ++k) dst[m][k] = *(const PG8_LAS bf16x8*)(lds + PG8_SA(b, h) + aoff + m * 2048 + k * 1024); } while (0)
#define PG8_LDB(dst, b, h) do { _Pragma("unroll") for (int n = 0; n < 2; ++n) _Pragma("unroll") for (int k = 0; k < 2; ++k) dst[n][k] = *(const PG8_LAS bf16x8*)(lds + PG8_SB(b, h) + boff + n * 2048 + k * 1024); } while (0)
#define PG8_MMA(ai, bj, At, Bt) do { __builtin_amdgcn_s_setprio(1); _Pragma("unroll") for (int m = 0; m < 4; ++m) _Pragma("unroll") for (int n = 0; n < 2; ++n) _Pragma("unroll") for (int k = 0; k < 2; ++k) \
        acc[ai][bj][m][n] = __builtin_amdgcn_mfma_f32_16x16x32_bf16(Bt[n][k], At[m][k], acc[ai][bj][m][n], 0, 0, 0); __builtin_amdgcn_s_setprio(0); } while (0)
#define PG8_WAIT_V(n) asm volatile("s_waitcnt vmcnt(" #n ")" ::: "memory")
#define PG8_WAIT_L(n) asm volatile("s_waitcnt lgkmcnt(" #n ")" ::: "memory")
#define PG8_BAR __builtin_amdgcn_s_barrier()
#define PG8_SCHED __builtin_amdgcn_sched_barrier(0)
    Unit cur, nxt; int ui = 0;
    if (!S.next(0, cur)) return;
    f32x4 acc[2][2][4][2];
#pragma unroll
    for (int a = 0; a < 2; ++a)
#pragma unroll
        for (int b = 0; b < 2; ++b)
#pragma unroll
            for (int m = 0; m < 4; ++m)
#pragma unroll
                for (int n = 0; n < 2; ++n) acc[a][b][m][n] = (f32x4){0.f, 0.f, 0.f, 0.f};
    bf16x8 At[4][2], B0[2][2], B1[2][2];
    const char* cA = (const char*)g.A + (size_t)cur.pm * tstep; const char* cB = (const char*)g.Bt + (size_t)cur.pn * tstep;
    S.a_ready(cur);
    if constexpr (SP2) {
        PG8_STAGE(PG8_SB(0, 0), cB, voffB); PG8_STAGE(PG8_SB(0, 1), cB + hstep, voffB); PG8_STAGE(PG8_SA(0, 0), cA, voffA); PG8_STAGE(PG8_SA(0, 1), cA + hstep, voffA);
        if (wr == 1) PG8_BAR;
        PG8_WAIT_V(2); PG8_BAR;
        PG8_STAGE(PG8_SB(1, 0), cB + kstep, voffB); PG8_STAGE(PG8_SA(1, 0), cA + kstep, voffA); PG8_STAGE(PG8_SB(1, 1), cB + hstep + kstep, voffB);
        PG8_WAIT_V(6); PG8_BAR;
    } else {
        PG8_STAGE(PG8_SB(0, 0), cB, voffB); PG8_STAGE(PG8_SA(0, 0), cA, voffA); PG8_STAGE(PG8_SB(0, 1), cB + hstep, voffB); PG8_STAGE(PG8_SA(0, 1), cA + hstep, voffA);
        if (wr == 1) PG8_BAR;
        PG8_WAIT_V(4); PG8_BAR;
        PG8_STAGE(PG8_SB(1, 0), cB + kstep, voffB); PG8_STAGE(PG8_SA(1, 0), cA + kstep, voffA); PG8_STAGE(PG8_SB(1, 1), cB + hstep + kstep, voffB);
        PG8_WAIT_V(6); PG8_BAR;
    }
    for (;;) {
        const bool has_next = S.next(ui + 1, nxt);
        const char* nA = has_next ? (const char*)g.A + (size_t)nxt.pm * tstep : cA; const char* nB = has_next ? (const char*)g.Bt + (size_t)nxt.pn * tstep : cB;
        for (int t = 0; t < nt; t += 2) {
            const bool last = (t == nt - 2);
            const char* a1 = cA + (size_t)(t + 1) * kstep;
            const char* a2 = last ? nA : cA + (size_t)(t + 2) * kstep; const char* b2 = last ? nB : cB + (size_t)(t + 2) * kstep;
            const char* a3 = a2 + kstep; const char* b3 = b2 + kstep;
            if (last && has_next) S.a_ready(nxt);
            if constexpr (SP2) {
            PG8_LDB(B0, 0, 0); PG8_LDB(B1, 0, 1); PG8_SCHED; PG8_LDA(At, 0, 0); PG8_STAGE(PG8_SA(1, 1), a1 + hstep, voffA);
            PG8_WAIT_V(8); PG8_WAIT_L(0); PG8_BAR; PG8_MMA(0, 0, At, B0); PG8_MMA(0, 1, At, B1); PG8_BAR; PG8_SCHED;
            PG8_LDA(At, 0, 1); PG8_STAGE(PG8_SB(0, 0), b2, voffB); PG8_STAGE(PG8_SB(0, 1), b2 + hstep, voffB); PG8_STAGE(PG8_SA(0, 0), a2, voffA);
            PG8_WAIT_V(8); PG8_WAIT_L(0); PG8_BAR; PG8_MMA(1, 0, At, B0); PG8_MMA(1, 1, At, B1); PG8_BAR; PG8_SCHED;
            PG8_LDB(B0, 1, 0); PG8_LDB(B1, 1, 1); PG8_SCHED; PG8_LDA(At, 1, 0); PG8_STAGE(PG8_SA(0, 1), a2 + hstep, voffA);
            PG8_WAIT_V(8); PG8_WAIT_L(0); PG8_BAR; PG8_MMA(0, 0, At, B0); PG8_MMA(0, 1, At, B1); PG8_BAR; PG8_SCHED;
            PG8_LDA(At, 1, 1); PG8_STAGE(PG8_SB(1, 0), b3, voffB); PG8_STAGE(PG8_SB(1, 1), b3 + hstep, voffB); PG8_STAGE(PG8_SA(1, 0), a3, voffA);
            PG8_WAIT_V(8); PG8_WAIT_L(0); PG8_BAR; PG8_MMA(1, 0, At, B0); PG8_MMA(1, 1, At, B1); PG8_BAR; PG8_SCHED;
            } else {
            PG8_LDB(B0, 0, 0); PG8_SCHED; PG8_LDA(At, 0, 0); PG8_STAGE(PG8_SA(1, 1), a1 + hstep, voffA);
            PG8_WAIT_L(8); PG8_BAR; PG8_WAIT_L(0); PG8_MMA(0, 0, At, B0); PG8_BAR; PG8_SCHED;
            PG8_LDB(B1, 0, 1); PG8_STAGE(PG8_SB(0, 0), b2, voffB);
            PG8_BAR; PG8_WAIT_L(0); PG8_MMA(0, 1, At, B1); PG8_BAR;
            PG8_LDA(At, 0, 1); PG8_STAGE(PG8_SA(0, 0), a2, voffA);
            PG8_BAR; PG8_WAIT_L(0); PG8_MMA(1, 0, At, B0); PG8_BAR; PG8_SCHED;
            PG8_STAGE(PG8_SB(0, 1), b2 + hstep, voffB);
            PG8_WAIT_V(6); PG8_BAR; PG8_MMA(1, 1, At, B1); PG8_BAR;
            PG8_LDB(B0, 1, 0); PG8_SCHED; PG8_LDA(At, 1, 0); PG8_STAGE(PG8_SA(0, 1), a2 + hstep, voffA);
            PG8_WAIT_L(8); PG8_BAR; PG8_WAIT_L(0); PG8_MMA(0, 0, At, B0); PG8_BAR; PG8_SCHED;
            PG8_LDB(B1, 1, 1); PG8_STAGE(PG8_SB(1, 0), b3, voffB);
            PG8_BAR; PG8_WAIT_L(0); PG8_MMA(0, 1, At, B1); PG8_BAR;
            PG8_LDA(At, 1, 1); PG8_STAGE(PG8_SA(1, 0), a3, voffA);
            PG8_BAR; PG8_WAIT_L(0); PG8_MMA(1, 0, At, B0); PG8_BAR; PG8_SCHED;
            PG8_STAGE(PG8_SB(1, 1), b3 + hstep, voffB);
            PG8_WAIT_V(6); PG8_BAR; PG8_MMA(1, 1, At, B1); PG8_BAR;
            }
        }
        if constexpr (ALIGN_EPI) { if (wr == 0) PG8_BAR; }
        if constexpr (!Epi::AFTER_DRAIN) { GTP_BEGIN E(acc, cur, wr, wc, fr, fq); GTP_END S.done(cur); }
        if (!has_next) break;
#pragma unroll
        for (int a = 0; a < 2; ++a)
#pragma unroll
            for (int b = 0; b < 2; ++b)
#pragma unroll
                for (int m = 0; m < 4; ++m)
#pragma unroll
                    for (int n = 0; n < 2; ++n) acc[a][b][m][n] = (f32x4){0.f, 0.f, 0.f, 0.f};
        cur = nxt; cA = nA; cB = nB; ++ui;
        if constexpr (ALIGN_EPI) { if (wr == 1) PG8_BAR; }
    }
    PG8_WAIT_V(0);
    if constexpr (!ALIGN_EPI) { if (wr == 0) PG8_BAR; }
    PG8_BAR;
    if constexpr (Epi::AFTER_DRAIN) { E.fused(acc, cur, wr, wc, fr, fq, lds, wid, lane); S.done(cur); }
#undef PG8_SA
#undef PG8_SB
#undef PG8_STAGE
#undef PG8_LDA
#undef PG8_LDB
#undef PG8_MMA
#undef PG8_WAIT_V
#undef PG8_WAIT_L
#undef PG8_BAR
#undef PG8_SCHED
}
}
namespace pg8 {
template <int ACT  > struct EpiBf16S {
    static constexpr bool PERM = true, AFTER_DRAIN = false;
    bf16_t* O; int ldc; const PG8_LAS float* rst; const PG8_LAS int* pmt; bool nostore;
    __device__ __forceinline__ void operator()(const f32x4 (&acc)[2][2][4][2], const Unit& u, int wr, int wc, int fr, int fq) const {
        const int row0 = u.pm * BM + wr * 64 + fr, col0 = u.pn * BM + wc * 32 + 8 * fq;
        int ti = 0;
#pragma unroll
        for (int i = 1; i < 4; ++i) if (pmt[i] == u.pm) ti = i;
        const PG8_LAS float* rt = rst + ti * 256 + wr * 64 + fr;
#pragma unroll
        for (int ai = 0; ai < 2; ++ai)
#pragma unroll
            for (int m = 0; m < 4; ++m) { bf16_t* rowp = O + (size_t)(row0 + ai * HALF + m * 16) * ldc + col0; const float r = rt[ai * HALF + m * 16];
#pragma unroll
                for (int bj = 0; bj < 2; ++bj) { f32x4 v0 = acc[ai][bj][m][0] * r, v1 = acc[ai][bj][m][1] * r;
                    if (ACT == 2) {
#pragma unroll
                        for (int i = 0; i < 4; ++i) { const float a = v0[i] > 0.f ? v0[i] : 0.f, b = v1[i] > 0.f ? v1[i] : 0.f; v0[i] = a * a; v1[i] = b * b; } }
                    u32x4 w; w.x = cvt_pk_bf16(v0[0], v0[1]); w.y = cvt_pk_bf16(v0[2], v0[3]); w.z = cvt_pk_bf16(v1[0], v1[1]); w.w = cvt_pk_bf16(v1[2], v1[3]);
                    if (!nostore) *(u32x4*)(rowp + bj * HALF) = w; else asm volatile("" :: "v"(w)); } }
    }
};
template <bool BASE_F32, bool OUT_F32> struct EpiRes {
    static constexpr bool PERM = true, AFTER_DRAIN = false;
    const void* base; void* out; int ldc; float* ss;
    __device__ __forceinline__ void operator()(const f32x4 (&acc)[2][2][4][2], const Unit& u, int wr, int wc, int fr, int fq) const {
        const int row0 = u.pm * BM + wr * 64 + fr, col0 = u.pn * BM + wc * 32 + 8 * fq;
        f32x4 pf[3][2][2];
        u32x4 pb[3][2];
#define RES_LOAD(gi_, slot_) do { const int ai2_ = (gi_) >> 2, m2_ = (gi_) & 3; const size_t off2_ = (size_t)(row0 + ai2_ * HALF + m2_ * 16) * ldc + col0; \
            _Pragma("unroll") for (int bj = 0; bj < 2; ++bj) { if (BASE_F32) { pf[slot_][bj][0] = *(const f32x4*)((const float*)base + off2_ + bj * HALF); pf[slot_][bj][1] = *(const f32x4*)((const float*)base + off2_ + bj * HALF + 4); } \
                else pb[slot_][bj] = *(const u32x4*)((const bf16_t*)base + off2_ + bj * HALF); } } while (0)
        RES_LOAD(0, 0); RES_LOAD(1, 1);
#pragma unroll
        for (int gi = 0; gi < 8; ++gi) { const int ai = gi >> 2, m = gi & 3; const size_t off = (size_t)(row0 + ai * HALF + m * 16) * ldc + col0;
            if (gi + 2 < 8) RES_LOAD(gi + 2, (gi + 2) % 3);
            float sq = 0.f;
#pragma unroll
            for (int bj = 0; bj < 2; ++bj) { f32x4 b0, b1;
                if (BASE_F32) { b0 = pf[gi % 3][bj][0]; b1 = pf[gi % 3][bj][1]; }
                else { const u32x4 w = pb[gi % 3][bj]; b0 = (f32x4){__uint_as_float(w.x << 16), __uint_as_float(w.x & 0xffff0000u), __uint_as_float(w.y << 16), __uint_as_float(w.y & 0xffff0000u)};
                    b1 = (f32x4){__uint_as_float(w.z << 16), __uint_as_float(w.z & 0xffff0000u), __uint_as_float(w.w << 16), __uint_as_float(w.w & 0xffff0000u)}; }
                const f32x4 o0 = b0 + acc[ai][bj][m][0], o1 = b1 + acc[ai][bj][m][1];
                sq += ((o0[0] * o0[0] + o0[1] * o0[1]) + (o0[2] * o0[2] + o0[3] * o0[3])) + ((o1[0] * o1[0] + o1[1] * o1[1]) + (o1[2] * o1[2] + o1[3] * o1[3]));
                if (OUT_F32) { *(f32x4*)((float*)out + off + bj * HALF) = o0; *(f32x4*)((float*)out + off + bj * HALF + 4) = o1; }
                else { u32x4 w; w.x = cvt_pk_bf16(o0[0], o0[1]); w.y = cvt_pk_bf16(o0[2], o0[3]); w.z = cvt_pk_bf16(o1[0], o1[1]); w.w = cvt_pk_bf16(o1[2], o1[3]); *(u32x4*)((bf16_t*)out + off + bj * HALF) = w; } }
            if (ss) { sq += __shfl_xor(sq, 16); sq += __shfl_xor(sq, 32); if (fq == 0) ss[(size_t)(row0 + ai * HALF + m * 16) * 16 + u.pn * 4 + wc] = sq; } }
#undef RES_LOAD
    }
};
}
#ifndef PG8_SP2
#define PG8_SP2 true
#endif
constexpr int NWAVES = 8;
constexpr int BATCH = 4, SEQ = 4096, DM = 1024, DEPTH = 4, FF = 4096, EVEN_IN = 3584, ODD_IN = 3072;
constexpr int M = BATCH * SEQ;
constexpr float EPS = 1e-6f;
constexpr float LOG2E = 1.4426950408889634f;
#ifndef MK_ONE_LAUNCH
#define MK_ONE_LAUNCH 1
#endif
enum { I_X = 0, I_NMIX, I_NMLP, I_WINE, I_WOUTE, I_SGUG, I_SGUW, I_SGUB, I_LBL, I_HNG, I_WINO, I_WOUTO, I_CONVW, I_QG, I_KG, I_LQ1, I_LK1, I_LQ2, I_LK2, I_DNG, I_W1, I_W2, N_IN };

constexpr size_t MiB = 1u << 20;
constexpr size_t WS_CTL = 0, CTL_ZERO_BYTES = 1 * MiB;
constexpr size_t WS_WIN = 1 * MiB, WS_WOUT = 8 * MiB, WS_W1 = 10 * MiB, WS_W2 = 18 * MiB;
constexpr size_t WS_XN = 26 * MiB;
constexpr size_t WS_Y = 58 * MiB;
constexpr size_t WS_MIX = 186 * MiB;
constexpr size_t WS_END = 218 * MiB;
constexpr int CW_TMO = 0, CW_CODE = 1, CW_BAR = 4096;
constexpr int CW_CENSUS = 8192, CW_GCNT = 12288, CW_DONE = 20480;

constexpr int RING_OFF = 0, RING_BYTES = 131072;
constexpr int LDSCTL_OFF = RING_BYTES, MISC_OFF = LDSCTL_OFF + 320;
constexpr int LDS_BYTES = 163840;
#define GAS __attribute__((address_space(1)))
#define LAS __attribute__((address_space(3)))
typedef unsigned short bf16;
typedef unsigned v4u __attribute__((ext_vector_type(4)));
typedef float f32x4 __attribute__((ext_vector_type(4)));
typedef short bf16x8 __attribute__((ext_vector_type(8)));
typedef GAS unsigned gu32;
typedef GAS unsigned long long gu64;
#define RLX_AGENT __ATOMIC_RELAXED, __HIP_MEMORY_SCOPE_AGENT
#define LDS_WAIT() asm volatile("s_waitcnt lgkmcnt(0)" ::: "memory")
#define VM_WAIT() asm volatile("s_waitcnt vmcnt(0)" ::: "memory")
__device__ __forceinline__ unsigned long long rt() { return __builtin_amdgcn_s_memrealtime(); }
__device__ __forceinline__ unsigned f2bf(float f) { unsigned u = __builtin_bit_cast(unsigned, f); return (u + 0x7fffu + ((u >> 16) & 1u)) >> 16; }
__device__ __forceinline__ unsigned pk2(float lo, float hi) { typedef float f32x2_ __attribute__((ext_vector_type(2))); typedef __bf16 bf16x2_ __attribute__((ext_vector_type(2))); const f32x2_ v = {lo, hi}; return __builtin_bit_cast(unsigned, __builtin_convertvector(v, bf16x2_)); }

#define XB_TMO      128
#define XB_XCNT(j)  (256  + 64 * (j))
#define XB_XSUB(j)  (1280 + 64 * (j))
#define XB_XGEN(j)  (2304 + 64 * (j))
#define XB_TOP      3328
#define XB_TOPGEN   3392
#define XCD_BAR_WORDS 3456
#define XB_SPIN_CAP (1u << 18)

__device__ __forceinline__ unsigned xb_ld(unsigned* p)              { return __hip_atomic_load(p, __ATOMIC_RELAXED, __HIP_MEMORY_SCOPE_AGENT); }
__device__ __forceinline__ unsigned xb_add(unsigned* p, unsigned v) { return __hip_atomic_fetch_add(p, v, __ATOMIC_RELAXED, __HIP_MEMORY_SCOPE_AGENT); }
__device__ __forceinline__ unsigned xb_xcc_id() { return (unsigned)__builtin_amdgcn_s_getreg((3 << 11) | 20) & 0xFu; }
#define XB_SPIN(cond, bar) do { unsigned _sp = 0; while (cond) { __builtin_amdgcn_s_sleep(1); \
    if ((++_sp & 255u) == 0u) { if (xb_ld(&(bar)[XB_TMO])) break; if (_sp > XB_SPIN_CAP) { atomicAdd(&(bar)[XB_TMO], 1u); break; } } } } while (0)

struct XcdBarrier {
    unsigned* bar; unsigned x; bool lead;
    volatile LAS unsigned* st;
};

__device__ __forceinline__ XcdBarrier xcd_barrier_post(unsigned* bar, volatile LAS unsigned* st, bool lead) {
    XcdBarrier b; b.bar = bar; b.x = xb_xcc_id(); b.st = st; b.lead = lead;
    if (lead) (void)xb_add(&bar[XB_XCNT(b.x)], 1u);
    return b;
}
__device__ __forceinline__ void xcd_barrier_complete(unsigned* bar, unsigned x, unsigned& nloc, unsigned& nx) {
    const unsigned G = gridDim.x * gridDim.y * gridDim.z;
    unsigned sum, cnt, mine, sp = 0u;
    for (;;) {
        sum = 0u; cnt = 0u; mine = 0u;
#pragma unroll
        for (unsigned j = 0; j < 16; ++j) { const unsigned c = xb_ld(&bar[XB_XCNT(j)]); sum += c; cnt += (c > 0u) ? 1u : 0u; mine = (j == x) ? c : mine; }
        if (sum == G) break;
        __builtin_amdgcn_s_sleep(1);
        if ((++sp & 255u) == 0u) { if (xb_ld(&bar[XB_TMO])) break; if (sp > XB_SPIN_CAP) { atomicAdd(&bar[XB_TMO], 1u); break; } }
    }
    nloc = mine > 0u ? mine : 1u; nx = cnt > 0u ? cnt : 1u;
}

__device__ __forceinline__ void xcd_barrier(const XcdBarrier& b) {
    asm volatile("s_waitcnt vmcnt(0)" ::: "memory");
    __syncthreads();
    if (b.lead) {
        unsigned* bar = b.bar;
        __builtin_amdgcn_s_waitcnt(0);
        unsigned nloc = b.st[0], nx = b.st[1];
        if (nloc == 0u) { xcd_barrier_complete(bar, b.x, nloc, nx); b.st[0] = nloc; b.st[1] = nx; }
        const unsigned old = xb_add(&bar[XB_XSUB(b.x)], 1u);
        const unsigned gen = old / nloc;
        if (old + 1u == (gen + 1u) * nloc) {
            __builtin_amdgcn_fence(__ATOMIC_RELEASE, "agent");
            asm volatile("s_waitcnt vmcnt(0)" ::: "memory");
            const unsigned og = xb_add(&bar[XB_TOP], 1u);
            const unsigned tg = og / nx;
            if (og + 1u == (tg + 1u) * nx) xb_add(&bar[XB_TOPGEN], 1u);
            else XB_SPIN(xb_ld(&bar[XB_TOPGEN]) == tg, bar);
            __builtin_amdgcn_fence(__ATOMIC_ACQUIRE, "agent");
            xb_add(&bar[XB_XGEN(b.x)], 1u);
            asm volatile("s_waitcnt vmcnt(0)" ::: "memory");
        } else {
            XB_SPIN(xb_ld(&bar[XB_XGEN(b.x)]) == gen, bar);
            __builtin_amdgcn_fence(__ATOMIC_ACQUIRE, "agent");
            asm volatile("s_waitcnt vmcnt(0)" ::: "memory");
        }
    }
    __syncthreads();
}

__device__ __forceinline__ void group_barrier(const XcdBarrier& b, unsigned* ctl, unsigned G, unsigned blk, int tid, int arrive_on = -1, int wait_on = -1, unsigned wait_target = 0u, int also_lo = -1, int also_hi = -1) {
    asm volatile("s_waitcnt vmcnt(0)" ::: "memory");
    unsigned mode = b.st[5];
    if (mode == 0u) {
        bool ok = (G == 256u);
#ifdef FORCE_GRID_FALLBACK
        ok = false;
#endif
        if (ok && tid < 256) { const unsigned c = xb_ld(&ctl[CW_CENSUS + tid]), r = xb_ld(&ctl[CW_CENSUS + (tid & 7)]); ok = (c != 0u) && (c == r); }
        if (b.lead) b.st[7] = 1u;
        __syncthreads();
        if (!ok) b.st[7] = 0u;
        __syncthreads();
        mode = b.st[7] ? 1u : 2u;
        __syncthreads();
        if (b.lead) b.st[5] = mode;
    }
    __syncthreads();
    if (mode == 1u) {
        if (b.lead) {
            unsigned* cnt = &ctl[CW_GCNT + 64 * (blk & 63u)];
            const unsigned k = b.st[6] + 1u; b.st[6] = k;
            if (arrive_on >= 0) (void)xb_add(&ctl[CW_DONE + 64 * arrive_on], 1u);
            (void)xb_add(cnt, 1u);
            unsigned* c_lo = also_lo >= 0 ? &ctl[CW_GCNT + 64 * ((also_lo >> 3) + 8 * (also_lo & 7))] : nullptr;
            unsigned* c_hi = (also_hi >= 0 && also_hi != also_lo) ? &ctl[CW_GCNT + 64 * ((also_hi >> 3) + 8 * (also_hi & 7))] : nullptr;
            unsigned* c_w = wait_on >= 0 ? &ctl[CW_DONE + 64 * wait_on] : nullptr;
            const unsigned need = (G / 64u) * k;
            { unsigned sp_ = 0;
              for (;;) {
                  const unsigned v0 = xb_ld(cnt), v1 = c_lo ? xb_ld(c_lo) : need, v2 = c_hi ? xb_ld(c_hi) : need, v3 = c_w ? xb_ld(c_w) : wait_target;
                  if (((v0 >= need) & (v1 >= need) & (v2 >= need) & (v3 >= wait_target)) != 0) break;
                  __builtin_amdgcn_s_sleep(1);
                  if ((++sp_ & 255u) == 0u) { if (xb_ld(&b.bar[XB_TMO])) break; if (sp_ > XB_SPIN_CAP) { atomicAdd(&b.bar[XB_TMO], 1u); break; } } } }
            __builtin_amdgcn_fence(__ATOMIC_ACQUIRE, "agent");
            asm volatile("s_waitcnt vmcnt(0)" ::: "memory");
        }
        __syncthreads();
    } else xcd_barrier(b);
}

__device__ __forceinline__ void guard_wait(const XcdBarrier& b, unsigned* ctl, int idx, unsigned target) {
    if (b.st[5] == 1u) { if (b.lead) XB_SPIN(xb_ld(&ctl[CW_DONE + 64 * idx]) < target, b.bar); __syncthreads(); }
}
struct Frame {
    LAS unsigned char* lds;
    int tid, lane, wave;
    int vcu, G, bx;
    const float* const* in;
    float* out; unsigned char* ws;
};
#define F_WIN ((bf16*)(F.ws + WS_WIN))
#define F_WOUT ((bf16*)(F.ws + WS_WOUT))
#define F_W1 ((bf16*)(F.ws + WS_W1))
#define F_W2 ((bf16*)(F.ws + WS_W2))
#define F_XN ((bf16*)(F.ws + WS_XN))
#define F_Y ((bf16*)(F.ws + WS_Y))
#define F_MIX ((bf16*)(F.ws + WS_MIX))
static __device__ const double ROPE_TURNS[32] = {0.15915494309189535, 0.11934937021124886, 0.08949940160889101, 0.06711508300522726, 0.050329212104487035, 0.03774158471741977, 0.0283021958306234, 0.02122365276477766, 0.015915494309189534, 0.011934937021124886, 0.008949940160889102, 0.006711508300522725, 0.005032921210448704, 0.003774158471741977, 0.00283021958306234, 0.0021223652764777662, 0.0015915494309189536, 0.0011934937021124885, 0.0008949940160889102, 0.0006711508300522726, 0.0005032921210448703, 0.00037741584717419774, 0.00028302195830623395, 0.0002122365276477766, 0.00015915494309189535, 0.00011934937021124886, 8.949940160889102e-05, 6.711508300522725e-05, 5.0329212104487035e-05, 3.774158471741978e-05, 2.8302195830623396e-05, 2.122365276477766e-05};
typedef unsigned long long u64;
#ifdef TPROBE
#define TP_BEGIN(id) unsigned long long tp0_##id = 0; if (TPROBE < 100 && ((id) == 1 || TPROBE == (id))) tp0_##id = __builtin_amdgcn_s_memrealtime();
#define TP_END(id) if (TPROBE < 100 && ((id) == 1 || TPROBE == (id)) && blockIdx.x == 0 && threadIdx.x == 0) { volatile LAS unsigned long long* pa_ = (volatile LAS unsigned long long*)(F.lds + MISC_OFF + 64) + ((id) == 1 ? 0 : 1); *pa_ = *pa_ + (__builtin_amdgcn_s_memrealtime() - tp0_##id); }
#else
#define TP_BEGIN(id)
#define TP_END(id)
#endif
typedef short v4i16_t __attribute__((ext_vector_type(4)));
__device__ __forceinline__ v4i16_t tr_read16(const LAS unsigned char* p) { return __builtin_amdgcn_ds_read_tr16_b64_v4i16((LAS v4i16_t*)p); }
__device__ __forceinline__ void lds_barrier() { asm volatile("s_waitcnt lgkmcnt(0)" ::: "memory"); __builtin_amdgcn_s_barrier(); asm volatile("" ::: "memory"); }
__device__ __forceinline__ float bf2f(unsigned h) { return __uint_as_float(h << 16); }
__device__ __forceinline__ float wave_sum(float v) {
#pragma unroll
    for (int o = 1; o < 64; o <<= 1) v += __shfl_xor(v, o);
    return v;
}
__device__ __forceinline__ float sigmoidf_(float a) { return __builtin_amdgcn_rcpf(1.f + __expf(-a)); }
__device__ __forceinline__ float gelu_tanh(float x) { const float y = 0.7978845608028654f * (x + 0.044715f * x * x * x); return x * __builtin_amdgcn_rcpf(1.f + __expf(-2.f * y)); }
__device__ __forceinline__ void unpack8(const v4u w, float (&f)[8]) {
    f[0] = bf2f(w.x & 0xffffu); f[1] = bf2f(w.x >> 16); f[2] = bf2f(w.y & 0xffffu); f[3] = bf2f(w.y >> 16);
    f[4] = bf2f(w.z & 0xffffu); f[5] = bf2f(w.z >> 16); f[6] = bf2f(w.w & 0xffffu); f[7] = bf2f(w.w >> 16);
}
__device__ __forceinline__ v4u pack8(const float (&f)[8]) { v4u w; w.x = pk2(f[0], f[1]); w.y = pk2(f[2], f[3]); w.z = pk2(f[4], f[5]); w.w = pk2(f[6], f[7]); return w; }

__device__ __forceinline__ void transpose_item(const float* W, int K, int N, bf16* WT, const float* gain, LAS float* scr, int item, int lane) {
    const int nblk = N / 32, kb = item / nblk, nb = item % nblk, k0 = 64 * kb, n0 = 32 * nb;
    float wv[32];
#pragma unroll
    for (int i = 0; i < 32; ++i) { const int kk = 2 * i + (lane >> 5); wv[i] = __builtin_nontemporal_load((const GAS float*)(W + (size_t)(k0 + kk) * N + n0 + (lane & 31))); }
    if (gain) {
#pragma unroll
        for (int i = 0; i < 32; ++i) wv[i] *= gain[k0 + 2 * i + (lane >> 5)]; }
#pragma unroll
    for (int i = 0; i < 32; ++i) scr[(2 * i + (lane >> 5)) * 33 + (lane & 31)] = wv[i];
    LDS_WAIT(); asm volatile("" ::: "memory");
    const int c = lane & 7;
#pragma unroll
    for (int j = 0; j < 4; ++j) { const int n = (lane >> 3) + 8 * j; const LAS float* s = scr + (8 * c) * 33 + n;
        v4u o; o.x = pk2(s[0 * 33], s[1 * 33]); o.y = pk2(s[2 * 33], s[3 * 33]); o.z = pk2(s[4 * 33], s[5 * 33]); o.w = pk2(s[6 * 33], s[7 * 33]);
        *(GAS v4u*)(WT + (size_t)(n0 + n) * K + k0 + 8 * c) = o; }
    LDS_WAIT(); asm volatile("" ::: "memory");
}
__device__ __forceinline__ void prep_weights(Frame& F, int l, int part, int wg0, int nwg) {
    LAS float* scr = (LAS float*)(F.lds + RING_OFF + F.wave * 16384);
    if (F.vcu < wg0 || F.vcu >= wg0 + nwg) return;
    const int gw = (F.vcu - wg0) * NWAVES + F.wave, NGW = nwg * NWAVES;
    const bool even = (l & 1) == 0; const int li = l >> 1, Nin = even ? EVEN_IN : ODD_IN;
    const float* Win = even ? F.in[I_WINE] + (size_t)li * DM * EVEN_IN : F.in[I_WINO] + (size_t)li * DM * ODD_IN;
    const float* Wout = (even ? F.in[I_WOUTE] : F.in[I_WOUTO]) + (size_t)li * DM * DM;
    const float* W1 = F.in[I_W1] + (size_t)l * DM * FF; const float* W2 = F.in[I_W2] + (size_t)l * FF * DM;
    const float* gmix = F.in[I_NMIX] + l * DM; const float* gmlp = F.in[I_NMLP] + l * DM;
    const int I_IN = (DM / 64) * (Nin / 32), I_OUT = (DM / 64) * (DM / 32), I_1 = (DM / 64) * (FF / 32), I_2 = (FF / 64) * (DM / 32);
    if (part == 0) { for (int it = gw; it < I_IN; it += NGW) transpose_item(Win, DM, Nin, F_WIN, gmix, scr, it, F.lane); return; }
    const int NITEMS = I_OUT + I_1 + I_2;
    for (int it = gw; it < NITEMS; it += NGW) {
        int r = it;
        if (r < I_OUT) { transpose_item(Wout, DM, DM, F_WOUT, nullptr, scr, r, F.lane); continue; } r -= I_OUT;
        if (r < I_1) { transpose_item(W1, DM, FF, F_W1, gmlp, scr, r, F.lane); continue; } r -= I_1;
        transpose_item(W2, FF, DM, F_W2, nullptr, scr, r, F.lane);
    }
}
constexpr size_t WS_XB = 220 * MiB;
constexpr size_t WS_SSA = 252 * MiB, WS_SSB = 253 * MiB;
#define F_XB ((bf16*)(F.ws + WS_XB))
constexpr int RST_OFF = RING_BYTES + 1024;
__device__ __forceinline__ void x_to_bf16(Frame& F, const float* src) {
    const int gw = F.vcu * NWAVES + F.wave, NGW = F.G * NWAVES; float* ss = (float*)(F.ws + WS_SSB);
    for (int m = gw; m < M; m += NGW) {
        const GAS f32x4* xr = (const GAS f32x4*)(src + (size_t)m * DM) + F.lane;
        f32x4 v[4]; float s = 0.f;
#pragma unroll
        for (int j = 0; j < 4; ++j) { v[j] = xr[64 * j]; s += (v[j].x * v[j].x + v[j].y * v[j].y) + (v[j].z * v[j].z + v[j].w * v[j].w); }
        s = wave_sum(s); if (F.lane < 16) ss[(size_t)m * 16 + F.lane] = (F.lane == 0) ? s : 0.f;
        GAS u64* o8 = (GAS u64*)(F_XB + (size_t)m * DM) + F.lane;
#pragma unroll
        for (int j = 0; j < 4; ++j) o8[64 * j] = (u64)pk2(v[j].x, v[j].y) | ((u64)pk2(v[j].z, v[j].w) << 32);
    }
}
template <class Sched>
__device__ __forceinline__ void fill_rstd(Frame& F, const Sched& S, const float* ss) {
    LAS float* rst = (LAS float*)(F.lds + RST_OFF); LAS int* pmt = (LAS int*)(F.lds + RST_OFF + 4096);
    const int r = F.tid & 255, half = F.tid >> 8;
#pragma unroll
    for (int j = 0; j < 2; ++j) { const int i = 2 * j + half; pg8::Unit u; const bool ok = S.next(i, u);
        if (ok) { const GAS f32x4* p = (const GAS f32x4*)(ss + (size_t)(u.pm * 256 + r) * 16); const f32x4 a = p[0], b = p[1], c = p[2], d = p[3];
            const float t = ((a[0] + a[1]) + (a[2] + a[3])) + ((b[0] + b[1]) + (b[2] + b[3])) + ((c[0] + c[1]) + (c[2] + c[3])) + ((d[0] + d[1]) + (d[2] + d[3]));
            rst[i * 256 + r] = __builtin_amdgcn_rsqf(t * (1.f / DM) + EPS); }
        if (r == 0) pmt[i] = ok ? u.pm : -1; }
    asm volatile("s_waitcnt vmcnt(0) lgkmcnt(0)" ::: "memory"); __syncthreads();
}

__device__ __forceinline__ void sgu_naive_unit(Frame& F, int e, int unit) {
    const int h = unit & 3, n = (unit >> 2) & 31, b = unit >> 7; const int row0 = b * SEQ + n * 128;
    LAS float* vn = (LAS float*)F.lds;
    const bf16* Y = F_Y; const int tid = F.tid;
    { const int q = tid >> 2, part = tid & 3; const bf16* vp = Y + (size_t)(row0 + q) * EVEN_IN + 512 + h * 128 + part * 32;
      float g[32]; float ss = 0.f;
#pragma unroll
      for (int i = 0; i < 4; ++i) { float f8[8]; unpack8(*(const GAS v4u*)(vp + 8 * i), f8);
#pragma unroll
          for (int j = 0; j < 8; ++j) { const float x = gelu_tanh(f8[j]); g[8 * i + j] = x; ss += x * x; } }
      ss += __shfl_xor(ss, 1); ss += __shfl_xor(ss, 2);
      const float r = __builtin_amdgcn_rsqf(ss * (1.f / 128.f) + EPS); const float* ng = F.in[I_SGUG] + e * 512 + h * 128 + part * 32;
#pragma unroll
      for (int i = 0; i < 32; ++i) vn[q * 129 + part * 32 + i] = g[i] * r * ng[i];
    }
    __syncthreads();
    { const int c = tid & 127, pq = __builtin_amdgcn_readfirstlane(tid >> 7); const float* Ws = F.in[I_SGUW] + (size_t)((e * 4 + h) * 128) * 128; const float* bs = F.in[I_SGUB] + (e * 4 + h) * 128;
      for (int pp = 0; pp < 32; ++pp) { const int p = pq * 32 + pp; const float* wr = Ws + p * 128; float acc = 0.f;
#pragma unroll 8
          for (int q = 0; q < 128; ++q) acc += wr[q] * vn[q * 129 + c];
          const float u = bf2f(Y[(size_t)(row0 + p) * EVEN_IN + h * 128 + c]);
          F_MIX[(size_t)(row0 + p) * DM + h * 128 + c] = (bf16)f2bf(gelu_tanh(u) * (acc + bs[p])); }
    }
    __syncthreads();
}
__device__ __forceinline__ void hgrn_naive(Frame& F, int e, int bh) {
    const int b = bh >> 2, h = bh & 3, tid = F.tid, kq = __builtin_amdgcn_readfirstlane(tid >> 7), v = tid & 127;
    LAS float* red = (LAS float*)F.lds;
    const bf16* Y = F_Y; float* OF = (float*)(F.ws + WS_XN);
    const float* lbl = F.in[I_LBL]; const float* ng = F.in[I_HNG] + e * 512;
    for (int z = 0; z < 2; ++z) {
        float lbv[32], S[32];
#pragma unroll
        for (int k = 0; k < 32; ++k) { const int ch = h * 128 + kq * 32 + k; S[k] = 0.f;
            if (e == 0) lbv[k] = 0.f; else { const float L0 = lbl[(z * 2 + 0) * 512 + ch], L1 = lbl[(z * 2 + 1) * 512 + ch]; lbv[k] = 1.f / (1.f + expf(L0 - L1)); } }
        for (int step = 0; step < SEQ; ++step) {
            const int pos = z ? SEQ - 1 - step : step; const size_t row = (size_t)b * SEQ + pos; const bf16* yr = Y + row * EVEN_IN;
            const float vi = bf2f(yr[1536 + h * 128 + v]); float part = 0.f;
#pragma unroll
            for (int i = 0; i < 4; ++i) { float a8[8], q8[8]; unpack8(*(const GAS v4u*)(yr + 2560 + z * 512 + h * 128 + kq * 32 + 8 * i), a8); unpack8(*(const GAS v4u*)(yr + 1024 + h * 128 + kq * 32 + 8 * i), q8);
#pragma unroll
                for (int j = 0; j < 8; ++j) { const int k = 8 * i + j; const float sg = sigmoidf_(a8[j]); const float f = lbv[k] + (1.f - lbv[k]) * sg, kk = (1.f - lbv[k]) * (1.f - sg);
                    S[k] = f * S[k] + kk * vi; part += q8[j] * S[k]; } }
            red[kq * 128 + v] = part; __syncthreads();
            float o = 0.f;
            if (kq == 0) { o = (red[v] + red[128 + v]) + (red[256 + v] + red[384 + v]);
                if (z == 0) OF[row * 512 + h * 128 + v] = o;
                else { o += OF[row * 512 + h * 128 + v]; const float ss = wave_sum(o * o); if (F.lane == 0) red[512 + F.wave] = ss; } }
            __syncthreads();
            if (z == 1 && kq == 0) { const float tot = red[512] + red[513]; const float r = __builtin_amdgcn_rsqf(tot * (1.f / 128.f) + EPS); const float gv = bf2f(yr[2048 + h * 128 + v]);
                F_MIX[row * DM + 512 + h * 128 + v] = (bf16)f2bf(o * r * ng[h * 128 + v] * gv * sigmoidf_(gv)); }
            __syncthreads();
        }
    }
}
__device__ __forceinline__ void conv_phase(Frame& F, int o) {
    const int gt = F.vcu * (NWAVES * 64) + F.tid, NT = F.G * NWAVES * 64; const float* cw = F.in[I_CONVW] + o * 3 * 512;
    for (int idx = gt; idx < (M / 4) * 64; idx += NT) { const int t0 = (idx >> 6) * 4, c = (idx & 63) * 8, pos0 = t0 & (SEQ - 1); const bf16* yr = F_Y + (size_t)t0 * ODD_IN;
        v4u hr[6], cr[6], br[4];
#pragma unroll
        for (int r = 0; r < 6; ++r) { const bool ok = (pos0 + r - 1 >= 0) && (pos0 + r - 1 < SEQ); const bf16* rp = yr + (ptrdiff_t)(ok ? r - 1 : 0) * ODD_IN; hr[r] = *(const GAS v4u*)(rp + c); cr[r] = *(const GAS v4u*)(rp + 1024 + c); }
#pragma unroll
        for (int r = 0; r < 4; ++r) br[r] = *(const GAS v4u*)(yr + (size_t)r * ODD_IN + 512 + c);
        float w0[8], w1[8], w2[8];
#pragma unroll
        for (int j = 0; j < 8; ++j) { w0[j] = cw[c + j]; w1[j] = cw[512 + c + j]; w2[j] = cw[1024 + c + j]; }
        float z[6][8];
#pragma unroll
        for (int r = 0; r < 6; ++r) { const bool ok = (pos0 + r - 1 >= 0) && (pos0 + r - 1 < SEQ); float hh[8], cg[8]; unpack8(hr[r], hh); unpack8(cr[r], cg);
#pragma unroll
            for (int j = 0; j < 8; ++j) z[r][j] = ok ? hh[j] * cg[j] : 0.f; }
#pragma unroll
        for (int r = 0; r < 4; ++r) { float bg[8], r8[8]; unpack8(br[r], bg);
#pragma unroll
            for (int j = 0; j < 8; ++j) r8[j] = bg[j] * (w0[j] * z[r][j] + w1[j] * z[r + 1][j] + w2[j] * z[r + 2][j]);
            *(GAS v4u*)(F_MIX + (size_t)(t0 + r) * DM + c) = pack8(r8); } }
}
__device__ __forceinline__ void qk_prep_phase(Frame& F, int o) {
    const int gw = F.vcu * NWAVES + F.wave, NGW = F.G * NWAVES, lane = F.lane;
    bf16* QR = (bf16*)(F.ws + WS_XN); bf16* KR = QR + (size_t)M * 512;
    const int d0 = (lane & 7) * 8; const bool hi = d0 >= 32;
    double inv[8];
#pragma unroll
    for (int j = 0; j < 8; ++j) inv[j] = ROPE_TURNS[(d0 + j) & 31];
    float gq[8], gk[8];
#pragma unroll
    for (int j = 0; j < 8; ++j) { gq[j] = F.in[I_QG][o * 64 + d0 + j]; gk[j] = F.in[I_KG][o * 64 + d0 + j]; }
    for (int it0 = gw * 4; it0 < 2 * M; it0 += NGW * 4) {
        v4u raw[4];
#pragma unroll
        for (int u = 0; u < 4; ++u) { const int it = it0 + u, t = it >> 1, which = it & 1; raw[u] = *(const GAS v4u*)(F_Y + (size_t)t * ODD_IN + 1536 + which * 512 + lane * 8); }
#pragma unroll
        for (int u = 0; u < 4; ++u) { const int it = it0 + u, t = it >> 1, which = it & 1, pos = t & (SEQ - 1);
            float x[8]; unpack8(raw[u], x); float ss = 0.f;
#pragma unroll
            for (int j = 0; j < 8; ++j) ss += x[j] * x[j];
            ss += __shfl_xor(ss, 1); ss += __shfl_xor(ss, 2); ss += __shfl_xor(ss, 4);
            const float r = __builtin_amdgcn_rsqf(ss * (1.f / 64.f) + EPS); const float sc = which ? 1.f : 0.125f * LOG2E; float y[8];
#pragma unroll
            for (int j = 0; j < 8; ++j) { x[j] = x[j] * r * (which ? gk[j] : gq[j]); const float p = __shfl_xor(x[j], 4); double tt = (double)pos * inv[j]; tt -= floor(tt); const float tf = (float)tt; const float cs = __builtin_amdgcn_cosf(tf), sn = __builtin_amdgcn_sinf(tf);
                y[j] = (hi ? (x[j] * cs + p * sn) : (x[j] * cs - p * sn)) * sc; }
            *(GAS v4u*)((which ? KR : QR) + (size_t)t * 512 + lane * 8) = pack8(y); }
    }
}
constexpr size_t WS_VT = WS_Y + 96 * MiB;
__device__ __forceinline__ void vt_phase(Frame& F) {
    LAS unsigned short* T = (LAS unsigned short*)F.lds;
    const int tid = F.tid;
    for (int it = F.vcu; it < 16 * 64; it += F.G) { const int bh = it >> 6, tt = it & 63, b = bh >> 2, h = bh & 3; const size_t tok0 = (size_t)b * SEQ + tt * 64;
        lds_barrier();
#pragma unroll
        for (int i = 0; i < 2; ++i) { const int idx = tid + 512 * i, row = idx >> 4, c16 = idx & 15; const v4u w = *(const GAS v4u*)(F_Y + (tok0 + row) * ODD_IN + 2560 + h * 128 + c16 * 8);
            LAS unsigned* d = (LAS unsigned*)(T + row * 130 + c16 * 8); d[0] = w.x; d[1] = w.y; d[2] = w.z; d[3] = w.w; }
        lds_barrier();
        { const int dv = tid >> 2, part = tid & 3;
          unsigned short v[16];
#pragma unroll
          for (int sl = 0; sl < 16; ++sl) { const int hi_ = sl >> 3, j = sl & 7; const int key = 16 * part + (j & 3) + 8 * (j >> 2) + 4 * hi_; v[sl] = T[key * 130 + dv]; }
          v4u o0, o1; o0.x = v[0] | ((unsigned)v[1] << 16); o0.y = v[2] | ((unsigned)v[3] << 16); o0.z = v[4] | ((unsigned)v[5] << 16); o0.w = v[6] | ((unsigned)v[7] << 16);
          o1.x = v[8] | ((unsigned)v[9] << 16); o1.y = v[10] | ((unsigned)v[11] << 16); o1.z = v[12] | ((unsigned)v[13] << 16); o1.w = v[14] | ((unsigned)v[15] << 16);
          bf16* dst = (bf16*)(F.ws + WS_VT) + ((size_t)(bh * 128 + dv)) * SEQ + tt * 64 + 16 * part;
          *(GAS v4u*)dst = o0; *(GAS v4u*)(dst + 8) = o1; }
    }
    lds_barrier();
}
__device__ __forceinline__ void attn_naive_unit(Frame& F, int o, int l_layer, int unit) {
    const int qb = unit & 31, h = (unit >> 5) & 3, b = unit >> 7, tid = F.tid; const int r = tid & 127, c = (tid >> 7) & 1, half = tid >> 8; const int qrow = b * SEQ + qb * 128 + r;
    const bf16* QR = (const bf16*)(F.ws + WS_XN); const bf16* KR = QR + (size_t)M * 512; const bf16* Y = F_Y;
    LAS float* Kt = (LAS float*)F.lds; LAS float* Vt = Kt + 64 * 128; LAS float* red = Vt + 64 * 128;
    float mq = 0.f, mk = 0.f, d1 = 0.f, d2 = 0.f;
    for (int i = 0; i < 64; ++i) { mq = fmaxf(mq, fabsf(F.in[I_QG][o * 64 + i])); mk = fmaxf(mk, fabsf(F.in[I_KG][o * 64 + i])); d1 += F.in[I_LQ1][o * 64 + i] * F.in[I_LK1][o * 64 + i]; d2 += F.in[I_LQ2][o * 64 + i] * F.in[I_LK2][o * 64 + i]; }
    const float linit = 0.8f - 0.6f * expf(-0.3f * (float)l_layer); const float lam = expf(d1) - expf(d2) + linit;
    const float m2 = 8.f * mq * mk * LOG2E;
    float q[64], O[64]; float l = 0.f;
    { const bf16* qp = QR + (size_t)qrow * 512 + h * 128 + c * 64;
#pragma unroll
      for (int i = 0; i < 8; ++i) { float f8[8]; unpack8(*(const GAS v4u*)(qp + 8 * i), f8);
#pragma unroll
          for (int j = 0; j < 8; ++j) q[8 * i + j] = f8[j]; } }
#pragma unroll
    for (int i = 0; i < 64; ++i) O[i] = 0.f;
    for (int kt = 0; kt < SEQ / 64; ++kt) {
        __syncthreads();
        { const int rr = tid >> 3, ch = tid & 7; const size_t krow = (size_t)b * SEQ + kt * 64 + rr; float f8[8];
#pragma unroll
          for (int hh = 0; hh < 2; ++hh) { unpack8(*(const GAS v4u*)(KR + krow * 512 + h * 128 + hh * 64 + ch * 8), f8);
#pragma unroll
              for (int j = 0; j < 8; ++j) Kt[rr * 128 + hh * 64 + ch * 8 + j] = f8[j];
              unpack8(*(const GAS v4u*)(Y + krow * ODD_IN + 2560 + h * 128 + hh * 64 + ch * 8), f8);
#pragma unroll
              for (int j = 0; j < 8; ++j) Vt[rr * 128 + hh * 64 + ch * 8 + j] = f8[j]; } }
        __syncthreads();
        for (int j = 0; j < 64; ++j) { float s = -m2;
#pragma unroll
            for (int d = 0; d < 64; d += 4) { const f32x4 kv = *(const LAS f32x4*)(Kt + j * 128 + c * 64 + d); s += q[d] * kv.x + q[d + 1] * kv.y + q[d + 2] * kv.z + q[d + 3] * kv.w; }
            const float p = exp2f(s); l += p;
#pragma unroll
            for (int d = 0; d < 64; d += 4) { const f32x4 vv = *(const LAS f32x4*)(Vt + j * 128 + half * 64 + d); O[d] += p * vv.x; O[d + 1] += p * vv.y; O[d + 2] += p * vv.z; O[d + 3] += p * vv.w; } }
    }
    __syncthreads();
    const float il = (c ? lam : 1.f) / l;
    if (c == 1) {
#pragma unroll
        for (int i = 0; i < 64; ++i) Kt[(half * 64 + i) * 128 + r] = O[i] * il; }
    __syncthreads();
    float ss = 0.f;
    if (c == 0) {
#pragma unroll
        for (int i = 0; i < 64; ++i) { O[i] = O[i] * il - Kt[(half * 64 + i) * 128 + r]; ss += O[i] * O[i]; }
        red[half * 128 + r] = ss; }
    __syncthreads();
    if (c == 0) { const float tot = red[r] + red[128 + r]; const float rr = (1.f - linit) * __builtin_amdgcn_rsqf(tot * (1.f / 128.f) + EPS); const float* sg = F.in[I_DNG] + o * 128 + half * 64;
        bf16* op = F_MIX + (size_t)qrow * DM + 512 + h * 128 + half * 64;
#pragma unroll
        for (int i = 0; i < 8; ++i) { float f8[8];
#pragma unroll
            for (int j = 0; j < 8; ++j) f8[j] = O[8 * i + j] * rr * sg[8 * i + j];
            *(GAS v4u*)(op + 8 * i) = pack8(f8); } }
    __syncthreads();
}
typedef float f32x16 __attribute__((ext_vector_type(16)));
constexpr size_t WS_APARK = WS_Y + 112 * MiB;
__device__ __forceinline__ void attn_params(Frame& F, int o, int l_layer, float& m2, float& lam, float& linit) {
    float mq = 0.f, mk = 0.f, d1 = 0.f, d2 = 0.f;
    for (int i = 0; i < 64; ++i) { mq = fmaxf(mq, fabsf(F.in[I_QG][o * 64 + i])); mk = fmaxf(mk, fabsf(F.in[I_KG][o * 64 + i])); d1 += F.in[I_LQ1][o * 64 + i] * F.in[I_LK1][o * 64 + i]; d2 += F.in[I_LQ2][o * 64 + i] * F.in[I_LK2][o * 64 + i]; }
    linit = 0.8f - 0.6f * expf(-0.3f * (float)l_layer); lam = expf(d1) - expf(d2) + linit; m2 = 8.f * mq * mk * LOG2E;
}
__device__ __forceinline__ int attn_lane(const Frame& F) { int t = F.tid; asm volatile("" : "+v"(t)); return t & 63; }
#define ATT_SB() __builtin_amdgcn_sched_barrier(0)
#define ATT_EXP4(P, i) do { P[4 * (i)] = __builtin_amdgcn_exp2f(P[4 * (i)]); P[4 * (i) + 1] = __builtin_amdgcn_exp2f(P[4 * (i) + 1]); P[4 * (i) + 2] = __builtin_amdgcn_exp2f(P[4 * (i) + 2]); P[4 * (i) + 3] = __builtin_amdgcn_exp2f(P[4 * (i) + 3]); } while (0)
#define ATT_ADD4(acc, P, i) do { acc += P[4 * (i)]; acc += P[4 * (i) + 1]; acc += P[4 * (i) + 2]; acc += P[4 * (i) + 3]; } while (0)
#define ATT_PIN() asm volatile("" : "+v"(N0), "+v"(N1), "+v"(O[0]), "+v"(O[1]), "+v"(O[2]), "+v"(O[3]), "+v"(l0), "+v"(l1), "+v"(pa[0]), "+v"(pa[1]), "+v"(pa[2]), "+v"(pa[3]))
#define ATT_CVT8(dst, P, q) do { v4u w_; w_.x = pg8::cvt_pk_bf16(P[8 * (q) + 0], P[8 * (q) + 1]); w_.y = pg8::cvt_pk_bf16(P[8 * (q) + 2], P[8 * (q) + 3]); w_.z = pg8::cvt_pk_bf16(P[8 * (q) + 4], P[8 * (q) + 5]); w_.w = pg8::cvt_pk_bf16(P[8 * (q) + 6], P[8 * (q) + 7]); dst = __builtin_bit_cast(bf16x8, w_); } while (0)
#define ATT_MFMA(a, b, c) __builtin_amdgcn_mfma_f32_32x32x16_bf16(a, b, c, 0, 0, 0)
template <class Dma>
__device__ __forceinline__ void attn_step(const LAS unsigned char* Kn, const LAS unsigned char* Vt, const int (&kofs)[4], const bf16x8 (&qf)[4], const f32x16& cm2, float& l0, float& l1,
                                          f32x16 (&O)[4], bf16x8 (&pa)[4], const Dma& dma) {
    bf16x8 kf0[4], kf1[4], va[4], vb[4];
#pragma unroll
    for (int ds = 0; ds < 4; ++ds) kf0[ds] = *(const LAS bf16x8*)(Kn + kofs[ds]);
#pragma unroll
    for (int ds = 0; ds < 4; ++ds) kf1[ds] = *(const LAS bf16x8*)(Kn + 4096 + kofs[ds]);
    f32x16 N0, N1;
    N0 = ATT_MFMA(kf0[0], qf[0], cm2);
    N0 = ATT_MFMA(kf0[1], qf[1], N0);
    N0 = ATT_MFMA(kf0[2], qf[2], N0);
    N0 = ATT_MFMA(kf0[3], qf[3], N0);
    N1 = ATT_MFMA(kf1[0], qf[0], cm2);
#pragma unroll
    for (int db = 0; db < 4; ++db) va[db] = *(const LAS bf16x8*)(Vt + db * 4096 + kofs[0]);
    ATT_PIN();
    N1 = ATT_MFMA(kf1[1], qf[1], N1); ATT_EXP4(N0, 0); ATT_PIN();
    N1 = ATT_MFMA(kf1[2], qf[2], N1); ATT_EXP4(N0, 1); ATT_PIN();
    N1 = ATT_MFMA(kf1[3], qf[3], N1); ATT_EXP4(N0, 2); ATT_PIN();
    dma();
    O[0] = ATT_MFMA(va[0], pa[0], O[0]);
#pragma unroll
    for (int db = 0; db < 4; ++db) vb[db] = *(const LAS bf16x8*)(Vt + db * 4096 + kofs[1]);
    ATT_EXP4(N0, 3); ATT_PIN();
    O[1] = ATT_MFMA(va[1], pa[0], O[1]); ATT_EXP4(N1, 0); ATT_PIN();
    O[2] = ATT_MFMA(va[2], pa[0], O[2]); ATT_EXP4(N1, 1); ATT_PIN();
    O[3] = ATT_MFMA(va[3], pa[0], O[3]);
#pragma unroll
    for (int db = 0; db < 4; ++db) va[db] = *(const LAS bf16x8*)(Vt + db * 4096 + kofs[2]);
    ATT_ADD4(l0, N0, 0); ATT_ADD4(l0, N0, 1); ATT_PIN();
    O[0] = ATT_MFMA(vb[0], pa[1], O[0]); ATT_EXP4(N1, 2); ATT_PIN();
    O[1] = ATT_MFMA(vb[1], pa[1], O[1]); ATT_EXP4(N1, 3); ATT_PIN();
    O[2] = ATT_MFMA(vb[2], pa[1], O[2]); ATT_CVT8(pa[0], N0, 0); ATT_ADD4(l0, N0, 2); ATT_PIN();
    O[3] = ATT_MFMA(vb[3], pa[1], O[3]);
#pragma unroll
    for (int db = 0; db < 4; ++db) vb[db] = *(const LAS bf16x8*)(Vt + db * 4096 + kofs[3]);
    ATT_ADD4(l0, N0, 3); ATT_PIN();
    O[0] = ATT_MFMA(va[0], pa[2], O[0]); ATT_CVT8(pa[1], N0, 1); ATT_PIN();
    O[1] = ATT_MFMA(va[1], pa[2], O[1]); ATT_ADD4(l1, N1, 0); ATT_ADD4(l1, N1, 1); ATT_PIN();
    O[2] = ATT_MFMA(va[2], pa[2], O[2]); ATT_ADD4(l1, N1, 2); ATT_ADD4(l1, N1, 3); ATT_PIN();
    O[3] = ATT_MFMA(va[3], pa[2], O[3]); ATT_PIN();
    O[0] = ATT_MFMA(vb[0], pa[3], O[0]); ATT_CVT8(pa[2], N1, 0); ATT_PIN();
    O[1] = ATT_MFMA(vb[1], pa[3], O[1]); ATT_PIN();
    O[2] = ATT_MFMA(vb[2], pa[3], O[2]); ATT_PIN();
    O[3] = ATT_MFMA(vb[3], pa[3], O[3]); ATT_PIN();
    ATT_CVT8(pa[3], N1, 1);
}
__device__ __forceinline__ void attn_step_last(const LAS unsigned char* Vt, const int (&kofs)[4], f32x16 (&O)[4], const bf16x8 (&pa)[4]) {
    bf16x8 va[4], vb[4];
#pragma unroll
    for (int db = 0; db < 4; ++db) va[db] = *(const LAS bf16x8*)(Vt + db * 4096 + kofs[0]);
#pragma unroll
    for (int db = 0; db < 4; ++db) vb[db] = *(const LAS bf16x8*)(Vt + db * 4096 + kofs[1]);
    ATT_SB();
#pragma unroll
    for (int db = 0; db < 4; ++db) O[db] = ATT_MFMA(va[db], pa[0], O[db]);
#pragma unroll
    for (int db = 0; db < 4; ++db) va[db] = *(const LAS bf16x8*)(Vt + db * 4096 + kofs[2]);
    ATT_SB();
#pragma unroll
    for (int db = 0; db < 4; ++db) O[db] = ATT_MFMA(vb[db], pa[1], O[db]);
#pragma unroll
    for (int db = 0; db < 4; ++db) vb[db] = *(const LAS bf16x8*)(Vt + db * 4096 + kofs[3]);
    ATT_SB();
#pragma unroll
    for (int db = 0; db < 4; ++db) O[db] = ATT_MFMA(va[db], pa[2], O[db]);
#pragma unroll
    for (int db = 0; db < 4; ++db) O[db] = ATT_MFMA(vb[db], pa[3], O[db]);
    ATT_SB();
}
__device__ __forceinline__ void attn_pass32(Frame& F, int b, int h, int c, int row0, float m2, f32x16 (&O)[4], float& l) {
    const int lane = attn_lane(F), wave = F.wave, r32 = lane & 31, hi = lane >> 5;
    const bf16* QR = (const bf16*)(F.ws + WS_XN); const bf16* KR = QR + (size_t)M * 512;
    LAS unsigned char* Kb = F.lds; LAS unsigned char* Vb = F.lds + 32768;
    bf16x8 qf[4];
#pragma unroll
    for (int ds = 0; ds < 4; ++ds) qf[ds] = *(const GAS bf16x8*)(QR + (size_t)(row0 + r32) * 512 + h * 128 + c * 64 + ds * 16 + hi * 8);
#pragma unroll
    for (int db = 0; db < 4; ++db)
#pragma unroll
        for (int r = 0; r < 16; ++r) O[db][r] = 0.f;
    const int kr = 8 * wave + (lane >> 3), cs = lane & 7;
    const char* ksrc = (const char*)(KR + (size_t)(b * SEQ + kr) * 512 + h * 128 + c * 64 + ((cs ^ ((kr >> 1) & 7)) * 8));
    const char* vsrc[2];
#pragma unroll
    for (int i = 0; i < 2; ++i) { const int vr = 16 * wave + 8 * i + (lane >> 3); vsrc[i] = (const char*)((const bf16*)(F.ws + WS_VT) + ((size_t)((b * 4 + h) * 128 + vr)) * SEQ + ((cs ^ ((vr >> 1) & 7)) * 8)); }
    const unsigned kdst = (unsigned)(size_t)(Kb + wave * 1024), vdst = (unsigned)(size_t)(Vb + wave * 2048);
#define ATT_GLDS(gsrc, ldsdst) do { unsigned keep_; asm volatile("s_mov_b32 %0, m0\n\ts_mov_b32 m0, %2\n\ts_nop 0\n\tglobal_load_lds_dwordx4 %1, off\n\ts_mov_b32 m0, %0" : "=&s"(keep_) : "v"(gsrc), "s"(ldsdst) : "memory"); } while (0)
#define ATT_DMA(t, slot) do { ATT_GLDS(ksrc + (size_t)(t) * (64 * 512 * 2), (unsigned)__builtin_amdgcn_readfirstlane(kdst + (slot) * 8192)); \
        ATT_GLDS(vsrc[0] + (size_t)(t) * (64 * 2), (unsigned)__builtin_amdgcn_readfirstlane(vdst + (slot) * 16384)); ATT_GLDS(vsrc[1] + (size_t)(t) * (64 * 2), (unsigned)__builtin_amdgcn_readfirstlane(vdst + (slot) * 16384 + 1024)); } while (0)
    asm volatile("s_waitcnt vmcnt(0)" : "+v"(qf[0]), "+v"(qf[1]), "+v"(qf[2]), "+v"(qf[3]) :: "memory");
    ATT_DMA(0, 0); ATT_DMA(1, 1); ATT_DMA(2, 2);
    int kofs[4];
#pragma unroll
    for (int i = 0; i < 4; ++i) kofs[i] = r32 * 128 + (((2 * i + hi) ^ ((r32 >> 1) & 7)) << 4);
    f32x16 cm2;
#pragma unroll
    for (int r = 0; r < 16; ++r) cm2[r] = -m2;
    asm volatile("s_waitcnt vmcnt(6)" ::: "memory"); __builtin_amdgcn_s_barrier(); asm volatile("" ::: "memory");
    bf16x8 pa[4]; float l0 = 0.f, l1 = 0.f;
    { bf16x8 kf[2][4]; f32x16 P0, P1;
#pragma unroll
      for (int kh = 0; kh < 2; ++kh)
#pragma unroll
          for (int ds = 0; ds < 4; ++ds) kf[kh][ds] = *(const LAS bf16x8*)(Kb + kh * 4096 + kofs[ds]);
      P0 = ATT_MFMA(kf[0][0], qf[0], cm2); P1 = ATT_MFMA(kf[1][0], qf[0], cm2);
#pragma unroll
      for (int ds = 1; ds < 4; ++ds) { P0 = ATT_MFMA(kf[0][ds], qf[ds], P0); P1 = ATT_MFMA(kf[1][ds], qf[ds], P1); }
#pragma unroll
      for (int i = 0; i < 4; ++i) { ATT_EXP4(P0, i); ATT_EXP4(P1, i); }
#pragma unroll
      for (int i = 0; i < 4; ++i) { ATT_ADD4(l0, P0, i); ATT_ADD4(l1, P1, i); }
      ATT_CVT8(pa[0], P0, 0); ATT_CVT8(pa[1], P0, 1); ATT_CVT8(pa[2], P1, 0); ATT_CVT8(pa[3], P1, 1); }
    asm volatile("s_waitcnt vmcnt(5) lgkmcnt(0)" ::: "memory"); __builtin_amdgcn_s_barrier(); asm volatile("" ::: "memory");
    int cur = 0, nxt1 = 1, nxt3 = 3;
    for (int kt = 0; kt < SEQ / 64 - 1; ++kt) {
        const int left = SEQ / 64 - 1 - kt;
        attn_step(Kb + nxt1 * 8192, Vb + cur * 16384, kofs, qf, cm2, l0, l1, O, pa, [&]() { if (left >= 3) ATT_DMA(kt + 3, nxt3); });
        if (left >= 3) asm volatile("s_waitcnt vmcnt(5) lgkmcnt(0)" ::: "memory"); else if (left == 2) asm volatile("s_waitcnt vmcnt(2) lgkmcnt(0)" ::: "memory"); else asm volatile("s_waitcnt vmcnt(0) lgkmcnt(0)" ::: "memory");
        __builtin_amdgcn_s_barrier(); asm volatile("" ::: "memory");
        nxt3 = cur; cur = nxt1; nxt1 = (nxt1 + 1) & 3;
    }
    attn_step_last(Vb + cur * 16384, kofs, O, pa);
    l = l0 + l1;
    asm volatile("s_waitcnt lgkmcnt(0)" ::: "memory"); __builtin_amdgcn_s_barrier(); asm volatile("" ::: "memory");
#undef ATT_DMA
#undef ATT_GLDS
}
__device__ __forceinline__ void attn_unit(Frame& F, int o, int unit, float m2, float lam, float linit) {
    TP_BEGIN(23)
    const int qb = unit & 15, h = (unit >> 4) & 3, b = unit >> 6;
    const int wave = F.wave;
    const int row0 = b * SEQ + qb * 256 + wave * 32;
    f32x16 O[4]; float l;
    attn_pass32(F, b, h, 0, row0, m2, O, l);
    { v4u* park = (v4u*)(F.ws + WS_APARK) + ((size_t)unit * NWAVES + wave) * 8 * 64 + attn_lane(F);
      l += __shfl_xor(l, 32); const float il = __builtin_amdgcn_rcpf(l);
#pragma unroll
      for (int db = 0; db < 4; ++db)
#pragma unroll
          for (int i = 0; i < 2; ++i) { v4u w; w.x = pg8::cvt_pk_bf16(O[db][8 * i] * il, O[db][8 * i + 1] * il); w.y = pg8::cvt_pk_bf16(O[db][8 * i + 2] * il, O[db][8 * i + 3] * il);
              w.z = pg8::cvt_pk_bf16(O[db][8 * i + 4] * il, O[db][8 * i + 5] * il); w.w = pg8::cvt_pk_bf16(O[db][8 * i + 6] * il, O[db][8 * i + 7] * il); *(GAS v4u*)(park + (2 * db + i) * 64) = w; } }
    attn_pass32(F, b, h, 1, row0, m2, O, l);
    const int lane = attn_lane(F), r32 = lane & 31, hi = lane >> 5;
    const v4u* park = (const v4u*)(F.ws + WS_APARK) + ((size_t)unit * NWAVES + wave) * 8 * 64 + lane;
    v4u pk[8];
#pragma unroll
    for (int i = 0; i < 8; ++i) pk[i] = *(const GAS v4u*)(park + i * 64);
    l += __shfl_xor(l, 32); const float il1 = lam * __builtin_amdgcn_rcpf(l);
    float ss = 0.f;
#pragma unroll
    for (int db = 0; db < 4; ++db)
#pragma unroll
        for (int i = 0; i < 2; ++i) { const v4u w4 = pk[2 * db + i];
#pragma unroll
            for (int j = 0; j < 4; ++j) { const unsigned w = w4[j]; const int r = 8 * i + 2 * j; const float a0 = __uint_as_float(w << 16) - O[db][r] * il1, a1 = __uint_as_float(w & 0xffff0000u) - O[db][r + 1] * il1; O[db][r] = a0; O[db][r + 1] = a1; ss += a0 * a0 + a1 * a1; } }
    ss += __shfl_xor(ss, 32);
    const float rr = (1.f - linit) * __builtin_amdgcn_rsqf(ss * (1.f / 128.f) + EPS);
    const float* sg = F.in[I_DNG] + o * 128;
    bf16* op = F_MIX + (size_t)(row0 + r32) * DM + 512 + h * 128;
    typedef unsigned u32x2 __attribute__((ext_vector_type(2)));
#pragma unroll
    for (int db = 0; db < 4; ++db)
#pragma unroll
        for (int i = 0; i < 4; ++i) { const int dv = 32 * db + 8 * i + 4 * hi; const f32x4 g4 = *(const GAS f32x4*)(sg + dv);
            u32x2 w; w.x = pg8::cvt_pk_bf16(O[db][4 * i] * rr * g4[0], O[db][4 * i + 1] * rr * g4[1]); w.y = pg8::cvt_pk_bf16(O[db][4 * i + 2] * rr * g4[2], O[db][4 * i + 3] * rr * g4[3]);
            *(GAS u32x2*)(op + dv) = w; }
    TP_END(23)
}
#if defined(P3_PROBE) && (P3_PROBE == 1)
#define P3_DRYLOADS 1
#else
#define P3_DRYLOADS 0
#endif
#ifndef P3_PROBE
#define P3_PROBE 0
#endif
constexpr int HS_QH = 0, HS_KH = 16384, HS_VV = 32768, HS_PL = 49152, HS_VEC = 57344, HS_SEG = 58880, HS_SET = 65536;
constexpr size_t WS_HST = WS_XN;
constexpr size_t WS_HD = WS_CTL + 512 * 1024;
constexpr size_t WS_OFB = WS_Y + 112 * MiB;
constexpr int HG_GT = RING_BYTES + 8192;
__device__ __forceinline__ float row16_sum(float v) {
    v += __builtin_bit_cast(float, __builtin_amdgcn_update_dpp(0, __builtin_bit_cast(int, v), 0x128, 0xf, 0xf, false));
    v += __builtin_bit_cast(float, __builtin_amdgcn_update_dpp(0, __builtin_bit_cast(int, v), 0x124, 0xf, 0xf, false));
    v += __builtin_bit_cast(float, __builtin_amdgcn_update_dpp(0, __builtin_bit_cast(int, v), 0x122, 0xf, 0xf, false));
    v += __builtin_bit_cast(float, __builtin_amdgcn_update_dpp(0, __builtin_bit_cast(int, v), 0x121, 0xf, 0xf, false));
    return v;
}
__device__ __forceinline__ void hgrn_glds(const void* gsrc, unsigned ldsdst) { unsigned keep_; asm volatile("s_mov_b32 %0, m0\n\ts_mov_b32 m0, %2\n\ts_nop 0\n\tglobal_load_lds_dwordx4 %1, off\n\ts_mov_b32 m0, %0" : "=&s"(keep_) : "v"(gsrc), "s"(ldsdst) : "memory"); }
__device__ __forceinline__ int hsw(int row, int byte) { return row * 256 + ((((byte >> 4) ^ (((row & 3) << 2) | ((row >> 2) & 3))) << 4) | (byte & 15)); }
__device__ __forceinline__ int psw(int row, int byte) { return row * 128 + ((((byte >> 4) ^ ((row >> 1) & 7)) << 4) | (byte & 15)); }
typedef short bf16x4 __attribute__((ext_vector_type(4)));
typedef float f32x2 __attribute__((ext_vector_type(2)));
__device__ __forceinline__ float hgrn_lb(Frame& F, int e, int z, int ch) { if (e == 0) return 0.f; const float* lbl = F.in[I_LBL]; return 1.f / (1.f + __expf(lbl[(z * 2 + 0) * 512 + ch] - lbl[(z * 2 + 1) * 512 + ch])); }

struct HgrnRegs { unsigned a2[8], q2[8]; v4u vv[2]; };
template <int MODE, int z>
__device__ __forceinline__ void hgrn_prep_load(Frame& F, int tid, size_t tok0, int h, HgrnRegs& R) {
    const int k2 = tid & 63, seg = F.wave; const bf16* Y = F_Y;
#pragma unroll
    for (int i = 0; i < 8; ++i) { const bf16* yr = Y + (tok0 + 8 * seg + i) * EVEN_IN + h * 128 + 2 * k2;
        R.a2[i] = __builtin_nontemporal_load((const GAS unsigned*)(yr + 2560 + z * 512)); R.q2[i] = (MODE == 3) ? __builtin_nontemporal_load((const GAS unsigned*)(yr + 1024)) : 0u; }
#pragma unroll
    for (int i = 0; i < 2; ++i) { const int idx = tid + 512 * i, row = idx >> 4, c16 = idx & 15; R.vv[i] = *(const GAS v4u*)(Y + (tok0 + row) * EVEN_IN + 1536 + h * 128 + c16 * 8); }
}
template <int MODE, int z>
__device__ __forceinline__ void hgrn_prep(Frame& F, int tid, LAS unsigned char* set, const HgrnRegs& R, float lb0, float lb1, float& tot0, float& tot1) {
    const int k2 = tid & 63, seg = F.wave;
    LAS float* SEG = (LAS float*)(set + HS_SEG); LAS float* VEC = (LAS float*)(set + HS_VEC);
    const unsigned (&a2)[8] = R.a2; const unsigned (&q2)[8] = R.q2; const v4u (&vv)[2] = R.vv;
    float lf[8][2], kk[8][2], qv[8][2];
#pragma unroll
    for (int i = 0; i < 8; ++i) {
        const float a0 = bf2f(a2[i] & 0xffffu), a1 = bf2f(a2[i] >> 16);
        const float s0 = sigmoidf_(a0), s1 = sigmoidf_(a1);
        lf[i][0] = 0.6931471805599453f * __builtin_amdgcn_logf(lb0 + (1.f - lb0) * s0); lf[i][1] = 0.6931471805599453f * __builtin_amdgcn_logf(lb1 + (1.f - lb1) * s1);
        kk[i][0] = (1.f - lb0) * (1.f - s0); kk[i][1] = (1.f - lb1) * (1.f - s1);
        qv[i][0] = bf2f(q2[i] & 0xffffu); qv[i][1] = bf2f(q2[i] >> 16); }
#pragma unroll
    for (int i = 0; i < 2; ++i) { const int idx = tid + 512 * i, row = idx >> 4, c16 = idx & 15; *(LAS v4u*)(set + HS_VV + hsw(row, c16 * 16)) = vv[i]; }
    float bl[8][2]; float t0 = 0.f, t1 = 0.f;
#pragma unroll
    for (int ii = 0; ii < 8; ++ii) { const int i = z ? 7 - ii : ii; t0 += lf[i][0]; t1 += lf[i][1]; bl[i][0] = t0; bl[i][1] = t1; }
    *(LAS f32x2*)(SEG + seg * 128 + 2 * k2) = (f32x2){t0, t1};
    lds_barrier();
    float base0 = 0.f, base1 = 0.f, r0 = 0.f, r1 = 0.f, e0 = 0.f, e1 = 0.f;
#pragma unroll
    for (int s = 0; s < 8; ++s) { const f32x2 sv = *(const LAS f32x2*)(SEG + s * 128 + 2 * k2);
        const bool before = z ? (s > seg) : (s < seg); if (before) { base0 += sv.x; base1 += sv.y; }
        const bool inref = z ? (s >= 4) : (s <= 3); if (inref) { r0 += sv.x; r1 += sv.y; }
        e0 += sv.x; e1 += sv.y; }
    if (MODE == 3) {
#pragma unroll
        for (int i = 0; i < 8; ++i) { const int row = 8 * seg + i;
            const float b0 = base0 + bl[i][0], b1 = base1 + bl[i][1];
            const float E0 = __expf(fminf(b0 - r0, 80.f)), E1 = __expf(fminf(b1 - r1, 80.f)), G0 = __expf(fminf(r0 - b0, 80.f)), G1 = __expf(fminf(r1 - b1, 80.f));
            *(LAS unsigned*)(set + HS_QH + hsw(row, 4 * k2)) = pk2(qv[i][0] * E0, qv[i][1] * E1);
            *(LAS unsigned*)(set + HS_KH + hsw(row, 4 * k2)) = pk2(kk[i][0] * G0, kk[i][1] * G1); }
        if (seg == 0) { *(LAS f32x2*)(VEC + 2 * k2) = (f32x2){__expf(r0), __expf(r1)}; *(LAS f32x2*)(VEC + 128 + 2 * k2) = (f32x2){__expf(e0 - r0), __expf(e1 - r1)}; *(LAS f32x2*)(VEC + 256 + 2 * k2) = (f32x2){__expf(e0), __expf(e1)}; }
    } else {
#pragma unroll
        for (int i = 0; i < 8; ++i) { const int row = 8 * seg + i;
            const float b0 = base0 + bl[i][0], b1 = base1 + bl[i][1];
            *(LAS unsigned*)(set + HS_KH + hsw(row, 4 * k2)) = pk2(kk[i][0] * __expf(e0 - b0 + tot0), kk[i][1] * __expf(e1 - b1 + tot1)); }
        tot0 += e0; tot1 += e1;
    }
}
__device__ __forceinline__ void hgrn_vfrags(LAS unsigned char* set, int w, int g, int qp, int pp, bf16x8 (&Vf)[2]) {
#pragma unroll
    for (int s = 0; s < 2; ++s) { const int row = 32 * s + 8 * g + qp;
        const v4i16_t lo = tr_read16(set + HS_VV + hsw(row, 32 * w + 8 * pp)), hi = tr_read16(set + HS_VV + hsw(row + 4, 32 * w + 8 * pp));
        Vf[s] = (bf16x8){lo[0], lo[1], lo[2], lo[3], hi[0], hi[1], hi[2], hi[3]}; }
}
template <bool PLAIN = false>
__device__ __forceinline__ void hgrn_ktv(LAS unsigned char* set, int g, int qp, int pp, const bf16x8 (&Vf)[2], f32x4 (&T)[8]) {
#pragma unroll
    for (int kb = 0; kb < 8; ++kb)
#pragma unroll
        for (int s = 0; s < 2; ++s) { const int row = 32 * s + 8 * g + qp;
            const v4i16_t lo = PLAIN ? *(const LAS v4i16_t*)(set + HS_KH + hsw(row, 32 * kb + 8 * pp)) : tr_read16(set + HS_KH + hsw(row, 32 * kb + 8 * pp)), hi = PLAIN ? *(const LAS v4i16_t*)(set + HS_KH + hsw(row + 4, 32 * kb + 8 * pp)) : tr_read16(set + HS_KH + hsw(row + 4, 32 * kb + 8 * pp));
            const bf16x8 kf = (bf16x8){lo[0], lo[1], lo[2], lo[3], hi[0], hi[1], hi[2], hi[3]};
            T[kb] = __builtin_amdgcn_mfma_f32_16x16x32_bf16(kf, Vf[s], T[kb], 0, 0, 0); }
}
template <int z>
__device__ __forceinline__ void hgrn_p1_dir(Frame& F, int e, int item) {
    const int gI = item & 15, h = (item >> 4) & 3, b = (item >> 6) & 3;
    const int w = F.wave, k2 = F.tid & 63;
    const float lb0 = hgrn_lb(F, e, z, h * 128 + 2 * k2), lb1 = hgrn_lb(F, e, z, h * 128 + 2 * k2 + 1);
    float tot0 = 0.f, tot1 = 0.f;
    f32x4 U[8];
#pragma unroll
    for (int kb = 0; kb < 8; ++kb) U[kb] = (f32x4){0.f, 0.f, 0.f, 0.f};
    HgrnRegs R; hgrn_prep_load<1, z>(F, F.tid, (size_t)b * SEQ + gI * 256 + (z ? 0 : 3) * 64, h, R);
#pragma unroll 1
    for (int ci = 0; ci < 4; ++ci) { const int cI = z ? ci : 3 - ci; (void)cI;
        int tid_l = F.tid; asm volatile("" : "+v"(tid_l));
        const int fr = tid_l & 15, g = (tid_l >> 4) & 3, qp = fr >> 2, pp = fr & 3;
        LAS unsigned char* set = F.lds + (ci & 1) * HS_SET;
        hgrn_prep<1, z>(F, tid_l, set, R, lb0, lb1, tot0, tot1);
        if (ci + 1 < 4) hgrn_prep_load<1, z>(F, tid_l, (size_t)b * SEQ + gI * 256 + (z ? ci + 1 : 2 - ci) * 64, h, R);
        lds_barrier();
        bf16x8 Vf[2]; hgrn_vfrags(set, w, g, qp, pp, Vf);
        hgrn_ktv(set, g, qp, pp, Vf, U); }
    float* Ug = (float*)(F.ws + WS_HST) + (size_t)item * 16384;
#pragma unroll
    for (int kb = 0; kb < 8; ++kb) *(GAS f32x4*)(Ug + ((w * 8 + kb) * 64 + F.lane) * 4) = U[kb];
    if (w == 0) { float* Dg = (float*)(F.ws + WS_HD) + (size_t)item * 128; Dg[2 * k2] = __expf(tot0); Dg[2 * k2 + 1] = __expf(tot1); }
    lds_barrier();
}
__device__ __forceinline__ void hgrn_p1_item(Frame& F, int e, int item) { if (item >> 8) hgrn_p1_dir<1>(F, e, item); else hgrn_p1_dir<0>(F, e, item); }
__device__ __forceinline__ void hgrn_scan(Frame& F) {
    const int gt = F.vcu * (NWAVES * 64) + F.tid, NT = F.G * NWAVES * 64;
    float* ST = (float*)(F.ws + WS_HST); const float* Dg = (const float*)(F.ws + WS_HD);
    for (int i = gt; i < 32 * 4096; i += NT) {
        const int seq = i >> 12, el = (i & 4095) * 4, k = 16 * ((i >> 6) & 7) + 4 * ((i & 63) >> 4), z = seq >> 4;
        f32x4 uv[16], dv[16];
#pragma unroll
        for (int gi = 0; gi < 16; ++gi) { const int gI = z ? 15 - gi : gi; const size_t it = (size_t)seq * 16 + gI; uv[gi] = *(const GAS f32x4*)(ST + it * 16384 + el); dv[gi] = *(const GAS f32x4*)(Dg + it * 128 + k); }
        f32x4 S = (f32x4){0.f, 0.f, 0.f, 0.f}; asm volatile("" : "+v"(S));
#pragma unroll
        for (int gi = 0; gi < 16; ++gi) { const int gI = z ? 15 - gi : gi; const size_t it = (size_t)seq * 16 + gI; *(GAS f32x4*)(ST + it * 16384 + el) = S; S = dv[gi] * S + uv[gi]; }
    }
}
__device__ __forceinline__ void hgrn_scan_issue(Frame& F, f32x4 (&uv)[16]) {
    const int i = F.vcu * (NWAVES * 64) + F.tid; const float* ST = (const float*)(F.ws + WS_HST);
    const int seq = i >> 12, el = (i & 4095) * 4, z = seq >> 4;
#pragma unroll
    for (int gi = 0; gi < 16; ++gi) { const int gI = z ? 15 - gi : gi; const size_t it = (size_t)seq * 16 + gI; uv[gi] = *(const GAS f32x4*)(ST + it * 16384 + el); }
}
__device__ __forceinline__ void hgrn_scan_finish(Frame& F, f32x4 (&uv)[16]) {
    int tid = F.tid; asm volatile("" : "+v"(tid));
    const int i = F.vcu * (NWAVES * 64) + tid; float* ST = (float*)(F.ws + WS_HST); const float* Dg = (const float*)(F.ws + WS_HD);
    const int seq = i >> 12, el = (i & 4095) * 4, k = 16 * ((i >> 6) & 7) + 4 * ((i & 63) >> 4), z = seq >> 4;
    f32x4 dv[16];
#pragma unroll
    for (int gi = 0; gi < 16; ++gi) { const int gI = z ? 15 - gi : gi; const size_t it = (size_t)seq * 16 + gI; dv[gi] = *(const GAS f32x4*)(Dg + it * 128 + k); }
    f32x4 S = (f32x4){0.f, 0.f, 0.f, 0.f}; asm volatile("" : "+v"(S));
#pragma unroll
    for (int gi = 0; gi < 16; ++gi) { const int gI = z ? 15 - gi : gi; const size_t it = (size_t)seq * 16 + gI; *(GAS f32x4*)(ST + it * 16384 + el) = S; S = dv[gi] * S + uv[gi]; }
}
template <int z>
__device__ __forceinline__ void hgrn_p3_dir(Frame& F, int e, int b, int h, int gI, bool dry) {
    const int w = F.wave, k2 = F.tid & 63; const int unit_ = (b * 4 + h) * 16 + gI;
    const float lb0 = hgrn_lb(F, e, z, h * 128 + 2 * k2), lb1 = hgrn_lb(F, e, z, h * 128 + 2 * k2 + 1);
    v4u* OFB = (v4u*)(F.ws + WS_OFB);
    const float ngv = F.in[I_HNG][e * 512 + h * 128 + 16 * w + (F.lane & 15)];
    f32x4 S[8];
    TP_BEGIN(12)
    { const float* Sin = (const float*)(F.ws + WS_HST) + (size_t)(((z * 4 + b) * 4 + h) * 16 + gI) * 16384;
#pragma unroll
      for (int kb = 0; kb < 8; ++kb) S[kb] = *(const GAS f32x4*)(Sin + ((w * 8 + kb) * 64 + F.lane) * 4); }
    HgrnRegs R; hgrn_prep_load<3, z>(F, F.tid, (size_t)b * SEQ + gI * 256 + (z ? 3 : 0) * 64, h, R);
    asm volatile("s_waitcnt vmcnt(0)" : "+v"(S[0]), "+v"(S[7]) :: "memory"); TP_END(12)
#pragma unroll 1
    for (int ci = 0; ci < 4; ++ci) { const int cI = z ? 3 - ci : ci; const size_t tok0 = (size_t)b * SEQ + gI * 256 + cI * 64;
        int tid_l = F.tid; asm volatile("" : "+v"(tid_l));
        const int fr = tid_l & 15, g = (tid_l >> 4) & 3, qp = fr >> 2, pp = fr & 3;
        LAS unsigned char* set = F.lds + (ci & 1) * HS_SET;
        float dm0 = 0.f, dm1 = 0.f;
        TP_BEGIN(4) hgrn_prep<3, z>(F, tid_l, set, R, lb0, lb1, dm0, dm1); TP_END(4)
        v4u pk[2];
        if (z == 1) { const v4u* pp_ = OFB + ((size_t)((unit_ * 4 + cI) * NWAVES + w) * 2) * 64 + (tid_l & 63); pk[0] = *(const GAS v4u*)pp_; pk[1] = *(const GAS v4u*)(pp_ + 64); }
        if (ci + 1 < 4) hgrn_prep_load<3, z>(F, tid_l, (size_t)b * SEQ + gI * 256 + (z ? 2 - ci : ci + 1) * 64, h, R);
        lds_barrier();
        if (z == 1) {
#pragma unroll
            for (int i = 0; i < 2; ++i) { const int p = 2 * w + i, row = 4 * p + ((tid_l & 63) >> 4), c16 = ((tid_l & 63) & 15) ^ ((row >> 2) & 3);
                hgrn_glds(F_Y + (tok0 + row) * EVEN_IN + 2048 + h * 128 + c16 * 8, (unsigned)__builtin_amdgcn_readfirstlane((unsigned)(size_t)(F.lds + HG_GT) + p * 1024)); } }
        TP_BEGIN(5)
        { const int tb = w >> 1;
#pragma unroll
          for (int jj = 0; jj < 2; ++jj) { const int jb = 2 * (w & 1) + jj; f32x4 acc = (f32x4){0.f, 0.f, 0.f, 0.f};
              const bool live = z ? (jb >= tb) : (jb <= tb);
              if (live) {
#pragma unroll
                  for (int s = 0; s < 4; ++s) { const bf16x8 kf = *(const LAS bf16x8*)(set + HS_KH + hsw(16 * jb + fr, 64 * s + 16 * g)); const bf16x8 qf = *(const LAS bf16x8*)(set + HS_QH + hsw(16 * tb + fr, 64 * s + 16 * g));
                      acc = __builtin_amdgcn_mfma_f32_16x16x32_bf16(kf, qf, acc, 0, 0, 0); }
#pragma unroll
                  for (int r = 0; r < 4; ++r) { const int j = 16 * jb + 4 * g + r, t = 16 * tb + fr; const bool keep = z ? (j >= t) : (j <= t); acc[r] = keep ? acc[r] : 0.f; } }
              typedef unsigned u32x2 __attribute__((ext_vector_type(2)));
              u32x2 pw; pw.x = pg8::cvt_pk_bf16(acc[0], acc[1]); pw.y = pg8::cvt_pk_bf16(acc[2], acc[3]);
              *(LAS u32x2*)(set + HS_PL + psw(16 * tb + fr, 32 * jb + 8 * g)) = pw; } }
        const LAS float* VEC = (const LAS float*)(set + HS_VEC);
        bf16x8 Sb[4];
#pragma unroll
        for (int s = 0; s < 4; ++s) { const f32x4 ea = *(const LAS f32x4*)(VEC + 32 * s + 4 * g), eb = *(const LAS f32x4*)(VEC + 32 * s + 16 + 4 * g); const f32x4 x = S[2 * s] * ea, y = S[2 * s + 1] * eb;
            v4u pw; pw.x = pg8::cvt_pk_bf16(x[0], x[1]); pw.y = pg8::cvt_pk_bf16(x[2], x[3]); pw.z = pg8::cvt_pk_bf16(y[0], y[1]); pw.w = pg8::cvt_pk_bf16(y[2], y[3]); Sb[s] = __builtin_bit_cast(bf16x8, pw); }
        bf16x8 Vf[2]; hgrn_vfrags(set, w, g, qp, pp, Vf);
        lds_barrier();
        TP_END(5) TP_BEGIN(6)
        f32x4 o[4];
#pragma unroll
        for (int tb = 0; tb < 4; ++tb) { f32x4 acc = (f32x4){0.f, 0.f, 0.f, 0.f}; const int row = 16 * tb + fr;
#pragma unroll
            for (int s = 0; s < 4; ++s) { const bf16x4 lo = *(const LAS bf16x4*)(set + HS_QH + hsw(row, 64 * s + 8 * g)), hi = *(const LAS bf16x4*)(set + HS_QH + hsw(row, 64 * s + 32 + 8 * g));
                const bf16x8 qf = (bf16x8){lo[0], lo[1], lo[2], lo[3], hi[0], hi[1], hi[2], hi[3]};
                acc = __builtin_amdgcn_mfma_f32_16x16x32_bf16(qf, Sb[s], acc, 0, 0, 0); }
#pragma unroll
            for (int s = 0; s < 2; ++s) { const bf16x8 pf = *(const LAS bf16x8*)(set + HS_PL + psw(row, 64 * s + 16 * g));
                acc = __builtin_amdgcn_mfma_f32_16x16x32_bf16(pf, Vf[s], acc, 0, 0, 0); }
            o[tb] = acc; }
        TP_END(6) TP_BEGIN(7)
        { f32x4 T[8];
#pragma unroll
          for (int kb = 0; kb < 8; ++kb) T[kb] = (f32x4){0.f, 0.f, 0.f, 0.f};
          if (P3_PROBE == 4 && dry) hgrn_ktv<true>(set, g, qp, pp, Vf, T); else if (!(P3_PROBE == 3 && dry)) hgrn_ktv(set, g, qp, pp, Vf, T);
#pragma unroll
          for (int kb = 0; kb < 8; ++kb) { const f32x4 dd = *(const LAS f32x4*)(VEC + 256 + 16 * kb + 4 * g), ee = *(const LAS f32x4*)(VEC + 128 + 16 * kb + 4 * g); S[kb] = dd * S[kb] + ee * T[kb]; } }
        TP_END(7) TP_BEGIN(8) TP_BEGIN(10)
        if (z == 0) {
            v4u* pp_ = OFB + ((size_t)((unit_ * 4 + cI) * NWAVES + w) * 2) * 64 + (tid_l & 63);
#pragma unroll
            for (int i = 0; i < 2; ++i) { v4u pw; pw.x = pg8::cvt_pk_bf16(o[2 * i][0], o[2 * i][1]); pw.y = pg8::cvt_pk_bf16(o[2 * i][2], o[2 * i][3]); pw.z = pg8::cvt_pk_bf16(o[2 * i + 1][0], o[2 * i + 1][1]); pw.w = pg8::cvt_pk_bf16(o[2 * i + 1][2], o[2 * i + 1][3]);
                *(GAS v4u*)(pp_ + 64 * i) = pw; }
        } else {
            LAS float* red = (LAS float*)(set + HS_SEG);
            TP_BEGIN(40)
#pragma unroll
            for (int tb = 0; tb < 4; ++tb)
#pragma unroll
                for (int r = 0; r < 4; ++r) { { const unsigned w2_ = pk[tb >> 1][2 * (tb & 1) + (r >> 1)]; o[tb][r] += (r & 1) ? __uint_as_float(w2_ & 0xffff0000u) : __uint_as_float(w2_ << 16); }
                    float ss = row16_sum(o[tb][r] * o[tb][r]);
                    if (fr == 0) red[(tb * 16 + 4 * g + r) * 8 + w] = ss; }
            TP_END(40) TP_BEGIN(41)
            asm volatile("s_waitcnt vmcnt(0)" ::: "memory");
            lds_barrier();
            TP_END(41) TP_BEGIN(42)
#pragma unroll
            for (int tb = 0; tb < 4; ++tb)
#pragma unroll
                for (int r = 0; r < 4; ++r) { const int t = tb * 16 + 4 * g + r; const f32x4 a = *(const LAS f32x4*)(red + t * 8), bq = *(const LAS f32x4*)(red + t * 8 + 4);
                    const float tot = (a[0] + a[1]) + (a[2] + a[3]) + (bq[0] + bq[1]) + (bq[2] + bq[3]); const float rr = __builtin_amdgcn_rsqf(tot * (1.f / 128.f) + EPS);
                    const size_t row = tok0 + t; const float gv = bf2f(*(const LAS unsigned short*)(F.lds + HG_GT + t * 256 + ((((2 * w + (fr >> 3)) ^ ((t >> 2) & 3)) << 4) | ((2 * fr) & 15))));
                    { const float ov_ = o[tb][r] * rr * ngv * gv * sigmoidf_(gv); if (!(P3_PROBE == 1 && dry)) F_MIX[row * DM + 512 + h * 128 + 16 * w + fr] = (bf16)f2bf(ov_); else asm volatile("" :: "v"(ov_)); } }
            TP_END(42)
        }
    if (z == 0) { TP_END(8) } else { TP_END(10) } }
    lds_barrier();
}
__device__ __forceinline__ void hgrn_p3_unit(Frame& F, int e, int unit, bool dry = false) {
    const int gI = unit & 15, h = (unit >> 4) & 3, b = unit >> 6;
    TP_BEGIN(9) hgrn_p3_dir<0>(F, e, b, h, gI, dry);
    asm volatile("s_waitcnt vmcnt(0)" ::: "memory"); __syncthreads();
    hgrn_p3_dir<1>(F, e, b, h, gI, dry); TP_END(9)
}
__device__ __forceinline__ void sgu_load_w(Frame& F, int e, int h) {
    const float* Ws = F.in[I_SGUW] + (size_t)((e * 4 + h) * 128) * 128; const int tid = F.tid;
#pragma unroll
    for (int i = 0; i < 4; ++i) { const int idx = tid + 512 * i, row = idx >> 4, c16 = idx & 15;
        const f32x4 a = *(const GAS f32x4*)(Ws + row * 128 + c16 * 8), bq = *(const GAS f32x4*)(Ws + row * 128 + c16 * 8 + 4);
        v4u w; w.x = pk2(a[0], a[1]); w.y = pk2(a[2], a[3]); w.z = pk2(bq[0], bq[1]); w.w = pk2(bq[2], bq[3]);
        *(LAS v4u*)(F.lds + hsw(row, c16 * 16)) = w; }
    if (tid < 128) ((LAS float*)(F.lds + 65536))[tid] = F.in[I_SGUB][(e * 4 + h) * 128 + tid];
}
__device__ __forceinline__ void sgu_unit(Frame& F, int e, int unit) {
    const int h = unit & 3, n = (unit >> 2) & 31, b = unit >> 7; const size_t row0 = (size_t)b * SEQ + n * 128;
    LAS unsigned char* WT = F.lds; LAS unsigned char* VN = F.lds + 32768;
    const bf16* Y = F_Y; int tid = F.tid; asm volatile("" : "+v"(tid));
    const int lane = tid & 63, w = F.wave, fr = lane & 15, g = lane >> 4, qp = fr >> 2, pp = fr & 3;
    { const int q = tid >> 2, part = tid & 3; const bf16* vp = Y + (row0 + q) * EVEN_IN + 512 + h * 128 + part * 32;
      float gl[32]; float ss = 0.f;
#pragma unroll
      for (int i = 0; i < 4; ++i) { float f8[8]; unpack8(*(const GAS v4u*)(vp + 8 * i), f8);
#pragma unroll
          for (int j = 0; j < 8; ++j) { const float x = gelu_tanh(f8[j]); gl[8 * i + j] = x; ss += x * x; } }
      ss += __shfl_xor(ss, 1); ss += __shfl_xor(ss, 2);
      const float r = __builtin_amdgcn_rsqf(ss * (1.f / 128.f) + EPS); const float* ng = F.in[I_SGUG] + e * 512 + h * 128 + part * 32;
#pragma unroll
      for (int i = 0; i < 4; ++i) { float f8[8];
#pragma unroll
          for (int j = 0; j < 8; ++j) f8[j] = gl[8 * i + j] * r * ng[8 * i + j];
          *(LAS v4u*)(VN + hsw(q, part * 64 + i * 16)) = pack8(f8); } }
    lds_barrier();
    bf16x8 Bf[4];
#pragma unroll
    for (int s = 0; s < 4; ++s) { const int row = 32 * s + 8 * g + qp;
        const v4i16_t lo = tr_read16(VN + hsw(row, 32 * w + 8 * pp)), hi = tr_read16(VN + hsw(row + 4, 32 * w + 8 * pp));
        Bf[s] = (bf16x8){lo[0], lo[1], lo[2], lo[3], hi[0], hi[1], hi[2], hi[3]}; }
    const LAS float* bs = (const LAS float*)(F.lds + 65536);
    unsigned short ur[32];
#pragma unroll
    for (int i = 0; i < 32; ++i) { const int p = 16 * (i >> 2) + 4 * g + (i & 3); ur[i] = Y[(row0 + p) * EVEN_IN + h * 128 + 16 * w + fr]; }
#pragma unroll
    for (int pb = 0; pb < 8; ++pb) { f32x4 acc = (f32x4){0.f, 0.f, 0.f, 0.f};
#pragma unroll
        for (int s = 0; s < 4; ++s) { const bf16x8 af = *(const LAS bf16x8*)(WT + hsw(16 * pb + fr, 64 * s + 16 * g)); acc = __builtin_amdgcn_mfma_f32_16x16x32_bf16(af, Bf[s], acc, 0, 0, 0); }
        const f32x4 b4 = *(const LAS f32x4*)(bs + 16 * pb + 4 * g);
#pragma unroll
        for (int r = 0; r < 4; ++r) { const int p = 16 * pb + 4 * g + r; const float u = bf2f(ur[pb * 4 + r]);
            F_MIX[(row0 + p) * DM + h * 128 + 16 * w + fr] = (bf16)f2bf(gelu_tanh(u) * (acc[r] + b4[r])); } }
    lds_barrier();
}
__device__ __forceinline__ void sgu_phase(Frame& F, int e) {
    int hprev = -1;
    if (F.G == 256) {
        const int x = F.bx & 7, j = F.bx >> 3, b = x >> 1, h = j & 3, n0 = 16 * (x & 1) + (j >> 2);
        lds_barrier(); sgu_load_w(F, e, h);
        sgu_unit(F, e, b * 128 + n0 * 4 + h); sgu_unit(F, e, b * 128 + (n0 + 8) * 4 + h);
        return; }
    for (int u = F.bx; u < 512; u += F.G) { const int h = u & 3; if (h != hprev) { lds_barrier(); sgu_load_w(F, e, h); hprev = h; } sgu_unit(F, e, u); }
}
#ifndef TP_SCALE
#define TP_SCALE 32.f
#define TP_OFFS 0.f
#endif
#ifndef TP_BLK
#define TP_BLK 0
#endif
#ifndef SCAN_OVERLAP
#define SCAN_OVERLAP 0
#endif
#ifndef BARCAT
#define BARCAT -1
#endif
constexpr int NPH = 1 + 2 * 7 + 2 * 6;
struct Args { const float* in[N_IN]; float* out; unsigned char* ws; int ph_lo, ph_hi, li, pad; };
__global__ void __launch_bounds__(NWAVES * 64, 2) fwd_kernel(Args args) {
    extern __shared__ __attribute__((aligned(16))) unsigned char lds[];
    const int wv_ = __builtin_amdgcn_readfirstlane((int)threadIdx.x >> 6);
#define MK_TID(dst) do { int ln_; asm volatile("v_mbcnt_lo_u32_b32 %0, -1, 0\n\tv_mbcnt_hi_u32_b32 %0, -1, %0" : "=v"(ln_)); (dst) = wv_ * 64 + ln_; } while (0)
    { int t0_; MK_TID(t0_);
      for (int u = t0_; u < (LDS_BYTES - LDSCTL_OFF) / 4; u += NWAVES * 64) ((LAS unsigned*)((LAS unsigned char*)lds + LDSCTL_OFF))[u] = 0u;
      __syncthreads();
      if (t0_ == 0) ((gu32*)(args.ws + WS_CTL))[CW_CENSUS + blockIdx.x] = xb_xcc_id() + 1u;
      if (args.ph_hi - args.ph_lo > 1) (void)xcd_barrier_post((unsigned*)((gu32*)(args.ws + WS_CTL) + CW_BAR), (volatile LAS unsigned*)((LAS unsigned char*)lds + MISC_OFF) + 8, t0_ == 0); }
    const int lo = args.ph_lo, hi = args.ph_hi; const int cat_ = -1; (void)cat_;
    int pc = 0;
#if defined(TPROBE) && TPROBE >= 100
    const unsigned long long tk0_ = __builtin_amdgcn_s_memrealtime();
#define TPH_T0 const unsigned long long tph0_ = __builtin_amdgcn_s_memrealtime(); const unsigned long long tpc0_ = __builtin_amdgcn_s_memtime();
#define TPH_T1 if (TPROBE == 200 + cat_ && blockIdx.x == 0 && threadIdx.x == 0) { volatile LAS unsigned long long* pa_ = (volatile LAS unsigned long long*)((LAS unsigned char*)lds + MISC_OFF + 64); pa_[2] = pa_[2] + (__builtin_amdgcn_s_memrealtime() - tph0_); pa_[1] = pa_[1] + (__builtin_amdgcn_s_memtime() - tpc0_); } \
    if (TPROBE == 100 + cat_ && blockIdx.x == 0 && threadIdx.x == 0) { volatile LAS unsigned long long* pa_ = (volatile LAS unsigned long long*)((LAS unsigned char*)lds + MISC_OFF + 64) + 1; *pa_ = *pa_ + (__builtin_amdgcn_s_memrealtime() - tph0_); }
#else
#define TPH_T0
#define TPH_T1
#endif
#if defined(TPROBE) && TPROBE == 150
#define GB_T0 const unsigned long long gb0_ = __builtin_amdgcn_s_memrealtime();
#define GB_T1 if (blockIdx.x == TP_BLK && bb.lead && (BARCAT < 0 || cat_ == BARCAT)) { volatile LAS unsigned long long* pa_ = (volatile LAS unsigned long long*)((LAS unsigned char*)lds + MISC_OFF + 64) + 1; *pa_ = *pa_ + (__builtin_amdgcn_s_memrealtime() - gb0_); }
#else
#define GB_T0
#define GB_T1
#endif
#define GRID_BARRIER() do { unsigned long long wsb_ = (unsigned long long)args.ws; unsigned b0_ = (unsigned)wsb_, b1_ = (unsigned)(wsb_ >> 32); asm volatile("" : "+v"(b0_), "+v"(b1_)); b0_ = __builtin_amdgcn_readfirstlane(b0_); b1_ = __builtin_amdgcn_readfirstlane(b1_);   \
        XcdBarrier bb; bb.bar = (unsigned*)((gu32*)((unsigned char*)(((unsigned long long)b1_ << 32) | b0_) + WS_CTL) + CW_BAR); bb.x = xb_xcc_id(); bb.st = (volatile LAS unsigned*)((LAS unsigned char*)lds + MISC_OFF) + 8; { int tb_; MK_TID(tb_); bb.lead = tb_ == 0; } GB_T0 xcd_barrier(bb); GB_T1 } while (0)
#define GROUP_BARRIER_X(ARR, WON, WTG, ALO, AHI) do { unsigned long long wsb_ = (unsigned long long)args.ws; unsigned b0_ = (unsigned)wsb_, b1_ = (unsigned)(wsb_ >> 32); asm volatile("" : "+v"(b0_), "+v"(b1_)); b0_ = __builtin_amdgcn_readfirstlane(b0_); b1_ = __builtin_amdgcn_readfirstlane(b1_); \
        unsigned* ctl_ = (unsigned*)((gu32*)((unsigned char*)(((unsigned long long)b1_ << 32) | b0_) + WS_CTL)); XcdBarrier bb; bb.bar = ctl_ + CW_BAR; bb.x = xb_xcc_id(); bb.st = (volatile LAS unsigned*)((LAS unsigned char*)lds + MISC_OFF) + 8; int tb_; MK_TID(tb_); bb.lead = tb_ == 0; \
        group_barrier(bb, ctl_, gridDim.x, blockIdx.x, tb_, (ARR), (WON), (WTG), (ALO), (AHI)); } while (0)
#define GROUP_BARRIER() GROUP_BARRIER_X(-1, -1, 0u, -1, -1)
#define GUARD_WAIT(IDX, TGT) do { unsigned long long wsb_ = (unsigned long long)args.ws; unsigned b0_ = (unsigned)wsb_, b1_ = (unsigned)(wsb_ >> 32); asm volatile("" : "+v"(b0_), "+v"(b1_)); b0_ = __builtin_amdgcn_readfirstlane(b0_); b1_ = __builtin_amdgcn_readfirstlane(b1_); \
        unsigned* ctl_ = (unsigned*)((gu32*)((unsigned char*)(((unsigned long long)b1_ << 32) | b0_) + WS_CTL)); XcdBarrier bb; bb.bar = ctl_ + CW_BAR; bb.x = 0u; bb.st = (volatile LAS unsigned*)((LAS unsigned char*)lds + MISC_OFF) + 8; int tb_; MK_TID(tb_); bb.lead = tb_ == 0; \
        guard_wait(bb, ctl_, (IDX), (TGT)); } while (0)
#ifdef PROBE_DUP
#define PH_REP_OPEN for (int rep_ = 0; rep_ < ((cat_ == PROBE_DUP) ? 2 : 1); ++rep_) { if (rep_) GRID_BARRIER();
#define PH_REP_CLOSE }
#define PH_FIRST(x) if (!rep_) { x; }
#define PH_ISDUP (cat_ == PROBE_DUP && rep_ == 0)
#else
#define PH_REP_OPEN {
#define PH_REP_CLOSE }
#define PH_FIRST(x) x;
#define PH_ISDUP false
#endif
#define PH_BEGIN(CAT) if (pc >= lo && pc < hi) { const int cat_ = (CAT); (void)cat_; TPH_T0 PH_REP_OPEN Frame F; { int bx_ = blockIdx.x, tid_; MK_TID(tid_); unsigned long long ws_ = (unsigned long long)args.ws, out_ = (unsigned long long)args.out; unsigned w0 = (unsigned)ws_, w1 = (unsigned)(ws_ >> 32), o0 = (unsigned)out_, o1 = (unsigned)(out_ >> 32); \
        asm volatile("" : "+v"(bx_), "+v"(w0), "+v"(w1), "+v"(o0), "+v"(o1), "+v"(tid_)); bx_ = __builtin_amdgcn_readfirstlane(bx_); w0 = __builtin_amdgcn_readfirstlane(w0); w1 = __builtin_amdgcn_readfirstlane(w1); o0 = __builtin_amdgcn_readfirstlane(o0); o1 = __builtin_amdgcn_readfirstlane(o1); \
        F.lds = (LAS unsigned char*)lds; F.tid = tid_; F.lane = tid_ & 63; F.wave = __builtin_amdgcn_readfirstlane(tid_ >> 6); F.G = gridDim.x; F.in = args.in; \
        F.bx = bx_; F.ws = (unsigned char*)(((unsigned long long)w1 << 32) | w0); F.out = (float*)(((unsigned long long)o1 << 32) | o0); F.vcu = (F.G % 8 == 0) ? (bx_ % 8) * (F.G / 8) + bx_ / 8 : bx_; }
#ifdef PROBE_XBAR
#define PH_XBAR if (cat_ == 9) for (int xb_ = 0; xb_ < PROBE_XBAR; ++xb_) GRID_BARRIER();
#else
#define PH_XBAR
#endif
#define PH_END   PH_REP_CLOSE if (pc + 1 < hi) GRID_BARRIER(); PH_XBAR TPH_T1 } ++pc;
#ifndef NO_GROUP_BARRIER
#define PH_END_G PH_REP_CLOSE if (pc + 1 < hi) GROUP_BARRIER(); PH_XBAR TPH_T1 } ++pc;
#define PH_END_C(cond) PH_REP_CLOSE if (pc + 1 < hi) { if (cond) GROUP_BARRIER(); else GRID_BARRIER(); } PH_XBAR TPH_T1 } ++pc;
#define PH_END_GX(ARR, WON, WTG) PH_REP_CLOSE if (pc + 1 < hi) GROUP_BARRIER_X(ARR, WON, WTG, -1, -1); PH_XBAR TPH_T1 } ++pc;
#define PH_END_GP(ALO, AHI) PH_REP_CLOSE if (pc + 1 < hi) GROUP_BARRIER_X(1, -1, 0u, ALO, AHI); PH_XBAR TPH_T1 } ++pc;
#else
#define PH_END_G PH_END
#define PH_END_C(cond) PH_END
#define PH_END_GX(ARR, WON, WTG) PH_END
#define PH_END_GP(ALO, AHI) PH_END
#endif
#define OWN_UNIT(bx_) ((((((bx_) & 7) >> 1) * 4 + ((bx_) >> 6)) * 16) + 8 * ((bx_) & 1) + (((bx_) >> 3) & 7))
    for (int l = 0; l < DEPTH; ++l) {
        const bool even = (l & 1) == 0; const int li = l >> 1; const int Nin = even ? EVEN_IN : ODD_IN;
        if (l == 0) { PH_BEGIN(0) prep_weights(F, 0, 0, 0, F.G); x_to_bf16(F, F.in[I_X]); PH_END }
        PH_BEGIN(1) { pg8::Gemm g{F_XB, F_WIN, M, Nin, DM, 0, F.tid}; pg8::StaticOrder S; S.init(M, Nin, F.G, F.bx);
            fill_rstd(F, S, (const float*)(F.ws + WS_SSB));
            pg8::EpiBf16S<0> E{F_Y, Nin, (const LAS float*)(F.lds + RST_OFF), (const LAS int*)(F.lds + RST_OFF + 4096), false};
            pg8::gemm_phase<pg8::EpiBf16S<0>, pg8::StaticOrder, true, true>(F.lds + RING_OFF, g, S, E); }
            GUARD_WAIT(1, gridDim.x * (unsigned)l);
            if (even && F.G == 256) { if (F.bx >= 128) { const int sv = F.vcu; F.vcu = F.bx - 128; prep_weights(F, l, 1, 0, 128); F.vcu = sv; } } else prep_weights(F, l, 1, 0, F.G);
        PH_END_C(even)
        if (even) {
            PH_BEGIN(2) { TP_BEGIN(32) if (F.G == 256) { hgrn_p1_item(F, li, OWN_UNIT(F.bx)); hgrn_p1_item(F, li, 256 + OWN_UNIT(F.bx)); } else for (int u = F.bx; u < 512; u += F.G) hgrn_p1_item(F, li, u); TP_END(32) }
            PH_END
            PH_BEGIN(3) { TP_BEGIN(30)
#ifndef PROBE_DUP
              if (SCAN_OVERLAP && F.G * NWAVES * 64 == 32 * 4096) { f32x4 uv_[16]; hgrn_scan_issue(F, uv_); sgu_phase(F, li); hgrn_scan_finish(F, uv_); } else
#endif
              { PH_FIRST(hgrn_scan(F)) sgu_phase(F, li); } TP_END(30) }
              if (l + 1 < DEPTH) { lds_barrier(); prep_weights(F, l + 1, 0, 0, F.G); }
            PH_END
            PH_BEGIN(4) for (int u0_ = F.bx; u0_ < 256; u0_ += F.G) { const int u = (F.G == 256) ? OWN_UNIT(u0_) : u0_;
#if defined(P3_X) && P3_X == 7
                _Pragma("unroll 1") for (int r2_ = 0; r2_ < 2; ++r2_)
#endif
                { int uu_ = u, tt_ = F.tid; asm volatile("" : "+v"(uu_), "+v"(tt_)); uu_ = __builtin_amdgcn_readfirstlane(uu_); F.tid = tt_; F.lane = tt_ & 63; hgrn_p3_unit(F, li, uu_, PH_ISDUP); } } PH_END_GX(0, -1, 0u)
        } else {
            PH_BEGIN(5)
#ifndef NO_ODDPREP
 { TP_BEGIN(33) conv_phase(F, li); TP_END(33) } { TP_BEGIN(34) qk_prep_phase(F, li); TP_END(34) } { TP_BEGIN(35) vt_phase(F); TP_END(35) }
                if (l + 1 < DEPTH) { lds_barrier(); prep_weights(F, l + 1, 0, 0, F.G); }
#endif
 PH_END
            PH_BEGIN(6)
#ifndef NO_ATTN
 { float m2_, lam_, linit_; attn_params(F, li, l, m2_, lam_, linit_); if (F.G == 256) attn_unit(F, li, OWN_UNIT(F.bx), m2_, lam_, linit_); else for (int u = F.vcu; u < 256; u += F.G) attn_unit(F, li, u, m2_, lam_, linit_);     }
#endif
 PH_END_GX(0, -1, 0u)
        }
        PH_BEGIN(7) { pg8::Gemm g{F_MIX, F_WOUT, M, DM, DM, 0, F.tid}; pg8::StaticOrder S; S.init(M, DM, F.G, F.bx);
            { pg8::EpiRes<false, false> E{F_XB, F_XB, DM, (float*)(F.ws + WS_SSA)}; pg8::gemm_phase<pg8::EpiRes<false, false>, pg8::StaticOrder, true, true>(F.lds + RING_OFF, g, S, E); } } PH_END_GX(-1, 0, gridDim.x * (unsigned)(l + 1))
        PH_BEGIN(9) { pg8::Gemm g{F_XB, F_W1, M, FF, DM, 0, F.tid};
#if defined(PROBE_DUP) && defined(PROBE_SHORTK)
            if (rep_ == 0) g.nt_over = PROBE_SHORTK;
#endif
            pg8::StaticOrder S; S.init(M, FF, F.G, F.bx);
            fill_rstd(F, S, (const float*)(F.ws + WS_SSA));
            pg8::EpiBf16S<2> E{F_Y, FF, (const LAS float*)(F.lds + RST_OFF), (const LAS int*)(F.lds + RST_OFF + 4096), false};
#if defined(PROBE_DUP) && defined(PROBE_NOSTORE)
            if (rep_ == 0) E.nostore = true;
#endif
            { TP_BEGIN(1) pg8::gemm_phase<pg8::EpiBf16S<2>, pg8::StaticOrder, true, true>(F.lds + RING_OFF, g, S, E); TP_END(1) } } PH_END_G
        PH_BEGIN(10) { pg8::Gemm g{F_Y, F_W2, M, DM, FF, 0, F.tid}; pg8::StaticOrder S; S.init(M, DM, F.G, F.bx);
            if (l == DEPTH - 1) { pg8::EpiRes<false, true> E{F_XB, F.out, DM, nullptr}; pg8::gemm_phase<pg8::EpiRes<false, true>, pg8::StaticOrder, true, true>(F.lds + RING_OFF, g, S, E); }
            else { pg8::EpiRes<false, false> E{F_XB, F_XB, DM, (float*)(F.ws + WS_SSB)}; pg8::gemm_phase<pg8::EpiRes<false, false>, pg8::StaticOrder, true, true>(F.lds + RING_OFF, g, S, E); } }
        PH_END_GP((int)(((unsigned)(8 * (blockIdx.x & 7) + ((blockIdx.x >> 3) & 7)) * 256u * (unsigned)(even ? ODD_IN : EVEN_IN) * 2u) >> 21), (int)((((unsigned)(8 * (blockIdx.x & 7) + ((blockIdx.x >> 3) & 7)) + 1u) * 256u * (unsigned)(even ? ODD_IN : EVEN_IN) * 2u - 1u) >> 21))
    }
#if defined(TPROBE) && TPROBE >= 100
    if (blockIdx.x == TP_BLK && threadIdx.x == 0) { volatile LAS unsigned long long* pa_ = (volatile LAS unsigned long long*)((LAS unsigned char*)lds + MISC_OFF + 64); *pa_ = __builtin_amdgcn_s_memrealtime() - tk0_; }
#endif
#ifdef TPROBE
    GRID_BARRIER();
    if (blockIdx.x == TP_BLK && threadIdx.x == 0) { volatile LAS unsigned long long* pa = (volatile LAS unsigned long long*)((LAS unsigned char*)lds + MISC_OFF + 64); const float a0 = (float)pa[0], a1 = (float)pa[1];
        args.out[0] = (TPROBE >= 200) ? 10.f + floorf(4.f * a1 / (float)pa[2] + 0.5f) : 10.f + floorf((TPROBE >= 100 ? 200.f : TP_SCALE) * a1 / a0 + 0.5f) - TP_OFFS; }
#endif
#undef PH_BEGIN
#undef PH_END
}

extern "C" void kernel_launch(void* const* d_in, const int* in_sizes, int n_in, void* d_out, int out_size, void* d_ws, size_t ws_size, hipStream_t stream) {
    static int grid = 0;
    if (grid == 0) {
        if (n_in != N_IN || in_sizes[0] != M * DM || out_size != M * DM || ws_size < 255 * MiB) { fprintf(stderr, "kernel_launch: unexpected shapes (n_in %d, in0 %d, out %d, ws %zu)\n", n_in, n_in > 0 ? in_sizes[0] : -1, out_size, ws_size); grid = -1; return; }
        int dev = 0, cus = 0, per_cu = 0;
        if (hipGetDevice(&dev) != hipSuccess || hipDeviceGetAttribute(&cus, hipDeviceAttributeMultiprocessorCount, dev) != hipSuccess) { grid = -1; return; }
        if (hipFuncSetAttribute((const void*)fwd_kernel, hipFuncAttributeMaxDynamicSharedMemorySize, LDS_BYTES) != hipSuccess) { fprintf(stderr, "kernel_launch: hipFuncSetAttribute failed\n"); grid = -1; return; }
        if (hipOccupancyMaxActiveBlocksPerMultiprocessor(&per_cu, (const void*)fwd_kernel, NWAVES * 64, LDS_BYTES) != hipSuccess || per_cu < 1) { fprintf(stderr, "kernel_launch: occupancy query reports %d workgroups per CU\n", per_cu); per_cu = 1; }
        (void)hipGetLastError();
        grid = cus;
    }
    if (grid < 0) return;
    if (hipMemsetAsync((char*)d_ws + WS_CTL, 0, CTL_ZERO_BYTES, stream) != hipSuccess) return;
    Args a{};
    for (int i = 0; i < N_IN; ++i) a.in[i] = (const float*)d_in[i];
    a.out = (float*)d_out; a.ws = (unsigned char*)d_ws;
#if MK_ONE_LAUNCH
    a.ph_lo = 0; a.ph_hi = NPH; a.li = 0;
    hipLaunchKernelGGL(fwd_kernel, dim3(grid), dim3(NWAVES * 64), LDS_BYTES, stream, a);
#else
    for (int p = 0; p < NPH; ++p) { a.ph_lo = p; a.ph_hi = p + 1; a.li = p;
        hipLaunchKernelGGL(fwd_kernel, dim3(grid), dim3(NWAVES * 64), LDS_BYTES, stream, a); }
#endif
}
```

```cpp
#include <hip/hip_runtime.h>
#include <cstdio>
#include <cstdint>
#if defined(TPROBE) && TPROBE == 30
#define GTP_BEGIN const unsigned long long gtp0_ = __builtin_amdgcn_s_memrealtime();
#define GTP_END if (g.N == 4096 && blockIdx.x == 0 && threadIdx.x == 0) { volatile __attribute__((address_space(3))) unsigned long long* pa_ = (volatile __attribute__((address_space(3))) unsigned long long*)(lds + 131072 + 320 + 64) + 1; *pa_ = *pa_ + (__builtin_amdgcn_s_memrealtime() - gtp0_); }
#else
#define GTP_BEGIN
#define GTP_END
#endif
namespace pg8 {
#define PG8_LAS __attribute__((address_space(3)))
typedef unsigned short bf16_t;
typedef short bf16x8 __attribute__((ext_vector_type(8)));
typedef float f32x4 __attribute__((ext_vector_type(4)));
typedef unsigned u32x4 __attribute__((ext_vector_type(4)));
constexpr int BM = 256, BK = 64, HALF = 128, HTB = HALF * BK * 2  , STAGE_BYTES = 8 * HTB, NXCD = 8, WGM = 8;

__host__ __device__ __forceinline__ int lds_byte(int r, int c) { const int st = (r >> 4) * 2 + (c >> 5), rr = r & 15, cc = c & 31, ob = rr * 64 + cc * 2; return st * 1024 + (ob ^ (((ob >> 9) & 1) << 5)); }
__host__ __device__ __forceinline__ void stage_rc(int b, int& R, int& C) { const int st = b / 1024, sb = b % 1024, swz = sb ^ (((sb >> 9) & 1) << 5); R = (st >> 1) * 16 + swz / 64; C = (st & 1) * 32 + (swz % 64) / 2; }
__host__ __device__ __forceinline__ int perm32(int rho) { const int n = rho >> 4, i = rho & 15; return 8 * (i >> 2) + 4 * n + (i & 3); }

struct Unit { int pm, pn; };
struct Gemm { const bf16_t* A; const bf16_t* Bt; int M, N, K; int nt_over; int tid; };

struct StaticOrder {
    int nM, nN, nwg, G, c;
    __host__ __device__ void init(int M, int N, int G_, int c_) { nM = M / BM; nN = N / BM; nwg = nM * nN; G = G_; c = c_; }
    __host__ __device__ bool next(int i, Unit& u) const {
        const long L = (long)i * G + c; if (L >= nwg) return false;
        int wgid = (int)L; { const int q = nwg / NXCD, r = nwg % NXCD, xcd = wgid % NXCD, off = wgid / NXCD; wgid = (xcd < r ? xcd * (q + 1) : r * (q + 1) + (xcd - r) * q) + off; }
        const int nig = WGM * nN, gid = wgid / nig, fm = gid * WGM, gsz = (nM - fm) < WGM ? (nM - fm) : WGM;
        u.pm = fm + ((wgid % nig) % gsz); u.pn = (wgid % nig) / gsz; return true;
    }
    __device__ __forceinline__ void a_ready(const Unit&) const {}
    __device__ __forceinline__ void done(const Unit&) const {}
};

__device__ __forceinline__ unsigned cvt_pk_bf16(float lo, float hi) { unsigned r; asm volatile("v_cvt_pk_bf16_f32 %0, %1, %2" : "=v"(r) : "v"(lo), "v"(hi)); return r; }
typedef float f32x2 __attribute__((ext_vector_type(2)));
__device__ __forceinline__ f32x2 gelu_pk(f32x2 v) {
    const f32x2 av = __builtin_elementwise_abs(v), d = av * 0.2316418882f + 1.0f;
    f32x2 t; t.x = __builtin_amdgcn_rcpf(d.x); t.y = __builtin_amdgcn_rcpf(d.y);
    f32x2 q = t * 0.5307027145f + (-0.7265760135f); q = q * t + 0.7107068705f; q = q * t + (-0.142248368f); q = q * t + 0.127414796f; q = q * t;
    const f32x2 s = (v * v) * (-0.72134752044f);
    f32x2 e; e.x = __builtin_amdgcn_exp2f(s.x); e.y = __builtin_amdgcn_exp2f(s.y);
    const f32x2 m = v * (q * e), r = v - m;
    f32x2 o; o.x = v.x < 0.f ? m.x : r.x; o.y = v.y < 0.f ? m.y : r.y; return o;
}

template <int ACT  > struct EpiBf16 {
    static constexpr bool PERM = true, AFTER_DRAIN = false; static_assert(ACT == 0 || ACT == 1, "EpiBf16: ACT is 0 (none) or 1 (gelu_pk)");
    bf16_t* O; int ldc; const float* bias; int split_cols; size_t split_stride; float scale0;
    __device__ __forceinline__ void operator()(const f32x4 (&acc)[2][2][4][2], const Unit& u, int wr, int wc, int fr, int fq) const {
        const int row0 = u.pm * BM + wr * 64 + fr; int colt = u.pn * BM; bf16_t* base = O;
        float sc = 1.f; if (split_cols) { const int t = colt / split_cols; base += (size_t)t * split_stride; colt -= t * split_cols; if (t == 0) sc = scale0; }
        const int col0 = colt + wc * 32 + 8 * fq, bcol0 = u.pn * BM + wc * 32 + 8 * fq;
        f32x4 bv[2][2];
#pragma unroll
        for (int bj = 0; bj < 2; ++bj)
#pragma unroll
            for (int n = 0; n < 2; ++n) bv[bj][n] = bias ? *(const f32x4*)(bias + bcol0 + bj * HALF + 4 * n) : (f32x4){0.f, 0.f, 0.f, 0.f};
#pragma unroll
        for (int ai = 0; ai < 2; ++ai)
#pragma unroll
            for (int m = 0; m < 4; ++m) { bf16_t* rowp = base + (size_t)(row0 + ai * HALF + m * 16) * ldc + col0;
#pragma unroll
                for (int bj = 0; bj < 2; ++bj) { f32x4 v0 = acc[ai][bj][m][0] + bv[bj][0], v1 = acc[ai][bj][m][1] + bv[bj][1];
                    if (ACT == 1) { f32x2 a = gelu_pk((f32x2){v0[0], v0[1]}), b = gelu_pk((f32x2){v0[2], v0[3]}), c = gelu_pk((f32x2){v1[0], v1[1]}), d = gelu_pk((f32x2){v1[2], v1[3]});
                        v0 = (f32x4){a.x, a.y, b.x, b.y}; v1 = (f32x4){c.x, c.y, d.x, d.y}; }
                    v0 = v0 * sc; v1 = v1 * sc; u32x4 w; w.x = cvt_pk_bf16(v0[0], v0[1]); w.y = cvt_pk_bf16(v0[2], v0[3]); w.z = cvt_pk_bf16(v1[0], v1[1]); w.w = cvt_pk_bf16(v1[2], v1[3]);
                    *(u32x4*)(rowp + bj * HALF) = w; } }
    }
};

struct PanelStats {
    unsigned* xbuf;
    unsigned* cnt;
    unsigned* tmo;
    int ntn; float eps;
    unsigned code;
    __device__ __forceinline__ bool run(const f32x4 (&v)[2][2][4][2], const Unit& u, int wr, int wc, int fr, int fq, PG8_LAS unsigned char* lds, int wid, int lane) const {
        typedef float f32x2v __attribute__((ext_vector_type(2)));
        PG8_LAS f32x2v* P = (PG8_LAS f32x2v*)lds;
        PG8_LAS f32x2v* S = (PG8_LAS f32x2v*)(lds + 8192);
        PG8_LAS unsigned* flag = (PG8_LAS unsigned*)(lds + 8192 + 2048);
#pragma unroll
        for (int ai = 0; ai < 2; ++ai)
#pragma unroll
            for (int m = 0; m < 4; ++m) {
                float s = 0.f;
#pragma unroll
                for (int bj = 0; bj < 2; ++bj)
#pragma unroll
                    for (int n = 0; n < 2; ++n) { const f32x4 x = v[ai][bj][m][n]; s += (x[0] + x[1]) + (x[2] + x[3]); }
                s += __shfl_xor(s, 16); s += __shfl_xor(s, 32);
                const float mw = s * (1.0f / 64.0f); float q = 0.f;
#pragma unroll
                for (int bj = 0; bj < 2; ++bj)
#pragma unroll
                    for (int n = 0; n < 2; ++n) { const f32x4 d = v[ai][bj][m][n] - mw; q += (d[0] * d[0] + d[1] * d[1]) + (d[2] * d[2] + d[3] * d[3]); }
                q += __shfl_xor(q, 16); q += __shfl_xor(q, 32);
                if (fq == 0) P[(ai * HALF + wr * 64 + m * 16 + fr) * 4 + wc] = (f32x2v){mw, q};
            }
        asm volatile("s_waitcnt lgkmcnt(0)" ::: "memory"); __builtin_amdgcn_s_barrier(); asm volatile("" ::: "memory");
#if defined(BROKEN_EXCHANGE_NO_WAIT)
#warning BROKEN CONTROL BUILD: the row-statistics exchange does not wait; results are wrong by design
        if (blockIdx.x >= 64) { const long long t0_ = clock64(); while (clock64() - t0_ < 60000) __builtin_amdgcn_s_sleep(8); }
#endif
        const int row = wid * 32 + (lane & 31);
        if (lane < 32) {
            const f32x2v a = P[row * 4 + 0], b = P[row * 4 + 1], c = P[row * 4 + 2], d = P[row * 4 + 3];
            const float mt = (a.x + b.x + c.x + d.x) * 0.25f;
            const float da = a.x - mt, db = b.x - mt, dc = c.x - mt, dd = d.x - mt;
            const float m2 = (a.y + b.y) + (c.y + d.y) + 64.0f * ((da * da + db * db) + (dc * dc + dd * dd));
            unsigned long long* slot = (unsigned long long*)xbuf + ((size_t)(u.pm * BM + row) * 4 + u.pn);
            __hip_atomic_store(slot, ((unsigned long long)__float_as_uint(m2) << 32) | __float_as_uint(mt), __ATOMIC_RELAXED, __HIP_MEMORY_SCOPE_AGENT);
        }
        asm volatile("s_waitcnt vmcnt(0)" ::: "memory");
        if (lane == 0) __hip_atomic_fetch_add(cnt + 64 * u.pm, 1u, __ATOMIC_RELAXED, __HIP_MEMORY_SCOPE_AGENT);
        if (wid == 0) {
            bool dead = false; const unsigned long long t0 = __builtin_amdgcn_s_memrealtime(); const unsigned want = 8u * (unsigned)ntn;
            for (;;) {
#if defined(BROKEN_EXCHANGE_NO_WAIT)
                break;
#endif
                if ((unsigned)__builtin_amdgcn_readfirstlane(__hip_atomic_load(cnt + 64 * u.pm, __ATOMIC_RELAXED, __HIP_MEMORY_SCOPE_AGENT)) >= want) break;
                if (__builtin_amdgcn_s_memrealtime() - t0 > 2000000ull) {
                    if (lane == 0) { unsigned expect = 0u; __hip_atomic_compare_exchange_strong(tmo + 1, &expect, code | (unsigned)(u.pm & 0xff), __ATOMIC_RELAXED, __ATOMIC_RELAXED, __HIP_MEMORY_SCOPE_AGENT);
                                     __hip_atomic_store(tmo, 1u, __ATOMIC_RELAXED, __HIP_MEMORY_SCOPE_AGENT); }
                    dead = true; break; }
                __builtin_amdgcn_s_sleep(2);
            }
            __builtin_amdgcn_fence(__ATOMIC_ACQUIRE, "agent");
            if (lane == 0) flag[0] = dead ? 1u : 0u;
        }
        asm volatile("s_waitcnt vmcnt(0) lgkmcnt(0)" ::: "memory"); __builtin_amdgcn_s_barrier(); asm volatile("" ::: "memory");
        const bool bad = flag[0] != 0u;
        if (lane < 32) {
            const unsigned long long* slot = (const unsigned long long*)xbuf + (size_t)(u.pm * BM + row) * 4; float mt[4], m2[4]; float ms = 0.f;
#pragma unroll
            for (int t = 0; t < 4; ++t) { if (t < ntn) { const unsigned long long w = __hip_atomic_load(slot + t, __ATOMIC_RELAXED, __HIP_MEMORY_SCOPE_AGENT); mt[t] = __uint_as_float((unsigned)w); m2[t] = __uint_as_float((unsigned)(w >> 32)); } else { mt[t] = 0.f; m2[t] = 0.f; } ms += mt[t]; }
            const float mean = ms / (float)ntn; float q = 0.f;
#pragma unroll
            for (int t = 0; t < 4; ++t) if (t < ntn) { const float dm = mt[t] - mean; q += m2[t] + 256.0f * dm * dm; }
            S[row] = (f32x2v){mean, 1.0f / sqrtf(q / (256.0f * (float)ntn) + eps)};
        }
        asm volatile("s_waitcnt lgkmcnt(0)" ::: "memory"); __builtin_amdgcn_s_barrier(); asm volatile("" ::: "memory");
        return bad;
    }
};
struct EpiLnRes {
    static constexpr bool PERM = false, AFTER_DRAIN = true;
    const float* base; float* out; int ldc; const float* bias; PanelStats st; unsigned poison;
    __device__ __forceinline__ void fused(f32x4 (&acc)[2][2][4][2], const Unit& u, int wr, int wc, int fr, int fq, PG8_LAS unsigned char* lds, int wid, int lane) const {
        typedef float f32x2v __attribute__((ext_vector_type(2)));
        const PG8_LAS f32x2v* S = (const PG8_LAS f32x2v*)(lds + 8192);
        const int col0 = u.pn * BM + wc * 32 + 4 * fq;
#pragma unroll
        for (int bj = 0; bj < 2; ++bj)
#pragma unroll
            for (int n = 0; n < 2; ++n) { const f32x4 bv = bias ? *(const f32x4*)(bias + col0 + bj * HALF + n * 16) : (f32x4){0.f, 0.f, 0.f, 0.f};
#pragma unroll
                for (int ai = 0; ai < 2; ++ai)
#pragma unroll
                    for (int m = 0; m < 4; ++m) acc[ai][bj][m][n] += bv; }
        f32x4 pre[4][2][2];
#pragma unroll
        for (int m = 0; m < 4; ++m) { const size_t off = (size_t)(u.pm * BM + wr * 64 + m * 16 + fr) * ldc + col0;
#pragma unroll
            for (int bj = 0; bj < 2; ++bj)
#pragma unroll
                for (int n = 0; n < 2; ++n) pre[m][bj][n] = *(const f32x4*)(base + off + bj * HALF + n * 16); }
        const bool bad = st.run(acc, u, wr, wc, fr, fq, lds, wid, lane) || poison != 0u;
        const float qnan = __builtin_nanf("");
#pragma unroll
        for (int ai = 0; ai < 2; ++ai)
#pragma unroll
            for (int m = 0; m < 4; ++m) { const int r = ai * HALF + wr * 64 + m * 16 + fr; const f32x2v sr = S[r]; const size_t off = (size_t)(u.pm * BM + r) * ldc + col0;
#pragma unroll
                for (int bj = 0; bj < 2; ++bj)
#pragma unroll
                    for (int n = 0; n < 2; ++n) { const f32x4 bs = ai == 0 ? pre[m][bj][n] : *(const f32x4*)(base + off + bj * HALF + n * 16); f32x4 o = bs + (acc[ai][bj][m][n] - sr.x) * sr.y;
                        if (bad) o = (f32x4){qnan, qnan, qnan, qnan}; *(f32x4*)(out + off + bj * HALF + n * 16) = o; }
                if (m & 1) asm volatile("" ::: "memory"); }
    }
};
struct EpiLnResLn {
    static constexpr bool PERM = false, AFTER_DRAIN = true;
    const float* base; float* out; bf16_t* xn; int ldc; const float* bias; PanelStats st1, st2; unsigned poison;
    __device__ __forceinline__ void fused(f32x4 (&acc)[2][2][4][2], const Unit& u, int wr, int wc, int fr, int fq, PG8_LAS unsigned char* lds, int wid, int lane) const {
        typedef float f32x2v __attribute__((ext_vector_type(2))); typedef unsigned u32x2v __attribute__((ext_vector_type(2)));
        const PG8_LAS f32x2v* S = (const PG8_LAS f32x2v*)(lds + 8192);
        const int col0 = u.pn * BM + wc * 32 + 4 * fq;
#pragma unroll
        for (int bj = 0; bj < 2; ++bj)
#pragma unroll
            for (int n = 0; n < 2; ++n) { const f32x4 bv = bias ? *(const f32x4*)(bias + col0 + bj * HALF + n * 16) : (f32x4){0.f, 0.f, 0.f, 0.f};
#pragma unroll
                for (int ai = 0; ai < 2; ++ai)
#pragma unroll
                    for (int m = 0; m < 4; ++m) acc[ai][bj][m][n] += bv; }
        bool bad = st1.run(acc, u, wr, wc, fr, fq, lds, wid, lane) || poison != 0u;
        const float qnan = __builtin_nanf("");
#pragma unroll
        for (int ai = 0; ai < 2; ++ai)
#pragma unroll
            for (int m = 0; m < 4; ++m) { const int r = ai * HALF + wr * 64 + m * 16 + fr; const f32x2v sr = S[r]; const size_t off = (size_t)(u.pm * BM + r) * ldc + col0;
#pragma unroll
                for (int bj = 0; bj < 2; ++bj)
#pragma unroll
                    for (int n = 0; n < 2; ++n) { const f32x4 bs = *(const f32x4*)(base + off + bj * HALF + n * 16); acc[ai][bj][m][n] = bs + (acc[ai][bj][m][n] - sr.x) * sr.y; }
                asm volatile("" : "+v"(acc[ai][0][m][0]), "+v"(acc[ai][0][m][1]), "+v"(acc[ai][1][m][0]), "+v"(acc[ai][1][m][1]));
                if (m & 1) asm volatile("" ::: "memory"); }
        const bool bad1 = bad;
        bad = st2.run(acc, u, wr, wc, fr, fq, lds, wid, lane) || bad;
#pragma unroll
        for (int ai = 0; ai < 2; ++ai)
#pragma unroll
            for (int m = 0; m < 4; ++m) { const int r = ai * HALF + wr * 64 + m * 16 + fr; const f32x2v sr = S[r]; const size_t off = (size_t)(u.pm * BM + r) * ldc + col0;
#pragma unroll
                for (int bj = 0; bj < 2; ++bj)
#pragma unroll
                    for (int n = 0; n < 2; ++n) { const f32x4 x1 = acc[ai][bj][m][n]; *(f32x4*)(out + off + bj * HALF + n * 16) = bad1 ? (f32x4){qnan, qnan, qnan, qnan} : x1;
                        const f32x4 o = (x1 - sr.x) * sr.y; u32x2v w; w.x = cvt_pk_bf16(o[0], o[1]); w.y = cvt_pk_bf16(o[2], o[3]);
                        if (bad) { w.x = 0x7fc07fc0u; w.y = 0x7fc07fc0u; } *(u32x2v*)(xn + off + bj * HALF + n * 16) = w; }
                asm volatile("" ::: "memory"); }
    }
};

template <class Epi, class Sched, bool ALIGN_EPI = false, bool SP2 = false>
__device__ __forceinline__ void gemm_phase(PG8_LAS unsigned char* lds, const Gemm g, const Sched& S, const Epi& E) {
    int tid_ = g.tid; asm volatile("" : "+v"(tid_));
    const int tid = tid_, wid = __builtin_amdgcn_readfirstlane(tid >> 6), lane = tid & 63, wr = wid >> 2, wc = wid & 3, fr = lane & 15, fq = lane >> 4;
    const int K = g.K, nt = g.nt_over ? g.nt_over : K / BK;
    unsigned voffA[2], voffB[2];
#pragma unroll
    for (int i = 0; i < 2; ++i) { int R, C; stage_rc(tid * 16 + i * 8192, R, C); const int Rb = Epi::PERM ? ((R & ~31) + perm32(R & 31)) : R;
        voffA[i] = (unsigned)(R * K + C) * 2u; voffB[i] = (unsigned)(Rb * K + C) * 2u; }
    const size_t kstep = (size_t)(BK * 2);
    const size_t hstep = (size_t)HALF * K * 2;
    const size_t tstep = 2 * hstep;
    const unsigned ldsw = (unsigned)wid * 1024u;
    const int aoff = lds_byte(wr * 64 + fr, fq * 8), boff = lds_byte(wc * 32 + fr, fq * 8);
#define PG8_SA(b, h) (((b) * 2 + (h)) * HTB)
#define PG8_SB(b, h) ((4 + (b) * 2 + (h)) * HTB)
#define PG8_STAGE(bufoff, gbase, voff) do { _Pragma("unroll") for (int _i = 0; _i < 2; ++_i) \
        __builtin_amdgcn_global_load_lds((const unsigned*)((const char*)(gbase) + (voff)[_i]), (PG8_LAS unsigned*)(lds + (bufoff) + ldsw + _i * 8192), 16, 0, 0); } while (0)
#define PG8_LDA(dst, b, h) do { _Pragma("unroll") for (int m = 0; m < 4; ++m) _Pragma("unroll") for (int k = 0; k < 2; ++k) dst[m][k] = *(const PG8_LAS bf16x8*)(lds + PG8_SA(b, h) + aoff + m * 2048 + k * 1024); } while (0)
#define PG8_LDB(dst, b, h) do { _Pragma("unroll") for (int n = 0; n < 2; ++n) _Pragma("unroll") for (int k = 0; k < 2; ++k) dst[n][k] = *(const PG8_LAS bf16x8*)(lds + PG8_SB(b, h) + boff + n * 2048 + k * 1024); } while (0)
#define PG8_MMA(ai, bj, At, Bt) do { __builtin_amdgcn_s_setprio(1); _Pragma("unroll") for (int m = 0; m < 4; ++m) _Pragma("unroll") for (int n = 0; n < 2; ++n) _Pragma("unroll") for (int k = 0; k < 2; ++k) \
        acc[ai][bj][m][n] = __builtin_amdgcn_mfma_f32_16x16x32_bf16(Bt[n][k], At[m][k], acc[ai][bj][m][n], 0, 0, 0); __builtin_amdgcn_s_setprio(0); } while (0)
#define PG8_WAIT_V(n) asm volatile("s_waitcnt vmcnt(" #n ")" ::: "memory")
#define PG8_WAIT_L(n) asm volatile("s_waitcnt lgkmcnt(" #n ")" ::: "memory")
#define PG8_BAR __builtin_amdgcn_s_barrier()
#define PG8_SCHED __builtin_amdgcn_sched_barrier(0)
    Unit cur, nxt; int ui = 0;
    if (!S.next(0, cur)) return;
    f32x4 acc[2][2][4][2];
#pragma unroll
    for (int a = 0; a < 2; ++a)
#pragma unroll
        for (int b = 0; b < 2; ++b)
#pragma unroll
            for (int m = 0; m < 4; ++m)
#pragma unroll
                for (int n = 0; n < 2; ++n) acc[a][b][m][n] = (f32x4){0.f, 0.f, 0.f, 0.f};
    bf16x8 At[4][2], B0[2][2], B1[2][2];
    const char* cA = (const char*)g.A + (size_t)cur.pm * tstep; const char* cB = (const char*)g.Bt + (size_t)cur.pn * tstep;
    S.a_ready(cur);
    if constexpr (SP2) {
        PG8_STAGE(PG8_SB(0, 0), cB, voffB); PG8_STAGE(PG8_SB(0, 1), cB + hstep, voffB); PG8_STAGE(PG8_SA(0, 0), cA, voffA); PG8_STAGE(PG8_SA(0, 1), cA + hstep, voffA);
        if (wr == 1) PG8_BAR;
        PG8_WAIT_V(2); PG8_BAR;
        PG8_STAGE(PG8_SB(1, 0), cB + kstep, voffB); PG8_STAGE(PG8_SA(1, 0), cA + kstep, voffA); PG8_STAGE(PG8_SB(1, 1), cB + hstep + kstep, voffB);
        PG8_WAIT_V(6); PG8_BAR;
    } else {
        PG8_STAGE(PG8_SB(0, 0), cB, voffB); PG8_STAGE(PG8_SA(0, 0), cA, voffA); PG8_STAGE(PG8_SB(0, 1), cB + hstep, voffB); PG8_STAGE(PG8_SA(0, 1), cA + hstep, voffA);
        if (wr == 1) PG8_BAR;
        PG8_WAIT_V(4); PG8_BAR;
        PG8_STAGE(PG8_SB(1, 0), cB + kstep, voffB); PG8_STAGE(PG8_SA(1, 0), cA + kstep, voffA); PG8_STAGE(PG8_SB(1, 1), cB + hstep + kstep, voffB);
        PG8_WAIT_V(6); PG8_BAR;
    }
    for (;;) {
        const bool has_next = S.next(ui + 1, nxt);
        const char* nA = has_next ? (const char*)g.A + (size_t)nxt.pm * tstep : cA; const char* nB = has_next ? (const char*)g.Bt + (size_t)nxt.pn * tstep : cB;
        for (int t = 0; t < nt; t += 2) {
            const bool last = (t == nt - 2);
            const char* a1 = cA + (size_t)(t + 1) * kstep;
            const char* a2 = last ? nA : cA + (size_t)(t + 2) * kstep; const char* b2 = last ? nB : cB + (size_t)(t + 2) * kstep;
            const char* a3 = a2 + kstep; const char* b3 = b2 + kstep;
            if (last && has_next) S.a_ready(nxt);
            if constexpr (SP2) {
            PG8_LDB(B0, 0, 0); PG8_LDB(B1, 0, 1); PG8_SCHED; PG8_LDA(At, 0, 0); PG8_STAGE(PG8_SA(1, 1), a1 + hstep, voffA);
            PG8_WAIT_V(8); PG8_WAIT_L(0); PG8_BAR; PG8_MMA(0, 0, At, B0); PG8_MMA(0, 1, At, B1); PG8_BAR; PG8_SCHED;
            PG8_LDA(At, 0, 1); PG8_STAGE(PG8_SB(0, 0), b2, voffB); PG8_STAGE(PG8_SB(0, 1), b2 + hstep, voffB); PG8_STAGE(PG8_SA(0, 0), a2, voffA);
            PG8_WAIT_V(8); PG8_WAIT_L(0); PG8_BAR; PG8_MMA(1, 0, At, B0); PG8_MMA(1, 1, At, B1); PG8_BAR; PG8_SCHED;
            PG8_LDB(B0, 1, 0); PG8_LDB(B1, 1, 1); PG8_SCHED; PG8_LDA(At, 1, 0); PG8_STAGE(PG8_SA(0, 1), a2 + hstep, voffA);
            PG8_WAIT_V(8); PG8_WAIT_L(0); PG8_BAR; PG8_MMA(0, 0, At, B0); PG8_MMA(0, 1, At, B1); PG8_BAR; PG8_SCHED;
            PG8_LDA(At, 1, 1); PG8_STAGE(PG8_SB(1, 0), b3, voffB); PG8_STAGE(PG8_SB(1, 1), b3 + hstep, voffB); PG8_STAGE(PG8_SA(1, 0), a3, voffA);
            PG8_WAIT_V(8); PG8_WAIT_L(0); PG8_BAR; PG8_MMA(1, 0, At, B0); PG8_MMA(1, 1, At, B1); PG8_BAR; PG8_SCHED;
            } else {
            PG8_LDB(B0, 0, 0); PG8_SCHED; PG8_LDA(At, 0, 0); PG8_STAGE(PG8_SA(1, 1), a1 + hstep, voffA);
            PG8_WAIT_L(8); PG8_BAR; PG8_WAIT_L(0); PG8_MMA(0, 0, At, B0); PG8_BAR; PG8_SCHED;
            PG8_LDB(B1, 0, 1); PG8_STAGE(PG8_SB(0, 0), b2, voffB);
            PG8_BAR; PG8_WAIT_L(0); PG8_MMA(0, 1, At, B1); PG8_BAR;
            PG8_LDA(At, 0, 1); PG8_STAGE(PG8_SA(0, 0), a2, voffA);
            PG8_BAR; PG8_WAIT_L(0); PG8_MMA(1, 0, At, B0); PG8_BAR; PG8_SCHED;
            PG8_STAGE(PG8_SB(0, 1), b2 + hstep, voffB);
            PG8_WAIT_V(6); PG8_BAR; PG8_MMA(1, 1, At, B1); PG8_BAR;
            PG8_LDB(B0, 1, 0); PG8_SCHED; PG8_LDA(At, 1, 0); PG8_STAGE(PG8_SA(0, 1), a2 + hstep, voffA);
            PG8_WAIT_L(8); PG8_BAR; PG8_WAIT_L(0); PG8_MMA(0, 0, At, B0); PG8_BAR; PG8_SCHED;
            PG8_LDB(B1, 1, 1); PG8_STAGE(PG8_SB(1, 0), b3, voffB);
            PG8_BAR; PG8_WAIT_L(0); PG8_MMA(0, 1, At, B1); PG8_BAR;
            PG8_LDA(At, 1, 1); PG8_STAGE(PG8_SA(1, 0), a3, voffA);
            PG8_BAR; PG8_WAIT_L(0); PG8_MMA(1, 0, At, B0); PG8_BAR; PG8_SCHED;
            PG8_STAGE(PG8_SB(1, 1), b3 + hstep, voffB);
            PG8_WAIT_V(6); PG8_BAR; PG8_MMA(1, 1, At, B1); PG8_BAR;
            }
        }
        if constexpr (ALIGN_EPI) { if (wr == 0) PG8_BAR; }
        if constexpr (!Epi::AFTER_DRAIN) { GTP_BEGIN E(acc, cur, wr, wc, fr, fq); GTP_END S.done(cur); }
        if (!has_next) break;
#pragma unroll
        for (int a = 0; a < 2; ++a)
#pragma unroll
            for (int b = 0; b < 2; ++b)
#pragma unroll
                for (int m = 0; m < 4; ++m)
#pragma unroll
                    for (int n = 0; n < 2; ++n) acc[a][b][m][n] = (f32x4){0.f, 0.f, 0.f, 0.f};
        cur = nxt; cA = nA; cB = nB; ++ui;
        if constexpr (ALIGN_EPI) { if (wr == 1) PG8_BAR; }
    }
    PG8_WAIT_V(0);
    if constexpr (!ALIGN_EPI) { if (wr == 0) PG8_BAR; }
    PG8_BAR;
    if constexpr (Epi::AFTER_DRAIN) { E.fused(acc, cur, wr, wc, fr, fq, lds, wid, lane); S.done(cur); }
#undef PG8_SA
#undef PG8_SB
#undef PG8_STAGE
#undef PG8_LDA
#undef PG8_LDB
#undef PG8_MMA
#undef PG8_WAIT_V
#undef PG8_WAIT_L
#undef PG8_BAR
#undef PG8_SCHED
}
}
namespace pg8 {
template <int ACT  > struct EpiBf16S {
    static constexpr bool PERM = true, AFTER_DRAIN = false;
    bf16_t* O; int ldc; const PG8_LAS float* rst; const PG8_LAS int* pmt; bool nostore;
    __device__ __forceinline__ void operator()(const f32x4 (&acc)[2][2][4][2], const Unit& u, int wr, int wc, int fr, int fq) const {
        const int row0 = u.pm * BM + wr * 64 + fr, col0 = u.pn * BM + wc * 32 + 8 * fq;
        int ti = 0;
#pragma unroll
        for (int i = 1; i < 4; ++i) if (pmt[i] == u.pm) ti = i;
        const PG8_LAS float* rt = rst + ti * 256 + wr * 64 + fr;
#pragma unroll
        for (int ai = 0; ai < 2; ++ai)
#pragma unroll
            for (int m = 0; m < 4; ++m) { bf16_t* rowp = O + (size_t)(row0 + ai * HALF + m * 16) * ldc + col0; const float r = rt[ai * HALF + m * 16];
#pragma unroll
                for (int bj = 0; bj < 2; ++bj) { f32x4 v0 = acc[ai][bj][m][0] * r, v1 = acc[ai][bj][m][1] * r;
                    if (ACT == 2) {
#pragma unroll
                        for (int i = 0; i < 4; ++i) { const float a = v0[i] > 0.f ? v0[i] : 0.f, b = v1[i] > 0.f ? v1[i] : 0.f; v0[i] = a * a; v1[i] = b * b; } }
                    u32x4 w; w.x = cvt_pk_bf16(v0[0], v0[1]); w.y = cvt_pk_bf16(v0[2], v0[3]); w.z = cvt_pk_bf16(v1[0], v1[1]); w.w = cvt_pk_bf16(v1[2], v1[3]);
                    if (!nostore) *(u32x4*)(rowp + bj * HALF) = w; else asm volatile("" :: "v"(w)); } }
    }
};
template <bool BASE_F32, bool OUT_F32> struct EpiRes {
    static constexpr bool PERM = true, AFTER_DRAIN = false;
    const void* base; void* out; int ldc; float* ss;
    __device__ __forceinline__ void operator()(const f32x4 (&acc)[2][2][4][2], const Unit& u, int wr, int wc, int fr, int fq) const {
        const int row0 = u.pm * BM + wr * 64 + fr, col0 = u.pn * BM + wc * 32 + 8 * fq;
        f32x4 pf[3][2][2];
        u32x4 pb[3][2];
#define RES_LOAD(gi_, slot_) do { const int ai2_ = (gi_) >> 2, m2_ = (gi_) & 3; const size_t off2_ = (size_t)(row0 + ai2_ * HALF + m2_ * 16) * ldc + col0; \
            _Pragma("unroll") for (int bj = 0; bj < 2; ++bj) { if (BASE_F32) { pf[slot_][bj][0] = *(const f32x4*)((const float*)base + off2_ + bj * HALF); pf[slot_][bj][1] = *(const f32x4*)((const float*)base + off2_ + bj * HALF + 4); } \
                else pb[slot_][bj] = *(const u32x4*)((const bf16_t*)base + off2_ + bj * HALF); } } while (0)
        RES_LOAD(0, 0); RES_LOAD(1, 1);
#pragma unroll
        for (int gi = 0; gi < 8; ++gi) { const int ai = gi >> 2, m = gi & 3; const size_t off = (size_t)(row0 + ai * HALF + m * 16) * ldc + col0;
            if (gi + 2 < 8) RES_LOAD(gi + 2, (gi + 2) % 3);
            float sq = 0.f;
#pragma unroll
            for (int bj = 0; bj < 2; ++bj) { f32x4 b0, b1;
                if (BASE_F32) { b0 = pf[gi % 3][bj][0]; b1 = pf[gi % 3][bj][1]; }
                else { const u32x4 w = pb[gi % 3][bj]; b0 = (f32x4){__uint_as_float(w.x << 16), __uint_as_float(w.x & 0xffff0000u), __uint_as_float(w.y << 16), __uint_as_float(w.y & 0xffff0000u)};
                    b1 = (f32x4){__uint_as_float(w.z << 16), __uint_as_float(w.z & 0xffff0000u), __uint_as_float(w.w << 16), __uint_as_float(w.w & 0xffff0000u)}; }
                const f32x4 o0 = b0 + acc[ai][bj][m][0], o1 = b1 + acc[ai][bj][m][1];
                sq += ((o0[0] * o0[0] + o0[1] * o0[1]) + (o0[2] * o0[2] + o0[3] * o0[3])) + ((o1[0] * o1[0] + o1[1] * o1[1]) + (o1[2] * o1[2] + o1[3] * o1[3]));
                if (OUT_F32) { *(f32x4*)((float*)out + off + bj * HALF) = o0; *(f32x4*)((float*)out + off + bj * HALF + 4) = o1; }
                else { u32x4 w; w.x = cvt_pk_bf16(o0[0], o0[1]); w.y = cvt_pk_bf16(o0[2], o0[3]); w.z = cvt_pk_bf16(o1[0], o1[1]); w.w = cvt_pk_bf16(o1[2], o1[3]); *(u32x4*)((bf16_t*)out + off + bj * HALF) = w; } }
            if (ss) { sq += __shfl_xor(sq, 16); sq += __shfl_xor(sq, 32); if (fq == 0) ss[(size_t)(row0 + ai * HALF + m * 16) * 16 + u.pn * 4 + wc] = sq; } }
#undef RES_LOAD
    }
};
}
#ifndef PG8_SP2
#define PG8_SP2 true
#endif
constexpr int NWAVES = 8;
constexpr int BATCH = 4, SEQ = 4096, DM = 1024, DEPTH = 4, FF = 4096, EVEN_IN = 3584, ODD_IN = 3072;
constexpr int M = BATCH * SEQ;
constexpr float EPS = 1e-6f;
constexpr float LOG2E = 1.4426950408889634f;
#ifndef MK_ONE_LAUNCH
#define MK_ONE_LAUNCH 1
#endif
enum { I_X = 0, I_NMIX, I_NMLP, I_WINE, I_WOUTE, I_SGUG, I_SGUW, I_SGUB, I_LBL, I_HNG, I_WINO, I_WOUTO, I_CONVW, I_QG, I_KG, I_LQ1, I_LK1, I_LQ2, I_LK2, I_DNG, I_W1, I_W2, N_IN };

constexpr size_t MiB = 1u << 20;
constexpr size_t WS_CTL = 0, CTL_ZERO_BYTES = 1 * MiB;
constexpr size_t WS_WIN = 1 * MiB, WS_WOUT = 8 * MiB, WS_W1 = 10 * MiB, WS_W2 = 18 * MiB;
constexpr size_t WS_XN = 26 * MiB;
constexpr size_t WS_Y = 58 * MiB;
constexpr size_t WS_MIX = 186 * MiB;
constexpr size_t WS_END = 218 * MiB;
constexpr int CW_TMO = 0, CW_CODE = 1, CW_BAR = 4096;
constexpr int CW_CENSUS = 8192, CW_GCNT = 12288, CW_DONE = 20480;

constexpr int RING_OFF = 0, RING_BYTES = 131072;
constexpr int LDSCTL_OFF = RING_BYTES, MISC_OFF = LDSCTL_OFF + 320;
constexpr int LDS_BYTES = 163840;
#define GAS __attribute__((address_space(1)))
#define LAS __attribute__((address_space(3)))
typedef unsigned short bf16;
typedef unsigned v4u __attribute__((ext_vector_type(4)));
typedef float f32x4 __attribute__((ext_vector_type(4)));
typedef short bf16x8 __attribute__((ext_vector_type(8)));
typedef GAS unsigned gu32;
typedef GAS unsigned long long gu64;
#define RLX_AGENT __ATOMIC_RELAXED, __HIP_MEMORY_SCOPE_AGENT
#define LDS_WAIT() asm volatile("s_waitcnt lgkmcnt(0)" ::: "memory")
#define VM_WAIT() asm volatile("s_waitcnt vmcnt(0)" ::: "memory")
__device__ __forceinline__ unsigned long long rt() { return __builtin_amdgcn_s_memrealtime(); }
__device__ __forceinline__ unsigned f2bf(float f) { unsigned u = __builtin_bit_cast(unsigned, f); return (u + 0x7fffu + ((u >> 16) & 1u)) >> 16; }
__device__ __forceinline__ unsigned pk2(float lo, float hi) { typedef float f32x2_ __attribute__((ext_vector_type(2))); typedef __bf16 bf16x2_ __attribute__((ext_vector_type(2))); const f32x2_ v = {lo, hi}; return __builtin_bit_cast(unsigned, __builtin_convertvector(v, bf16x2_)); }

#define XB_TMO      128
#define XB_XCNT(j)  (256  + 64 * (j))
#define XB_XSUB(j)  (1280 + 64 * (j))
#define XB_XGEN(j)  (2304 + 64 * (j))
#define XB_TOP      3328
#define XB_TOPGEN   3392
#define XCD_BAR_WORDS 3456
#define XB_SPIN_CAP (1u << 18)

__device__ __forceinline__ unsigned xb_ld(unsigned* p)              { return __hip_atomic_load(p, __ATOMIC_RELAXED, __HIP_MEMORY_SCOPE_AGENT); }
__device__ __forceinline__ unsigned xb_add(unsigned* p, unsigned v) { return __hip_atomic_fetch_add(p, v, __ATOMIC_RELAXED, __HIP_MEMORY_SCOPE_AGENT); }
__device__ __forceinline__ unsigned xb_xcc_id() { return (unsigned)__builtin_amdgcn_s_getreg((3 << 11) | 20) & 0xFu; }
#define XB_SPIN(cond, bar) do { unsigned _sp = 0; while (cond) { __builtin_amdgcn_s_sleep(1); \
    if ((++_sp & 255u) == 0u) { if (xb_ld(&(bar)[XB_TMO])) break; if (_sp > XB_SPIN_CAP) { atomicAdd(&(bar)[XB_TMO], 1u); break; } } } } while (0)

struct XcdBarrier {
    unsigned* bar; unsigned x; bool lead;
    volatile LAS unsigned* st;
};

__device__ __forceinline__ XcdBarrier xcd_barrier_post(unsigned* bar, volatile LAS unsigned* st, bool lead) {
    XcdBarrier b; b.bar = bar; b.x = xb_xcc_id(); b.st = st; b.lead = lead;
    if (lead) (void)xb_add(&bar[XB_XCNT(b.x)], 1u);
    return b;
}
__device__ __forceinline__ void xcd_barrier_complete(unsigned* bar, unsigned x, unsigned& nloc, unsigned& nx) {
    const unsigned G = gridDim.x * gridDim.y * gridDim.z;
    unsigned sum, cnt, mine, sp = 0u;
    for (;;) {
        sum = 0u; cnt = 0u; mine = 0u;
#pragma unroll
        for (unsigned j = 0; j < 16; ++j) { const unsigned c = xb_ld(&bar[XB_XCNT(j)]); sum += c; cnt += (c > 0u) ? 1u : 0u; mine = (j == x) ? c : mine; }
        if (sum == G) break;
        __builtin_amdgcn_s_sleep(1);
        if ((++sp & 255u) == 0u) { if (xb_ld(&bar[XB_TMO])) break; if (sp > XB_SPIN_CAP) { atomicAdd(&bar[XB_TMO], 1u); break; } }
    }
    nloc = mine > 0u ? mine : 1u; nx = cnt > 0u ? cnt : 1u;
}

__device__ __forceinline__ void xcd_barrier(const XcdBarrier& b) {
    asm volatile("s_waitcnt vmcnt(0)" ::: "memory");
    __syncthreads();
    if (b.lead) {
        unsigned* bar = b.bar;
        __builtin_amdgcn_s_waitcnt(0);
        unsigned nloc = b.st[0], nx = b.st[1];
        if (nloc == 0u) { xcd_barrier_complete(bar, b.x, nloc, nx); b.st[0] = nloc; b.st[1] = nx; }
        const unsigned old = xb_add(&bar[XB_XSUB(b.x)], 1u);
        const unsigned gen = old / nloc;
        if (old + 1u == (gen + 1u) * nloc) {
            __builtin_amdgcn_fence(__ATOMIC_RELEASE, "agent");
            asm volatile("s_waitcnt vmcnt(0)" ::: "memory");
            const unsigned og = xb_add(&bar[XB_TOP], 1u);
            const unsigned tg = og / nx;
            if (og + 1u == (tg + 1u) * nx) xb_add(&bar[XB_TOPGEN], 1u);
            else XB_SPIN(xb_ld(&bar[XB_TOPGEN]) == tg, bar);
            __builtin_amdgcn_fence(__ATOMIC_ACQUIRE, "agent");
            xb_add(&bar[XB_XGEN(b.x)], 1u);
            asm volatile("s_waitcnt vmcnt(0)" ::: "memory");
        } else {
            XB_SPIN(xb_ld(&bar[XB_XGEN(b.x)]) == gen, bar);
            __builtin_amdgcn_fence(__ATOMIC_ACQUIRE, "agent");
            asm volatile("s_waitcnt vmcnt(0)" ::: "memory");
        }
    }
    __syncthreads();
}

__device__ __forceinline__ void group_barrier(const XcdBarrier& b, unsigned* ctl, unsigned G, unsigned blk, int tid, int arrive_on = -1, int wait_on = -1, unsigned wait_target = 0u, int also_lo = -1, int also_hi = -1) {
    asm volatile("s_waitcnt vmcnt(0)" ::: "memory");
    unsigned mode = b.st[5];
    if (mode == 0u) {
        bool ok = (G == 256u);
#ifdef FORCE_GRID_FALLBACK
        ok = false;
#endif
        if (ok && tid < 256) { const unsigned c = xb_ld(&ctl[CW_CENSUS + tid]), r = xb_ld(&ctl[CW_CENSUS + (tid & 7)]); ok = (c != 0u) && (c == r); }
        if (b.lead) b.st[7] = 1u;
        __syncthreads();
        if (!ok) b.st[7] = 0u;
        __syncthreads();
        mode = b.st[7] ? 1u : 2u;
        __syncthreads();
        if (b.lead) b.st[5] = mode;
    }
    __syncthreads();
    if (mode == 1u) {
        if (b.lead) {
            unsigned* cnt = &ctl[CW_GCNT + 64 * (blk & 63u)];
            const unsigned k = b.st[6] + 1u; b.st[6] = k;
            if (arrive_on >= 0) (void)xb_add(&ctl[CW_DONE + 64 * arrive_on], 1u);
            (void)xb_add(cnt, 1u);
            unsigned* c_lo = also_lo >= 0 ? &ctl[CW_GCNT + 64 * ((also_lo >> 3) + 8 * (also_lo & 7))] : nullptr;
            unsigned* c_hi = (also_hi >= 0 && also_hi != also_lo) ? &ctl[CW_GCNT + 64 * ((also_hi >> 3) + 8 * (also_hi & 7))] : nullptr;
            unsigned* c_w = wait_on >= 0 ? &ctl[CW_DONE + 64 * wait_on] : nullptr;
            const unsigned need = (G / 64u) * k;
            { unsigned sp_ = 0;
              for (;;) {
                  const unsigned v0 = xb_ld(cnt), v1 = c_lo ? xb_ld(c_lo) : need, v2 = c_hi ? xb_ld(c_hi) : need, v3 = c_w ? xb_ld(c_w) : wait_target;
                  if (((v0 >= need) & (v1 >= need) & (v2 >= need) & (v3 >= wait_target)) != 0) break;
                  __builtin_amdgcn_s_sleep(1);
                  if ((++sp_ & 255u) == 0u) { if (xb_ld(&b.bar[XB_TMO])) break; if (sp_ > XB_SPIN_CAP) { atomicAdd(&b.bar[XB_TMO], 1u); break; } } } }
            __builtin_amdgcn_fence(__ATOMIC_ACQUIRE, "agent");
            asm volatile("s_waitcnt vmcnt(0)" ::: "memory");
        }
        __syncthreads();
    } else xcd_barrier(b);
}

__device__ __forceinline__ void guard_wait(const XcdBarrier& b, unsigned* ctl, int idx, unsigned target) {
    if (b.st[5] == 1u) { if (b.lead) XB_SPIN(xb_ld(&ctl[CW_DONE + 64 * idx]) < target, b.bar); __syncthreads(); }
}
struct Frame {
    LAS unsigned char* lds;
    int tid, lane, wave;
    int vcu, G, bx;
    const float* const* in;
    float* out; unsigned char* ws;
};
#define F_WIN ((bf16*)(F.ws + WS_WIN))
#define F_WOUT ((bf16*)(F.ws + WS_WOUT))
#define F_W1 ((bf16*)(F.ws + WS_W1))
#define F_W2 ((bf16*)(F.ws + WS_W2))
#define F_XN ((bf16*)(F.ws + WS_XN))
#define F_Y ((bf16*)(F.ws + WS_Y))
#define F_MIX ((bf16*)(F.ws + WS_MIX))
static __device__ const double ROPE_TURNS[32] = {0.15915494309189535, 0.11934937021124886, 0.08949940160889101, 0.06711508300522726, 0.050329212104487035, 0.03774158471741977, 0.0283021958306234, 0.02122365276477766, 0.015915494309189534, 0.011934937021124886, 0.008949940160889102, 0.006711508300522725, 0.005032921210448704, 0.003774158471741977, 0.00283021958306234, 0.0021223652764777662, 0.0015915494309189536, 0.0011934937021124885, 0.0008949940160889102, 0.0006711508300522726, 0.0005032921210448703, 0.00037741584717419774, 0.00028302195830623395, 0.0002122365276477766, 0.00015915494309189535, 0.00011934937021124886, 8.949940160889102e-05, 6.711508300522725e-05, 5.0329212104487035e-05, 3.774158471741978e-05, 2.8302195830623396e-05, 2.122365276477766e-05};
typedef unsigned long long u64;
#ifdef TPROBE
#define TP_BEGIN(id) unsigned long long tp0_##id = 0; if (TPROBE < 100 && ((id) == 1 || TPROBE == (id))) tp0_##id = __builtin_amdgcn_s_memrealtime();
#define TP_END(id) if (TPROBE < 100 && ((id) == 1 || TPROBE == (id)) && blockIdx.x == 0 && threadIdx.x == 0) { volatile LAS unsigned long long* pa_ = (volatile LAS unsigned long long*)(F.lds + MISC_OFF + 64) + ((id) == 1 ? 0 : 1); *pa_ = *pa_ + (__builtin_amdgcn_s_memrealtime() - tp0_##id); }
#else
#define TP_BEGIN(id)
#define TP_END(id)
#endif
typedef short v4i16_t __attribute__((ext_vector_type(4)));
__device__ __forceinline__ v4i16_t tr_read16(const LAS unsigned char* p) { return __builtin_amdgcn_ds_read_tr16_b64_v4i16((LAS v4i16_t*)p); }
__device__ __forceinline__ void lds_barrier() { asm volatile("s_waitcnt lgkmcnt(0)" ::: "memory"); __builtin_amdgcn_s_barrier(); asm volatile("" ::: "memory"); }
__device__ __forceinline__ float bf2f(unsigned h) { return __uint_as_float(h << 16); }
__device__ __forceinline__ float wave_sum(float v) {
#pragma unroll
    for (int o = 1; o < 64; o <<= 1) v += __shfl_xor(v, o);
    return v;
}
__device__ __forceinline__ float sigmoidf_(float a) { return __builtin_amdgcn_rcpf(1.f + __expf(-a)); }
__device__ __forceinline__ float gelu_tanh(float x) { const float y = 0.7978845608028654f * (x + 0.044715f * x * x * x); return x * __builtin_amdgcn_rcpf(1.f + __expf(-2.f * y)); }
__device__ __forceinline__ void unpack8(const v4u w, float (&f)[8]) {
    f[0] = bf2f(w.x & 0xffffu); f[1] = bf2f(w.x >> 16); f[2] = bf2f(w.y & 0xffffu); f[3] = bf2f(w.y >> 16);
    f[4] = bf2f(w.z & 0xffffu); f[5] = bf2f(w.z >> 16); f[6] = bf2f(w.w & 0xffffu); f[7] = bf2f(w.w >> 16);
}
__device__ __forceinline__ v4u pack8(const float (&f)[8]) { v4u w; w.x = pk2(f[0], f[1]); w.y = pk2(f[2], f[3]); w.z = pk2(f[4], f[5]); w.w = pk2(f[6], f[7]); return w; }

__device__ __forceinline__ void transpose_item(const float* W, int K, int N, bf16* WT, const float* gain, LAS float* scr, int item, int lane) {
    const int nblk = N / 32, kb = item / nblk, nb = item % nblk, k0 = 64 * kb, n0 = 32 * nb;
    float wv[32];
#pragma unroll
    for (int i = 0; i < 32; ++i) { const int kk = 2 * i + (lane >> 5); wv[i] = __builtin_nontemporal_load((const GAS float*)(W + (size_t)(k0 + kk) * N + n0 + (lane & 31))); }
    if (gain) {
#pragma unroll
        for (int i = 0; i < 32; ++i) wv[i] *= gain[k0 + 2 * i + (lane >> 5)]; }
#pragma unroll
    for (int i = 0; i < 32; ++i) scr[(2 * i + (lane >> 5)) * 33 + (lane & 31)] = wv[i];
    LDS_WAIT(); asm volatile("" ::: "memory");
    const int c = lane & 7;
#pragma unroll
    for (int j = 0; j < 4; ++j) { const int n = (lane >> 3) + 8 * j; const LAS float* s = scr + (8 * c) * 33 + n;
        v4u o; o.x = pk2(s[0 * 33], s[1 * 33]); o.y = pk2(s[2 * 33], s[3 * 33]); o.z = pk2(s[4 * 33], s[5 * 33]); o.w = pk2(s[6 * 33], s[7 * 33]);
        *(GAS v4u*)(WT + (size_t)(n0 + n) * K + k0 + 8 * c) = o; }
    LDS_WAIT(); asm volatile("" ::: "memory");
}
__device__ __forceinline__ void prep_weights(Frame& F, int l, int part, int wg0, int nwg) {
    LAS float* scr = (LAS float*)(F.lds + RING_OFF + F.wave * 16384);
    if (F.vcu < wg0 || F.vcu >= wg0 + nwg) return;
    const int gw = (F.vcu - wg0) * NWAVES + F.wave, NGW = nwg * NWAVES;
    const bool even = (l & 1) == 0; const int li = l >> 1, Nin = even ? EVEN_IN : ODD_IN;
    const float* Win = even ? F.in[I_WINE] + (size_t)li * DM * EVEN_IN : F.in[I_WINO] + (size_t)li * DM * ODD_IN;
    const float* Wout = (even ? F.in[I_WOUTE] : F.in[I_WOUTO]) + (size_t)li * DM * DM;
    const float* W1 = F.in[I_W1] + (size_t)l * DM * FF; const float* W2 = F.in[I_W2] + (size_t)l * FF * DM;
    const float* gmix = F.in[I_NMIX] + l * DM; const float* gmlp = F.in[I_NMLP] + l * DM;
    const int I_IN = (DM / 64) * (Nin / 32), I_OUT = (DM / 64) * (DM / 32), I_1 = (DM / 64) * (FF / 32), I_2 = (FF / 64) * (DM / 32);
    if (part == 0) { for (int it = gw; it < I_IN; it += NGW) transpose_item(Win, DM, Nin, F_WIN, gmix, scr, it, F.lane); return; }
    const int NITEMS = I_OUT + I_1 + I_2;
    for (int it = gw; it < NITEMS; it += NGW) {
        int r = it;
        if (r < I_OUT) { transpose_item(Wout, DM, DM, F_WOUT, nullptr, scr, r, F.lane); continue; } r -= I_OUT;
        if (r < I_1) { transpose_item(W1, DM, FF, F_W1, gmlp, scr, r, F.lane); continue; } r -= I_1;
        transpose_item(W2, FF, DM, F_W2, nullptr, scr, r, F.lane);
    }
}
constexpr size_t WS_XB = 220 * MiB;
constexpr size_t WS_SSA = 252 * MiB, WS_SSB = 253 * MiB;
#define F_XB ((bf16*)(F.ws + WS_XB))
constexpr int RST_OFF = RING_BYTES + 1024;
__device__ __forceinline__ void x_to_bf16(Frame& F, const float* src) {
    const int gw = F.vcu * NWAVES + F.wave, NGW = F.G * NWAVES; float* ss = (float*)(F.ws + WS_SSB);
    for (int m = gw; m < M; m += NGW) {
        const GAS f32x4* xr = (const GAS f32x4*)(src + (size_t)m * DM) + F.lane;
        f32x4 v[4]; float s = 0.f;
#pragma unroll
        for (int j = 0; j < 4; ++j) { v[j] = xr[64 * j]; s += (v[j].x * v[j].x + v[j].y * v[j].y) + (v[j].z * v[j].z + v[j].w * v[j].w); }
        s = wave_sum(s); if (F.lane < 16) ss[(size_t)m * 16 + F.lane] = (F.lane == 0) ? s : 0.f;
        GAS u64* o8 = (GAS u64*)(F_XB + (size_t)m * DM) + F.lane;
#pragma unroll
        for (int j = 0; j < 4; ++j) o8[64 * j] = (u64)pk2(v[j].x, v[j].y) | ((u64)pk2(v[j].z, v[j].w) << 32);
    }
}
template <class Sched>
__device__ __forceinline__ void fill_rstd(Frame& F, const Sched& S, const float* ss) {
    LAS float* rst = (LAS float*)(F.lds + RST_OFF); LAS int* pmt = (LAS int*)(F.lds + RST_OFF + 4096);
    const int r = F.tid & 255, half = F.tid >> 8;
#pragma unroll
    for (int j = 0; j < 2; ++j) { const int i = 2 * j + half; pg8::Unit u; const bool ok = S.next(i, u);
        if (ok) { const GAS f32x4* p = (const GAS f32x4*)(ss + (size_t)(u.pm * 256 + r) * 16); const f32x4 a = p[0], b = p[1], c = p[2], d = p[3];
            const float t = ((a[0] + a[1]) + (a[2] + a[3])) + ((b[0] + b[1]) + (b[2] + b[3])) + ((c[0] + c[1]) + (c[2] + c[3])) + ((d[0] + d[1]) + (d[2] + d[3]));
            rst[i * 256 + r] = __builtin_amdgcn_rsqf(t * (1.f / DM) + EPS); }
        if (r == 0) pmt[i] = ok ? u.pm : -1; }
    asm volatile("s_waitcnt vmcnt(0) lgkmcnt(0)" ::: "memory"); __syncthreads();
}

__device__ __forceinline__ void sgu_naive_unit(Frame& F, int e, int unit) {
    const int h = unit & 3, n = (unit >> 2) & 31, b = unit >> 7; const int row0 = b * SEQ + n * 128;
    LAS float* vn = (LAS float*)F.lds;
    const bf16* Y = F_Y; const int tid = F.tid;
    { const int q = tid >> 2, part = tid & 3; const bf16* vp = Y + (size_t)(row0 + q) * EVEN_IN + 512 + h * 128 + part * 32;
      float g[32]; float ss = 0.f;
#pragma unroll
      for (int i = 0; i < 4; ++i) { float f8[8]; unpack8(*(const GAS v4u*)(vp + 8 * i), f8);
#pragma unroll
          for (int j = 0; j < 8; ++j) { const float x = gelu_tanh(f8[j]); g[8 * i + j] = x; ss += x * x; } }
      ss += __shfl_xor(ss, 1); ss += __shfl_xor(ss, 2);
      const float r = __builtin_amdgcn_rsqf(ss * (1.f / 128.f) + EPS); const float* ng = F.in[I_SGUG] + e * 512 + h * 128 + part * 32;
#pragma unroll
      for (int i = 0; i < 32; ++i) vn[q * 129 + part * 32 + i] = g[i] * r * ng[i];
    }
    __syncthreads();
    { const int c = tid & 127, pq = __builtin_amdgcn_readfirstlane(tid >> 7); const float* Ws = F.in[I_SGUW] + (size_t)((e * 4 + h) * 128) * 128; const float* bs = F.in[I_SGUB] + (e * 4 + h) * 128;
      for (int pp = 0; pp < 32; ++pp) { const int p = pq * 32 + pp; const float* wr = Ws + p * 128; float acc = 0.f;
#pragma unroll 8
          for (int q = 0; q < 128; ++q) acc += wr[q] * vn[q * 129 + c];
          const float u = bf2f(Y[(size_t)(row0 + p) * EVEN_IN + h * 128 + c]);
          F_MIX[(size_t)(row0 + p) * DM + h * 128 + c] = (bf16)f2bf(gelu_tanh(u) * (acc + bs[p])); }
    }
    __syncthreads();
}
__device__ __forceinline__ void hgrn_naive(Frame& F, int e, int bh) {
    const int b = bh >> 2, h = bh & 3, tid = F.tid, kq = __builtin_amdgcn_readfirstlane(tid >> 7), v = tid & 127;
    LAS float* red = (LAS float*)F.lds;
    const bf16* Y = F_Y; float* OF = (float*)(F.ws + WS_XN);
    const float* lbl = F.in[I_LBL]; const float* ng = F.in[I_HNG] + e * 512;
    for (int z = 0; z < 2; ++z) {
        float lbv[32], S[32];
#pragma unroll
        for (int k = 0; k < 32; ++k) { const int ch = h * 128 + kq * 32 + k; S[k] = 0.f;
            if (e == 0) lbv[k] = 0.f; else { const float L0 = lbl[(z * 2 + 0) * 512 + ch], L1 = lbl[(z * 2 + 1) * 512 + ch]; lbv[k] = 1.f / (1.f + expf(L0 - L1)); } }
        for (int step = 0; step < SEQ; ++step) {
            const int pos = z ? SEQ - 1 - step : step; const size_t row = (size_t)b * SEQ + pos; const bf16* yr = Y + row * EVEN_IN;
            const float vi = bf2f(yr[1536 + h * 128 + v]); float part = 0.f;
#pragma unroll
            for (int i = 0; i < 4; ++i) { float a8[8], q8[8]; unpack8(*(const GAS v4u*)(yr + 2560 + z * 512 + h * 128 + kq * 32 + 8 * i), a8); unpack8(*(const GAS v4u*)(yr + 1024 + h * 128 + kq * 32 + 8 * i), q8);
#pragma unroll
                for (int j = 0; j < 8; ++j) { const int k = 8 * i + j; const float sg = sigmoidf_(a8[j]); const float f = lbv[k] + (1.f - lbv[k]) * sg, kk = (1.f - lbv[k]) * (1.f - sg);
                    S[k] = f * S[k] + kk * vi; part += q8[j] * S[k]; } }
            red[kq * 128 + v] = part; __syncthreads();
            float o = 0.f;
            if (kq == 0) { o = (red[v] + red[128 + v]) + (red[256 + v] + red[384 + v]);
                if (z == 0) OF[row * 512 + h * 128 + v] = o;
                else { o += OF[row * 512 + h * 128 + v]; const float ss = wave_sum(o * o); if (F.lane == 0) red[512 + F.wave] = ss; } }
            __syncthreads();
            if (z == 1 && kq == 0) { const float tot = red[512] + red[513]; const float r = __builtin_amdgcn_rsqf(tot * (1.f / 128.f) + EPS); const float gv = bf2f(yr[2048 + h * 128 + v]);
                F_MIX[row * DM + 512 + h * 128 + v] = (bf16)f2bf(o * r * ng[h * 128 + v] * gv * sigmoidf_(gv)); }
            __syncthreads();
        }
    }
}
__device__ __forceinline__ void conv_phase(Frame& F, int o) {
    const int gt = F.vcu * (NWAVES * 64) + F.tid, NT = F.G * NWAVES * 64; const float* cw = F.in[I_CONVW] + o * 3 * 512;
    for (int idx = gt; idx < (M / 4) * 64; idx += NT) { const int t0 = (idx >> 6) * 4, c = (idx & 63) * 8, pos0 = t0 & (SEQ - 1); const bf16* yr = F_Y + (size_t)t0 * ODD_IN;
        v4u hr[6], cr[6], br[4];
#pragma unroll
        for (int r = 0; r < 6; ++r) { const bool ok = (pos0 + r - 1 >= 0) && (pos0 + r - 1 < SEQ); const bf16* rp = yr + (ptrdiff_t)(ok ? r - 1 : 0) * ODD_IN; hr[r] = *(const GAS v4u*)(rp + c); cr[r] = *(const GAS v4u*)(rp + 1024 + c); }
#pragma unroll
        for (int r = 0; r < 4; ++r) br[r] = *(const GAS v4u*)(yr + (size_t)r * ODD_IN + 512 + c);
        float w0[8], w1[8], w2[8];
#pragma unroll
        for (int j = 0; j < 8; ++j) { w0[j] = cw[c + j]; w1[j] = cw[512 + c + j]; w2[j] = cw[1024 + c + j]; }
        float z[6][8];
#pragma unroll
        for (int r = 0; r < 6; ++r) { const bool ok = (pos0 + r - 1 >= 0) && (pos0 + r - 1 < SEQ); float hh[8], cg[8]; unpack8(hr[r], hh); unpack8(cr[r], cg);
#pragma unroll
            for (int j = 0; j < 8; ++j) z[r][j] = ok ? hh[j] * cg[j] : 0.f; }
#pragma unroll
        for (int r = 0; r < 4; ++r) { float bg[8], r8[8]; unpack8(br[r], bg);
#pragma unroll
            for (int j = 0; j < 8; ++j) r8[j] = bg[j] * (w0[j] * z[r][j] + w1[j] * z[r + 1][j] + w2[j] * z[r + 2][j]);
            *(GAS v4u*)(F_MIX + (size_t)(t0 + r) * DM + c) = pack8(r8); } }
}
__device__ __forceinline__ void qk_prep_phase(Frame& F, int o) {
    const int gw = F.vcu * NWAVES + F.wave, NGW = F.G * NWAVES, lane = F.lane;
    bf16* QR = (bf16*)(F.ws + WS_XN); bf16* KR = QR + (size_t)M * 512;
    const int d0 = (lane & 7) * 8; const bool hi = d0 >= 32;
    double inv[8];
#pragma unroll
    for (int j = 0; j < 8; ++j) inv[j] = ROPE_TURNS[(d0 + j) & 31];
    float gq[8], gk[8];
#pragma unroll
    for (int j = 0; j < 8; ++j) { gq[j] = F.in[I_QG][o * 64 + d0 + j]; gk[j] = F.in[I_KG][o * 64 + d0 + j]; }
    for (int it0 = gw * 4; it0 < 2 * M; it0 += NGW * 4) {
        v4u raw[4];
#pragma unroll
        for (int u = 0; u < 4; ++u) { const int it = it0 + u, t = it >> 1, which = it & 1; raw[u] = *(const GAS v4u*)(F_Y + (size_t)t * ODD_IN + 1536 + which * 512 + lane * 8); }
#pragma unroll
        for (int u = 0; u < 4; ++u) { const int it = it0 + u, t = it >> 1, which = it & 1, pos = t & (SEQ - 1);
            float x[8]; unpack8(raw[u], x); float ss = 0.f;
#pragma unroll
            for (int j = 0; j < 8; ++j) ss += x[j] * x[j];
            ss += __shfl_xor(ss, 1); ss += __shfl_xor(ss, 2); ss += __shfl_xor(ss, 4);
            const float r = __builtin_amdgcn_rsqf(ss * (1.f / 64.f) + EPS); const float sc = which ? 1.f : 0.125f * LOG2E; float y[8];
#pragma unroll
            for (int j = 0; j < 8; ++j) { x[j] = x[j] * r * (which ? gk[j] : gq[j]); const float p = __shfl_xor(x[j], 4); double tt = (double)pos * inv[j]; tt -= floor(tt); const float tf = (float)tt; const float cs = __builtin_amdgcn_cosf(tf), sn = __builtin_amdgcn_sinf(tf);
                y[j] = (hi ? (x[j] * cs + p * sn) : (x[j] * cs - p * sn)) * sc; }
            *(GAS v4u*)((which ? KR : QR) + (size_t)t * 512 + lane * 8) = pack8(y); }
    }
}
constexpr size_t WS_VT = WS_Y + 96 * MiB;
__device__ __forceinline__ void vt_phase(Frame& F) {
    LAS unsigned short* T = (LAS unsigned short*)F.lds;
    const int tid = F.tid;
    for (int it = F.vcu; it < 16 * 64; it += F.G) { const int bh = it >> 6, tt = it & 63, b = bh >> 2, h = bh & 3; const size_t tok0 = (size_t)b * SEQ + tt * 64;
        lds_barrier();
#pragma unroll
        for (int i = 0; i < 2; ++i) { const int idx = tid + 512 * i, row = idx >> 4, c16 = idx & 15; const v4u w = *(const GAS v4u*)(F_Y + (tok0 + row) * ODD_IN + 2560 + h * 128 + c16 * 8);
            LAS unsigned* d = (LAS unsigned*)(T + row * 130 + c16 * 8); d[0] = w.x; d[1] = w.y; d[2] = w.z; d[3] = w.w; }
        lds_barrier();
        { const int dv = tid >> 2, part = tid & 3;
          unsigned short v[16];
#pragma unroll
          for (int sl = 0; sl < 16; ++sl) { const int hi_ = sl >> 3, j = sl & 7; const int key = 16 * part + (j & 3) + 8 * (j >> 2) + 4 * hi_; v[sl] = T[key * 130 + dv]; }
          v4u o0, o1; o0.x = v[0] | ((unsigned)v[1] << 16); o0.y = v[2] | ((unsigned)v[3] << 16); o0.z = v[4] | ((unsigned)v[5] << 16); o0.w = v[6] | ((unsigned)v[7] << 16);
          o1.x = v[8] | ((unsigned)v[9] << 16); o1.y = v[10] | ((unsigned)v[11] << 16); o1.z = v[12] | ((unsigned)v[13] << 16); o1.w = v[14] | ((unsigned)v[15] << 16);
          bf16* dst = (bf16*)(F.ws + WS_VT) + ((size_t)(bh * 128 + dv)) * SEQ + tt * 64 + 16 * part;
          *(GAS v4u*)dst = o0; *(GAS v4u*)(dst + 8) = o1; }
    }
    lds_barrier();
}
__device__ __forceinline__ void attn_naive_unit(Frame& F, int o, int l_layer, int unit) {
    const int qb = unit & 31, h = (unit >> 5) & 3, b = unit >> 7, tid = F.tid; const int r = tid & 127, c = (tid >> 7) & 1, half = tid >> 8; const int qrow = b * SEQ + qb * 128 + r;
    const bf16* QR = (const bf16*)(F.ws + WS_XN); const bf16* KR = QR + (size_t)M * 512; const bf16* Y = F_Y;
    LAS float* Kt = (LAS float*)F.lds; LAS float* Vt = Kt + 64 * 128; LAS float* red = Vt + 64 * 128;
    float mq = 0.f, mk = 0.f, d1 = 0.f, d2 = 0.f;
    for (int i = 0; i < 64; ++i) { mq = fmaxf(mq, fabsf(F.in[I_QG][o * 64 + i])); mk = fmaxf(mk, fabsf(F.in[I_KG][o * 64 + i])); d1 += F.in[I_LQ1][o * 64 + i] * F.in[I_LK1][o * 64 + i]; d2 += F.in[I_LQ2][o * 64 + i] * F.in[I_LK2][o * 64 + i]; }
    const float linit = 0.8f - 0.6f * expf(-0.3f * (float)l_layer); const float lam = expf(d1) - expf(d2) + linit;
    const float m2 = 8.f * mq * mk * LOG2E;
    float q[64], O[64]; float l = 0.f;
    { const bf16* qp = QR + (size_t)qrow * 512 + h * 128 + c * 64;
#pragma unroll
      for (int i = 0; i < 8; ++i) { float f8[8]; unpack8(*(const GAS v4u*)(qp + 8 * i), f8);
#pragma unroll
          for (int j = 0; j < 8; ++j) q[8 * i + j] = f8[j]; } }
#pragma unroll
    for (int i = 0; i < 64; ++i) O[i] = 0.f;
    for (int kt = 0; kt < SEQ / 64; ++kt) {
        __syncthreads();
        { const int rr = tid >> 3, ch = tid & 7; const size_t krow = (size_t)b * SEQ + kt * 64 + rr; float f8[8];
#pragma unroll
          for (int hh = 0; hh < 2; ++hh) { unpack8(*(const GAS v4u*)(KR + krow * 512 + h * 128 + hh * 64 + ch * 8), f8);
#pragma unroll
              for (int j = 0; j < 8; ++j) Kt[rr * 128 + hh * 64 + ch * 8 + j] = f8[j];
              unpack8(*(const GAS v4u*)(Y + krow * ODD_IN + 2560 + h * 128 + hh * 64 + ch * 8), f8);
#pragma unroll
              for (int j = 0; j < 8; ++j) Vt[rr * 128 + hh * 64 + ch * 8 + j] = f8[j]; } }
        __syncthreads();
        for (int j = 0; j < 64; ++j) { float s = -m2;
#pragma unroll
            for (int d = 0; d < 64; d += 4) { const f32x4 kv = *(const LAS f32x4*)(Kt + j * 128 + c * 64 + d); s += q[d] * kv.x + q[d + 1] * kv.y + q[d + 2] * kv.z + q[d + 3] * kv.w; }
            const float p = exp2f(s); l += p;
#pragma unroll
            for (int d = 0; d < 64; d += 4) { const f32x4 vv = *(const LAS f32x4*)(Vt + j * 128 + half * 64 + d); O[d] += p * vv.x; O[d + 1] += p * vv.y; O[d + 2] += p * vv.z; O[d + 3] += p * vv.w; } }
    }
    __syncthreads();
    const float il = (c ? lam : 1.f) / l;
    if (c == 1) {
#pragma unroll
        for (int i = 0; i < 64; ++i) Kt[(half * 64 + i) * 128 + r] = O[i] * il; }
    __syncthreads();
    float ss = 0.f;
    if (c == 0) {
#pragma unroll
        for (int i = 0; i < 64; ++i) { O[i] = O[i] * il - Kt[(half * 64 + i) * 128 + r]; ss += O[i] * O[i]; }
        red[half * 128 + r] = ss; }
    __syncthreads();
    if (c == 0) { const float tot = red[r] + red[128 + r]; const float rr = (1.f - linit) * __builtin_amdgcn_rsqf(tot * (1.f / 128.f) + EPS); const float* sg = F.in[I_DNG] + o * 128 + half * 64;
        bf16* op = F_MIX + (size_t)qrow * DM + 512 + h * 128 + half * 64;
#pragma unroll
        for (int i = 0; i < 8; ++i) { float f8[8];
#pragma unroll
            for (int j = 0; j < 8; ++j) f8[j] = O[8 * i + j] * rr * sg[8 * i + j];
            *(GAS v4u*)(op + 8 * i) = pack8(f8); } }
    __syncthreads();
}
typedef float f32x16 __attribute__((ext_vector_type(16)));
constexpr size_t WS_APARK = WS_Y + 112 * MiB;
__device__ __forceinline__ void attn_params(Frame& F, int o, int l_layer, float& m2, float& lam, float& linit) {
    float mq = 0.f, mk = 0.f, d1 = 0.f, d2 = 0.f;
    for (int i = 0; i < 64; ++i) { mq = fmaxf(mq, fabsf(F.in[I_QG][o * 64 + i])); mk = fmaxf(mk, fabsf(F.in[I_KG][o * 64 + i])); d1 += F.in[I_LQ1][o * 64 + i] * F.in[I_LK1][o * 64 + i]; d2 += F.in[I_LQ2][o * 64 + i] * F.in[I_LK2][o * 64 + i]; }
    linit = 0.8f - 0.6f * expf(-0.3f * (float)l_layer); lam = expf(d1) - expf(d2) + linit; m2 = 8.f * mq * mk * LOG2E;
}
__device__ __forceinline__ int attn_lane(const Frame& F) { int t = F.tid; asm volatile("" : "+v"(t)); return t & 63; }
#define ATT_SB() __builtin_amdgcn_sched_barrier(0)
#define ATT_EXP4(P, i) do { P[4 * (i)] = __builtin_amdgcn_exp2f(P[4 * (i)]); P[4 * (i) + 1] = __builtin_amdgcn_exp2f(P[4 * (i) + 1]); P[4 * (i) + 2] = __builtin_amdgcn_exp2f(P[4 * (i) + 2]); P[4 * (i) + 3] = __builtin_amdgcn_exp2f(P[4 * (i) + 3]); } while (0)
#define ATT_ADD4(acc, P, i) do { acc += P[4 * (i)]; acc += P[4 * (i) + 1]; acc += P[4 * (i) + 2]; acc += P[4 * (i) + 3]; } while (0)
#define ATT_PIN() asm volatile("" : "+v"(N0), "+v"(N1), "+v"(O[0]), "+v"(O[1]), "+v"(O[2]), "+v"(O[3]), "+v"(l0), "+v"(l1), "+v"(pa[0]), "+v"(pa[1]), "+v"(pa[2]), "+v"(pa[3]))
#define ATT_CVT8(dst, P, q) do { v4u w_; w_.x = pg8::cvt_pk_bf16(P[8 * (q) + 0], P[8 * (q) + 1]); w_.y = pg8::cvt_pk_bf16(P[8 * (q) + 2], P[8 * (q) + 3]); w_.z = pg8::cvt_pk_bf16(P[8 * (q) + 4], P[8 * (q) + 5]); w_.w = pg8::cvt_pk_bf16(P[8 * (q) + 6], P[8 * (q) + 7]); dst = __builtin_bit_cast(bf16x8, w_); } while (0)
#define ATT_MFMA(a, b, c) __builtin_amdgcn_mfma_f32_32x32x16_bf16(a, b, c, 0, 0, 0)
template <class Dma>
__device__ __forceinline__ void attn_step(const LAS unsigned char* Kn, const LAS unsigned char* Vt, const int (&kofs)[4], const bf16x8 (&qf)[4], const f32x16& cm2, float& l0, float& l1,
                                          f32x16 (&O)[4], bf16x8 (&pa)[4], const Dma& dma) {
    bf16x8 kf0[4], kf1[4], va[4], vb[4];
#pragma unroll
    for (int ds = 0; ds < 4; ++ds) kf0[ds] = *(const LAS bf16x8*)(Kn + kofs[ds]);
#pragma unroll
    for (int ds = 0; ds < 4; ++ds) kf1[ds] = *(const LAS bf16x8*)(Kn + 4096 + kofs[ds]);
    f32x16 N0, N1;
    N0 = ATT_MFMA(kf0[0], qf[0], cm2);
    N0 = ATT_MFMA(kf0[1], qf[1], N0);
    N0 = ATT_MFMA(kf0[2], qf[2], N0);
    N0 = ATT_MFMA(kf0[3], qf[3], N0);
    N1 = ATT_MFMA(kf1[0], qf[0], cm2);
#pragma unroll
    for (int db = 0; db < 4; ++db) va[db] = *(const LAS bf16x8*)(Vt + db * 4096 + kofs[0]);
    ATT_PIN();
    N1 = ATT_MFMA(kf1[1], qf[1], N1); ATT_EXP4(N0, 0); ATT_PIN();
    N1 = ATT_MFMA(kf1[2], qf[2], N1); ATT_EXP4(N0, 1); ATT_PIN();
    N1 = ATT_MFMA(kf1[3], qf[3], N1); ATT_EXP4(N0, 2); ATT_PIN();
    dma();
    O[0] = ATT_MFMA(va[0], pa[0], O[0]);
#pragma unroll
    for (int db = 0; db < 4; ++db) vb[db] = *(const LAS bf16x8*)(Vt + db * 4096 + kofs[1]);
    ATT_EXP4(N0, 3); ATT_PIN();
    O[1] = ATT_MFMA(va[1], pa[0], O[1]); ATT_EXP4(N1, 0); ATT_PIN();
    O[2] = ATT_MFMA(va[2], pa[0], O[2]); ATT_EXP4(N1, 1); ATT_PIN();
    O[3] = ATT_MFMA(va[3], pa[0], O[3]);
#pragma unroll
    for (int db = 0; db < 4; ++db) va[db] = *(const LAS bf16x8*)(Vt + db * 4096 + kofs[2]);
    ATT_ADD4(l0, N0, 0); ATT_ADD4(l0, N0, 1); ATT_PIN();
    O[0] = ATT_MFMA(vb[0], pa[1], O[0]); ATT_EXP4(N1, 2); ATT_PIN();
    O[1] = ATT_MFMA(vb[1], pa[1], O[1]); ATT_EXP4(N1, 3); ATT_PIN();
    O[2] = ATT_MFMA(vb[2], pa[1], O[2]); ATT_CVT8(pa[0], N0, 0); ATT_ADD4(l0, N0, 2); ATT_PIN();
    O[3] = ATT_MFMA(vb[3], pa[1], O[3]);
#pragma unroll
    for (int db = 0; db < 4; ++db) vb[db] = *(const LAS bf16x8*)(Vt + db * 4096 + kofs[3]);
    ATT_ADD4(l0, N0, 3); ATT_PIN();
    O[0] = ATT_MFMA(va[0], pa[2], O[0]); ATT_CVT8(pa[1], N0, 1); ATT_PIN();
    O[1] = ATT_MFMA(va[1], pa[2], O[1]); ATT_ADD4(l1, N1, 0); ATT_ADD4(l1, N1, 1); ATT_PIN();
    O[2] = ATT_MFMA(va[2], pa[2], O[2]); ATT_ADD4(l1, N1, 2); ATT_ADD4(l1, N1, 3); ATT_PIN();
    O[3] = ATT_MFMA(va[3], pa[2], O[3]); ATT_PIN();
    O[0] = ATT_MFMA(vb[0], pa[3], O[0]); ATT_CVT8(pa[2], N1, 0); ATT_PIN();
    O[1] = ATT_MFMA(vb[1], pa[3], O[1]); ATT_PIN();
    O[2] = ATT_MFMA(vb[2], pa[3], O[2]); ATT_PIN();
    O[3] = ATT_MFMA(vb[3], pa[3], O[3]); ATT_PIN();
    ATT_CVT8(pa[3], N1, 1);
}
__device__ __forceinline__ void attn_step_last(const LAS unsigned char* Vt, const int (&kofs)[4], f32x16 (&O)[4], const bf16x8 (&pa)[4]) {
    bf16x8 va[4], vb[4];
#pragma unroll
    for (int db = 0; db < 4; ++db) va[db] = *(const LAS bf16x8*)(Vt + db * 4096 + kofs[0]);
#pragma unroll
    for (int db = 0; db < 4; ++db) vb[db] = *(const LAS bf16x8*)(Vt + db * 4096 + kofs[1]);
    ATT_SB();
#pragma unroll
    for (int db = 0; db < 4; ++db) O[db] = ATT_MFMA(va[db], pa[0], O[db]);
#pragma unroll
    for (int db = 0; db < 4; ++db) va[db] = *(const LAS bf16x8*)(Vt + db * 4096 + kofs[2]);
    ATT_SB();
#pragma unroll
    for (int db = 0; db < 4; ++db) O[db] = ATT_MFMA(vb[db], pa[1], O[db]);
#pragma unroll
    for (int db = 0; db < 4; ++db) vb[db] = *(const LAS bf16x8*)(Vt + db * 4096 + kofs[3]);
    ATT_SB();
#pragma unroll
    for (int db = 0; db < 4; ++db) O[db] = ATT_MFMA(va[db], pa[2], O[db]);
#pragma unroll
    for (int db = 0; db < 4; ++db) O[db] = ATT_MFMA(vb[db], pa[3], O[db]);
    ATT_SB();
}
__device__ __forceinline__ void attn_pass32(Frame& F, int b, int h, int c, int row0, float m2, f32x16 (&O)[4], float& l) {
    const int lane = attn_lane(F), wave = F.wave, r32 = lane & 31, hi = lane >> 5;
    const bf16* QR = (const bf16*)(F.ws + WS_XN); const bf16* KR = QR + (size_t)M * 512;
    LAS unsigned char* Kb = F.lds; LAS unsigned char* Vb = F.lds + 40960;
    bf16x8 qf[4];
#pragma unroll
    for (int ds = 0; ds < 4; ++ds) qf[ds] = *(const GAS bf16x8*)(QR + (size_t)(row0 + r32) * 512 + h * 128 + c * 64 + ds * 16 + hi * 8);
#pragma unroll
    for (int db = 0; db < 4; ++db)
#pragma unroll
        for (int r = 0; r < 16; ++r) O[db][r] = 0.f;
    const int kr = 8 * wave + (lane >> 3), cs = lane & 7;
    const char* ksrc = (const char*)(KR + (size_t)(b * SEQ + kr) * 512 + h * 128 + c * 64 + ((cs ^ ((kr >> 1) & 7)) * 8));
    const char* vsrc[2];
#pragma unroll
    for (int i = 0; i < 2; ++i) { const int vr = 16 * wave + 8 * i + (lane >> 3); vsrc[i] = (const char*)((const bf16*)(F.ws + WS_VT) + ((size_t)((b * 4 + h) * 128 + vr)) * SEQ + ((cs ^ ((vr >> 1) & 7)) * 8)); }
    const unsigned kdst = (unsigned)(size_t)(Kb + wave * 1024), vdst = (unsigned)(size_t)(Vb + wave * 2048);
#define ATT_GLDS(gsrc, ldsdst) do { unsigned keep_; asm volatile("s_mov_b32 %0, m0\n\ts_mov_b32 m0, %2\n\ts_nop 0\n\tglobal_load_lds_dwordx4 %1, off\n\ts_mov_b32 m0, %0" : "=&s"(keep_) : "v"(gsrc), "s"(ldsdst) : "memory"); } while (0)
#define ATT_DMAK(t, slot) ATT_GLDS(ksrc + (size_t)(t) * (64 * 512 * 2), (unsigned)__builtin_amdgcn_readfirstlane(kdst + (slot) * 8192))
#define ATT_DMAV(t, slot) do { ATT_GLDS(vsrc[0] + (size_t)(t) * (64 * 2), (unsigned)__builtin_amdgcn_readfirstlane(vdst + (slot) * 16384)); ATT_GLDS(vsrc[1] + (size_t)(t) * (64 * 2), (unsigned)__builtin_amdgcn_readfirstlane(vdst + (slot) * 16384 + 1024)); } while (0)
    asm volatile("s_waitcnt vmcnt(0)" : "+v"(qf[0]), "+v"(qf[1]), "+v"(qf[2]), "+v"(qf[3]) :: "memory");
    ATT_DMAK(0, 0); ATT_DMAK(1, 1); ATT_DMAK(2, 2); ATT_DMAV(0, 0); ATT_DMAV(1, 1);
    int kofs[4];
#pragma unroll
    for (int i = 0; i < 4; ++i) kofs[i] = r32 * 128 + (((2 * i + hi) ^ ((r32 >> 1) & 7)) << 4);
    f32x16 cm2;
#pragma unroll
    for (int r = 0; r < 16; ++r) cm2[r] = -m2;
    asm volatile("s_waitcnt vmcnt(0)" ::: "memory"); __builtin_amdgcn_s_barrier(); asm volatile("" ::: "memory");
    bf16x8 pa[4]; float l0 = 0.f, l1 = 0.f;
    { bf16x8 kf[2][4]; f32x16 P0, P1;
#pragma unroll
      for (int kh = 0; kh < 2; ++kh)
#pragma unroll
          for (int ds = 0; ds < 4; ++ds) kf[kh][ds] = *(const LAS bf16x8*)(Kb + kh * 4096 + kofs[ds]);
      P0 = ATT_MFMA(kf[0][0], qf[0], cm2); P1 = ATT_MFMA(kf[1][0], qf[0], cm2);
#pragma unroll
      for (int ds = 1; ds < 4; ++ds) { P0 = ATT_MFMA(kf[0][ds], qf[ds], P0); P1 = ATT_MFMA(kf[1][ds], qf[ds], P1); }
#pragma unroll
      for (int i = 0; i < 4; ++i) { ATT_EXP4(P0, i); ATT_EXP4(P1, i); }
#pragma unroll
      for (int i = 0; i < 4; ++i) { ATT_ADD4(l0, P0, i); ATT_ADD4(l1, P1, i); }
      ATT_CVT8(pa[0], P0, 0); ATT_CVT8(pa[1], P0, 1); ATT_CVT8(pa[2], P1, 0); ATT_CVT8(pa[3], P1, 1); }
    constexpr int NT = SEQ / 64;
    for (int kt = 0; kt < NT - 2; kt += 2) {
        attn_step(Kb + ((kt + 1) % 5) * 8192, Vb + (kt & 3) * 16384, kofs, qf, cm2, l0, l1, O, pa,
                  [&]() { if (kt + 3 < NT) ATT_DMAK(kt + 3, (kt + 3) % 5); if (kt + 4 < NT) ATT_DMAK(kt + 4, (kt + 4) % 5); if (kt + 2 < NT) ATT_DMAV(kt + 2, (kt + 2) & 3); if (kt + 3 < NT) ATT_DMAV(kt + 3, (kt + 3) & 3); });
        attn_step(Kb + ((kt + 2) % 5) * 8192, Vb + ((kt + 1) & 3) * 16384, kofs, qf, cm2, l0, l1, O, pa, [&]() {});
        asm volatile("s_waitcnt vmcnt(0) lgkmcnt(0)" ::: "memory"); __builtin_amdgcn_s_barrier(); asm volatile("" ::: "memory");
    }
    attn_step(Kb + ((NT - 1) % 5) * 8192, Vb + ((NT - 2) & 3) * 16384, kofs, qf, cm2, l0, l1, O, pa, [&]() {});
    attn_step_last(Vb + ((NT - 1) & 3) * 16384, kofs, O, pa);
    l = l0 + l1;
    asm volatile("s_waitcnt lgkmcnt(0)" ::: "memory"); __builtin_amdgcn_s_barrier(); asm volatile("" ::: "memory");
#undef ATT_DMAK
#undef ATT_DMAV
#undef ATT_GLDS
}
__device__ __forceinline__ void attn_unit(Frame& F, int o, int unit, float m2, float lam, float linit) {
    TP_BEGIN(23)
    const int qb = unit & 15, h = (unit >> 4) & 3, b = unit >> 6;
    const int wave = F.wave;
    const int row0 = b * SEQ + qb * 256 + wave * 32;
    f32x16 O[4]; float l;
    attn_pass32(F, b, h, 0, row0, m2, O, l);
    { v4u* park = (v4u*)(F.ws + WS_APARK) + ((size_t)unit * NWAVES + wave) * 8 * 64 + attn_lane(F);
      l += __shfl_xor(l, 32); const float il = __builtin_amdgcn_rcpf(l);
#pragma unroll
      for (int db = 0; db < 4; ++db)
#pragma unroll
          for (int i = 0; i < 2; ++i) { v4u w; w.x = pg8::cvt_pk_bf16(O[db][8 * i] * il, O[db][8 * i + 1] * il); w.y = pg8::cvt_pk_bf16(O[db][8 * i + 2] * il, O[db][8 * i + 3] * il);
              w.z = pg8::cvt_pk_bf16(O[db][8 * i + 4] * il, O[db][8 * i + 5] * il); w.w = pg8::cvt_pk_bf16(O[db][8 * i + 6] * il, O[db][8 * i + 7] * il); *(GAS v4u*)(park + (2 * db + i) * 64) = w; } }
    attn_pass32(F, b, h, 1, row0, m2, O, l);
    const int lane = attn_lane(F), r32 = lane & 31, hi = lane >> 5;
    const v4u* park = (const v4u*)(F.ws + WS_APARK) + ((size_t)unit * NWAVES + wave) * 8 * 64 + lane;
    v4u pk[8];
#pragma unroll
    for (int i = 0; i < 8; ++i) pk[i] = *(const GAS v4u*)(park + i * 64);
    l += __shfl_xor(l, 32); const float il1 = lam * __builtin_amdgcn_rcpf(l);
    float ss = 0.f;
#pragma unroll
    for (int db = 0; db < 4; ++db)
#pragma unroll
        for (int i = 0; i < 2; ++i) { const v4u w4 = pk[2 * db + i];
#pragma unroll
            for (int j = 0; j < 4; ++j) { const unsigned w = w4[j]; const int r = 8 * i + 2 * j; const float a0 = __uint_as_float(w << 16) - O[db][r] * il1, a1 = __uint_as_float(w & 0xffff0000u) - O[db][r + 1] * il1; O[db][r] = a0; O[db][r + 1] = a1; ss += a0 * a0 + a1 * a1; } }
    ss += __shfl_xor(ss, 32);
    const float rr = (1.f - linit) * __builtin_amdgcn_rsqf(ss * (1.f / 128.f) + EPS);
    const float* sg = F.in[I_DNG] + o * 128;
    bf16* op = F_MIX + (size_t)(row0 + r32) * DM + 512 + h * 128;
    typedef unsigned u32x2 __attribute__((ext_vector_type(2)));
#pragma unroll
    for (int db = 0; db < 4; ++db)
#pragma unroll
        for (int i = 0; i < 4; ++i) { const int dv = 32 * db + 8 * i + 4 * hi; const f32x4 g4 = *(const GAS f32x4*)(sg + dv);
            u32x2 w; w.x = pg8::cvt_pk_bf16(O[db][4 * i] * rr * g4[0], O[db][4 * i + 1] * rr * g4[1]); w.y = pg8::cvt_pk_bf16(O[db][4 * i + 2] * rr * g4[2], O[db][4 * i + 3] * rr * g4[3]);
            *(GAS u32x2*)(op + dv) = w; }
    TP_END(23)
}
#if defined(P3_PROBE) && (P3_PROBE == 1)
#define P3_DRYLOADS 1
#else
#define P3_DRYLOADS 0
#endif
#ifndef P3_PROBE
#define P3_PROBE 0
#endif
constexpr int HS_QH = 0, HS_KH = 16384, HS_VV = 32768, HS_PL = 49152, HS_VEC = 57344, HS_SEG = 58880, HS_SET = 65536;
constexpr size_t WS_HST = WS_XN;
constexpr size_t WS_HD = WS_CTL + 512 * 1024;
constexpr size_t WS_OFB = WS_Y + 112 * MiB;
constexpr int HG_GT = RING_BYTES + 8192;
__device__ __forceinline__ float row16_sum(float v) {
    v += __builtin_bit_cast(float, __builtin_amdgcn_update_dpp(0, __builtin_bit_cast(int, v), 0x128, 0xf, 0xf, false));
    v += __builtin_bit_cast(float, __builtin_amdgcn_update_dpp(0, __builtin_bit_cast(int, v), 0x124, 0xf, 0xf, false));
    v += __builtin_bit_cast(float, __builtin_amdgcn_update_dpp(0, __builtin_bit_cast(int, v), 0x122, 0xf, 0xf, false));
    v += __builtin_bit_cast(float, __builtin_amdgcn_update_dpp(0, __builtin_bit_cast(int, v), 0x121, 0xf, 0xf, false));
    return v;
}
__device__ __forceinline__ void hgrn_glds(const void* gsrc, unsigned ldsdst) { unsigned keep_; asm volatile("s_mov_b32 %0, m0\n\ts_mov_b32 m0, %2\n\ts_nop 0\n\tglobal_load_lds_dwordx4 %1, off\n\ts_mov_b32 m0, %0" : "=&s"(keep_) : "v"(gsrc), "s"(ldsdst) : "memory"); }
__device__ __forceinline__ int hsw(int row, int byte) { return row * 256 + ((((byte >> 4) ^ (((row & 3) << 2) | ((row >> 2) & 3))) << 4) | (byte & 15)); }
__device__ __forceinline__ int psw(int row, int byte) { return row * 128 + ((((byte >> 4) ^ ((row >> 1) & 7)) << 4) | (byte & 15)); }
typedef short bf16x4 __attribute__((ext_vector_type(4)));
typedef float f32x2 __attribute__((ext_vector_type(2)));
__device__ __forceinline__ float hgrn_lb(Frame& F, int e, int z, int ch) { if (e == 0) return 0.f; const float* lbl = F.in[I_LBL]; return 1.f / (1.f + __expf(lbl[(z * 2 + 0) * 512 + ch] - lbl[(z * 2 + 1) * 512 + ch])); }

struct HgrnRegs { unsigned a2[8], q2[8]; v4u vv[2]; };
template <int MODE, int z>
__device__ __forceinline__ void hgrn_prep_load(Frame& F, int tid, size_t tok0, int h, HgrnRegs& R) {
    const int k2 = tid & 63, seg = F.wave; const bf16* Y = F_Y;
#pragma unroll
    for (int i = 0; i < 8; ++i) { const bf16* yr = Y + (tok0 + 8 * seg + i) * EVEN_IN + h * 128 + 2 * k2;
        R.a2[i] = __builtin_nontemporal_load((const GAS unsigned*)(yr + 2560 + z * 512)); R.q2[i] = (MODE == 3) ? __builtin_nontemporal_load((const GAS unsigned*)(yr + 1024)) : 0u; }
#pragma unroll
    for (int i = 0; i < 2; ++i) { const int idx = tid + 512 * i, row = idx >> 4, c16 = idx & 15; R.vv[i] = *(const GAS v4u*)(Y + (tok0 + row) * EVEN_IN + 1536 + h * 128 + c16 * 8); }
}
template <int MODE, int z>
__device__ __forceinline__ void hgrn_prep(Frame& F, int tid, LAS unsigned char* set, const HgrnRegs& R, float lb0, float lb1, float& tot0, float& tot1) {
    const int k2 = tid & 63, seg = F.wave;
    LAS float* SEG = (LAS float*)(set + HS_SEG); LAS float* VEC = (LAS float*)(set + HS_VEC);
    const unsigned (&a2)[8] = R.a2; const unsigned (&q2)[8] = R.q2; const v4u (&vv)[2] = R.vv;
    float lf[8][2], kk[8][2], qv[8][2];
#pragma unroll
    for (int i = 0; i < 8; ++i) {
        const float a0 = bf2f(a2[i] & 0xffffu), a1 = bf2f(a2[i] >> 16);
        const float s0 = sigmoidf_(a0), s1 = sigmoidf_(a1);
        lf[i][0] = 0.6931471805599453f * __builtin_amdgcn_logf(lb0 + (1.f - lb0) * s0); lf[i][1] = 0.6931471805599453f * __builtin_amdgcn_logf(lb1 + (1.f - lb1) * s1);
        kk[i][0] = (1.f - lb0) * (1.f - s0); kk[i][1] = (1.f - lb1) * (1.f - s1);
        qv[i][0] = bf2f(q2[i] & 0xffffu); qv[i][1] = bf2f(q2[i] >> 16); }
#pragma unroll
    for (int i = 0; i < 2; ++i) { const int idx = tid + 512 * i, row = idx >> 4, c16 = idx & 15; *(LAS v4u*)(set + HS_VV + hsw(row, c16 * 16)) = vv[i]; }
    float bl[8][2]; float t0 = 0.f, t1 = 0.f;
#pragma unroll
    for (int ii = 0; ii < 8; ++ii) { const int i = z ? 7 - ii : ii; t0 += lf[i][0]; t1 += lf[i][1]; bl[i][0] = t0; bl[i][1] = t1; }
    *(LAS f32x2*)(SEG + seg * 128 + 2 * k2) = (f32x2){t0, t1};
    lds_barrier();
    float base0 = 0.f, base1 = 0.f, r0 = 0.f, r1 = 0.f, e0 = 0.f, e1 = 0.f;
#pragma unroll
    for (int s = 0; s < 8; ++s) { const f32x2 sv = *(const LAS f32x2*)(SEG + s * 128 + 2 * k2);
        const bool before = z ? (s > seg) : (s < seg); if (before) { base0 += sv.x; base1 += sv.y; }
        const bool inref = z ? (s >= 4) : (s <= 3); if (inref) { r0 += sv.x; r1 += sv.y; }
        e0 += sv.x; e1 += sv.y; }
    if (MODE == 3) {
#pragma unroll
        for (int i = 0; i < 8; ++i) { const int row = 8 * seg + i;
            const float b0 = base0 + bl[i][0], b1 = base1 + bl[i][1];
            const float E0 = __expf(fminf(b0 - r0, 80.f)), E1 = __expf(fminf(b1 - r1, 80.f)), G0 = __expf(fminf(r0 - b0, 80.f)), G1 = __expf(fminf(r1 - b1, 80.f));
            *(LAS unsigned*)(set + HS_QH + hsw(row, 4 * k2)) = pk2(qv[i][0] * E0, qv[i][1] * E1);
            *(LAS unsigned*)(set + HS_KH + hsw(row, 4 * k2)) = pk2(kk[i][0] * G0, kk[i][1] * G1); }
        if (seg == 0) { *(LAS f32x2*)(VEC + 2 * k2) = (f32x2){__expf(r0), __expf(r1)}; *(LAS f32x2*)(VEC + 128 + 2 * k2) = (f32x2){__expf(e0 - r0), __expf(e1 - r1)}; *(LAS f32x2*)(VEC + 256 + 2 * k2) = (f32x2){__expf(e0), __expf(e1)}; }
    } else {
#pragma unroll
        for (int i = 0; i < 8; ++i) { const int row = 8 * seg + i;
            const float b0 = base0 + bl[i][0], b1 = base1 + bl[i][1];
            *(LAS unsigned*)(set + HS_KH + hsw(row, 4 * k2)) = pk2(kk[i][0] * __expf(e0 - b0 + tot0), kk[i][1] * __expf(e1 - b1 + tot1)); }
        tot0 += e0; tot1 += e1;
    }
}
__device__ __forceinline__ void hgrn_vfrags(LAS unsigned char* set, int w, int g, int qp, int pp, bf16x8 (&Vf)[2]) {
#pragma unroll
    for (int s = 0; s < 2; ++s) { const int row = 32 * s + 8 * g + qp;
        const v4i16_t lo = tr_read16(set + HS_VV + hsw(row, 32 * w + 8 * pp)), hi = tr_read16(set + HS_VV + hsw(row + 4, 32 * w + 8 * pp));
        Vf[s] = (bf16x8){lo[0], lo[1], lo[2], lo[3], hi[0], hi[1], hi[2], hi[3]}; }
}
template <bool PLAIN = false>
__device__ __forceinline__ void hgrn_ktv(LAS unsigned char* set, int g, int qp, int pp, const bf16x8 (&Vf)[2], f32x4 (&T)[8]) {
#pragma unroll
    for (int kb = 0; kb < 8; ++kb)
#pragma unroll
        for (int s = 0; s < 2; ++s) { const int row = 32 * s + 8 * g + qp;
            const v4i16_t lo = PLAIN ? *(const LAS v4i16_t*)(set + HS_KH + hsw(row, 32 * kb + 8 * pp)) : tr_read16(set + HS_KH + hsw(row, 32 * kb + 8 * pp)), hi = PLAIN ? *(const LAS v4i16_t*)(set + HS_KH + hsw(row + 4, 32 * kb + 8 * pp)) : tr_read16(set + HS_KH + hsw(row + 4, 32 * kb + 8 * pp));
            const bf16x8 kf = (bf16x8){lo[0], lo[1], lo[2], lo[3], hi[0], hi[1], hi[2], hi[3]};
            T[kb] = __builtin_amdgcn_mfma_f32_16x16x32_bf16(kf, Vf[s], T[kb], 0, 0, 0); }
}
template <int z>
__device__ __forceinline__ void hgrn_p1_dir(Frame& F, int e, int item) {
    const int gI = item & 15, h = (item >> 4) & 3, b = (item >> 6) & 3;
    const int w = F.wave, k2 = F.tid & 63;
    const float lb0 = hgrn_lb(F, e, z, h * 128 + 2 * k2), lb1 = hgrn_lb(F, e, z, h * 128 + 2 * k2 + 1);
    float tot0 = 0.f, tot1 = 0.f;
    f32x4 U[8];
#pragma unroll
    for (int kb = 0; kb < 8; ++kb) U[kb] = (f32x4){0.f, 0.f, 0.f, 0.f};
    HgrnRegs R; hgrn_prep_load<1, z>(F, F.tid, (size_t)b * SEQ + gI * 256 + (z ? 0 : 3) * 64, h, R);
#pragma unroll 1
    for (int ci = 0; ci < 4; ++ci) { const int cI = z ? ci : 3 - ci; (void)cI;
        int tid_l = F.tid; asm volatile("" : "+v"(tid_l));
        const int fr = tid_l & 15, g = (tid_l >> 4) & 3, qp = fr >> 2, pp = fr & 3;
        LAS unsigned char* set = F.lds + (ci & 1) * HS_SET;
        hgrn_prep<1, z>(F, tid_l, set, R, lb0, lb1, tot0, tot1);
        if (ci + 1 < 4) hgrn_prep_load<1, z>(F, tid_l, (size_t)b * SEQ + gI * 256 + (z ? ci + 1 : 2 - ci) * 64, h, R);
        lds_barrier();
        bf16x8 Vf[2]; hgrn_vfrags(set, w, g, qp, pp, Vf);
        hgrn_ktv(set, g, qp, pp, Vf, U); }
    float* Ug = (float*)(F.ws + WS_HST) + (size_t)item * 16384;
#pragma unroll
    for (int kb = 0; kb < 8; ++kb) *(GAS f32x4*)(Ug + ((w * 8 + kb) * 64 + F.lane) * 4) = U[kb];
    if (w == 0) { float* Dg = (float*)(F.ws + WS_HD) + (size_t)item * 128; Dg[2 * k2] = __expf(tot0); Dg[2 * k2 + 1] = __expf(tot1); }
    lds_barrier();
}
__device__ __forceinline__ void hgrn_p1_item(Frame& F, int e, int item) { if (item >> 8) hgrn_p1_dir<1>(F, e, item); else hgrn_p1_dir<0>(F, e, item); }
__device__ __forceinline__ void hgrn_scan(Frame& F) {
    const int gt = F.vcu * (NWAVES * 64) + F.tid, NT = F.G * NWAVES * 64;
    float* ST = (float*)(F.ws + WS_HST); const float* Dg = (const float*)(F.ws + WS_HD);
    for (int i = gt; i < 32 * 4096; i += NT) {
        const int seq = i >> 12, el = (i & 4095) * 4, k = 16 * ((i >> 6) & 7) + 4 * ((i & 63) >> 4), z = seq >> 4;
        f32x4 uv[16], dv[16];
#pragma unroll
        for (int gi = 0; gi < 16; ++gi) { const int gI = z ? 15 - gi : gi; const size_t it = (size_t)seq * 16 + gI; uv[gi] = *(const GAS f32x4*)(ST + it * 16384 + el); dv[gi] = *(const GAS f32x4*)(Dg + it * 128 + k); }
        f32x4 S = (f32x4){0.f, 0.f, 0.f, 0.f}; asm volatile("" : "+v"(S));
#pragma unroll
        for (int gi = 0; gi < 16; ++gi) { const int gI = z ? 15 - gi : gi; const size_t it = (size_t)seq * 16 + gI; *(GAS f32x4*)(ST + it * 16384 + el) = S; S = dv[gi] * S + uv[gi]; }
    }
}
__device__ __forceinline__ void hgrn_scan_issue(Frame& F, f32x4 (&uv)[16]) {
    const int i = F.vcu * (NWAVES * 64) + F.tid; const float* ST = (const float*)(F.ws + WS_HST);
    const int seq = i >> 12, el = (i & 4095) * 4, z = seq >> 4;
#pragma unroll
    for (int gi = 0; gi < 16; ++gi) { const int gI = z ? 15 - gi : gi; const size_t it = (size_t)seq * 16 + gI; uv[gi] = *(const GAS f32x4*)(ST + it * 16384 + el); }
}
__device__ __forceinline__ void hgrn_scan_finish(Frame& F, f32x4 (&uv)[16]) {
    int tid = F.tid; asm volatile("" : "+v"(tid));
    const int i = F.vcu * (NWAVES * 64) + tid; float* ST = (float*)(F.ws + WS_HST); const float* Dg = (const float*)(F.ws + WS_HD);
    const int seq = i >> 12, el = (i & 4095) * 4, k = 16 * ((i >> 6) & 7) + 4 * ((i & 63) >> 4), z = seq >> 4;
    f32x4 dv[16];
#pragma unroll
    for (int gi = 0; gi < 16; ++gi) { const int gI = z ? 15 - gi : gi; const size_t it = (size_t)seq * 16 + gI; dv[gi] = *(const GAS f32x4*)(Dg + it * 128 + k); }
    f32x4 S = (f32x4){0.f, 0.f, 0.f, 0.f}; asm volatile("" : "+v"(S));
#pragma unroll
    for (int gi = 0; gi < 16; ++gi) { const int gI = z ? 15 - gi : gi; const size_t it = (size_t)seq * 16 + gI; *(GAS f32x4*)(ST + it * 16384 + el) = S; S = dv[gi] * S + uv[gi]; }
}
template <int z>
__device__ __forceinline__ void hgrn_p3_dir(Frame& F, int e, int b, int h, int gI, bool dry) {
    const int w = F.wave, k2 = F.tid & 63; const int unit_ = (b * 4 + h) * 16 + gI;
    const float lb0 = hgrn_lb(F, e, z, h * 128 + 2 * k2), lb1 = hgrn_lb(F, e, z, h * 128 + 2 * k2 + 1);
    v4u* OFB = (v4u*)(F.ws + WS_OFB);
    const float ngv = F.in[I_HNG][e * 512 + h * 128 + 16 * w + (F.lane & 15)];
    f32x4 S[8];
    TP_BEGIN(12)
    { const float* Sin = (const float*)(F.ws + WS_HST) + (size_t)(((z * 4 + b) * 4 + h) * 16 + gI) * 16384;
#pragma unroll
      for (int kb = 0; kb < 8; ++kb) S[kb] = *(const GAS f32x4*)(Sin + ((w * 8 + kb) * 64 + F.lane) * 4); }
    HgrnRegs R; hgrn_prep_load<3, z>(F, F.tid, (size_t)b * SEQ + gI * 256 + (z ? 3 : 0) * 64, h, R);
    asm volatile("s_waitcnt vmcnt(0)" : "+v"(S[0]), "+v"(S[7]) :: "memory"); TP_END(12)
#pragma unroll 1
    for (int ci = 0; ci < 4; ++ci) { const int cI = z ? 3 - ci : ci; const size_t tok0 = (size_t)b * SEQ + gI * 256 + cI * 64;
        int tid_l = F.tid; asm volatile("" : "+v"(tid_l));
        const int fr = tid_l & 15, g = (tid_l >> 4) & 3, qp = fr >> 2, pp = fr & 3;
        LAS unsigned char* set = F.lds + (ci & 1) * HS_SET;
        float dm0 = 0.f, dm1 = 0.f;
        TP_BEGIN(4) hgrn_prep<3, z>(F, tid_l, set, R, lb0, lb1, dm0, dm1); TP_END(4)
        v4u pk[2];
        if (z == 1) { const v4u* pp_ = OFB + ((size_t)((unit_ * 4 + cI) * NWAVES + w) * 2) * 64 + (tid_l & 63); pk[0] = *(const GAS v4u*)pp_; pk[1] = *(const GAS v4u*)(pp_ + 64); }
        if (ci + 1 < 4) hgrn_prep_load<3, z>(F, tid_l, (size_t)b * SEQ + gI * 256 + (z ? 2 - ci : ci + 1) * 64, h, R);
        lds_barrier();
        if (z == 1) {
#pragma unroll
            for (int i = 0; i < 2; ++i) { const int p = 2 * w + i, row = 4 * p + ((tid_l & 63) >> 4), c16 = ((tid_l & 63) & 15) ^ ((row >> 2) & 3);
                hgrn_glds(F_Y + (tok0 + row) * EVEN_IN + 2048 + h * 128 + c16 * 8, (unsigned)__builtin_amdgcn_readfirstlane((unsigned)(size_t)(F.lds + HG_GT) + p * 1024)); } }
        TP_BEGIN(5)
        { const int tb = w >> 1;
#pragma unroll
          for (int jj = 0; jj < 2; ++jj) { const int jb = 2 * (w & 1) + jj; f32x4 acc = (f32x4){0.f, 0.f, 0.f, 0.f};
              const bool live = z ? (jb >= tb) : (jb <= tb);
              if (live) {
#pragma unroll
                  for (int s = 0; s < 4; ++s) { const bf16x8 kf = *(const LAS bf16x8*)(set + HS_KH + hsw(16 * jb + fr, 64 * s + 16 * g)); const bf16x8 qf = *(const LAS bf16x8*)(set + HS_QH + hsw(16 * tb + fr, 64 * s + 16 * g));
                      acc = __builtin_amdgcn_mfma_f32_16x16x32_bf16(kf, qf, acc, 0, 0, 0); }
#pragma unroll
                  for (int r = 0; r < 4; ++r) { const int j = 16 * jb + 4 * g + r, t = 16 * tb + fr; const bool keep = z ? (j >= t) : (j <= t); acc[r] = keep ? acc[r] : 0.f; } }
              typedef unsigned u32x2 __attribute__((ext_vector_type(2)));
              u32x2 pw; pw.x = pg8::cvt_pk_bf16(acc[0], acc[1]); pw.y = pg8::cvt_pk_bf16(acc[2], acc[3]);
              *(LAS u32x2*)(set + HS_PL + psw(16 * tb + fr, 32 * jb + 8 * g)) = pw; } }
        const LAS float* VEC = (const LAS float*)(set + HS_VEC);
        bf16x8 Sb[4];
#pragma unroll
        for (int s = 0; s < 4; ++s) { const f32x4 ea = *(const LAS f32x4*)(VEC + 32 * s + 4 * g), eb = *(const LAS f32x4*)(VEC + 32 * s + 16 + 4 * g); const f32x4 x = S[2 * s] * ea, y = S[2 * s + 1] * eb;
            v4u pw; pw.x = pg8::cvt_pk_bf16(x[0], x[1]); pw.y = pg8::cvt_pk_bf16(x[2], x[3]); pw.z = pg8::cvt_pk_bf16(y[0], y[1]); pw.w = pg8::cvt_pk_bf16(y[2], y[3]); Sb[s] = __builtin_bit_cast(bf16x8, pw); }
        bf16x8 Vf[2]; hgrn_vfrags(set, w, g, qp, pp, Vf);
        lds_barrier();
        TP_END(5) TP_BEGIN(6)
        f32x4 o[4];
#pragma unroll
        for (int tb = 0; tb < 4; ++tb) { f32x4 acc = (f32x4){0.f, 0.f, 0.f, 0.f}; const int row = 16 * tb + fr;
#pragma unroll
            for (int s = 0; s < 4; ++s) { const bf16x4 lo = *(const LAS bf16x4*)(set + HS_QH + hsw(row, 64 * s + 8 * g)), hi = *(const LAS bf16x4*)(set + HS_QH + hsw(row, 64 * s + 32 + 8 * g));
                const bf16x8 qf = (bf16x8){lo[0], lo[1], lo[2], lo[3], hi[0], hi[1], hi[2], hi[3]};
                acc = __builtin_amdgcn_mfma_f32_16x16x32_bf16(qf, Sb[s], acc, 0, 0, 0); }
#pragma unroll
            for (int s = 0; s < 2; ++s) { const bf16x8 pf = *(const LAS bf16x8*)(set + HS_PL + psw(row, 64 * s + 16 * g));
                acc = __builtin_amdgcn_mfma_f32_16x16x32_bf16(pf, Vf[s], acc, 0, 0, 0); }
            o[tb] = acc; }
        TP_END(6) TP_BEGIN(7)
        { f32x4 T[8];
#pragma unroll
          for (int kb = 0; kb < 8; ++kb) T[kb] = (f32x4){0.f, 0.f, 0.f, 0.f};
          if (P3_PROBE == 4 && dry) hgrn_ktv<true>(set, g, qp, pp, Vf, T); else if (!(P3_PROBE == 3 && dry)) hgrn_ktv(set, g, qp, pp, Vf, T);
#pragma unroll
          for (int kb = 0; kb < 8; ++kb) { const f32x4 dd = *(const LAS f32x4*)(VEC + 256 + 16 * kb + 4 * g), ee = *(const LAS f32x4*)(VEC + 128 + 16 * kb + 4 * g); S[kb] = dd * S[kb] + ee * T[kb]; } }
        TP_END(7) TP_BEGIN(8) TP_BEGIN(10)
        if (z == 0) {
            v4u* pp_ = OFB + ((size_t)((unit_ * 4 + cI) * NWAVES + w) * 2) * 64 + (tid_l & 63);
#pragma unroll
            for (int i = 0; i < 2; ++i) { v4u pw; pw.x = pg8::cvt_pk_bf16(o[2 * i][0], o[2 * i][1]); pw.y = pg8::cvt_pk_bf16(o[2 * i][2], o[2 * i][3]); pw.z = pg8::cvt_pk_bf16(o[2 * i + 1][0], o[2 * i + 1][1]); pw.w = pg8::cvt_pk_bf16(o[2 * i + 1][2], o[2 * i + 1][3]);
                *(GAS v4u*)(pp_ + 64 * i) = pw; }
        } else {
            LAS float* red = (LAS float*)(set + HS_SEG);
            TP_BEGIN(40)
#pragma unroll
            for (int tb = 0; tb < 4; ++tb)
#pragma unroll
                for (int r = 0; r < 4; ++r) { { const unsigned w2_ = pk[tb >> 1][2 * (tb & 1) + (r >> 1)]; o[tb][r] += (r & 1) ? __uint_as_float(w2_ & 0xffff0000u) : __uint_as_float(w2_ << 16); }
                    float ss = row16_sum(o[tb][r] * o[tb][r]);
                    if (fr == 0) red[(tb * 16 + 4 * g + r) * 8 + w] = ss; }
            TP_END(40) TP_BEGIN(41)
            asm volatile("s_waitcnt vmcnt(0)" ::: "memory");
            lds_barrier();
            TP_END(41) TP_BEGIN(42)
#pragma unroll
            for (int tb = 0; tb < 4; ++tb)
#pragma unroll
                for (int r = 0; r < 4; ++r) { const int t = tb * 16 + 4 * g + r; const f32x4 a = *(const LAS f32x4*)(red + t * 8), bq = *(const LAS f32x4*)(red + t * 8 + 4);
                    const float tot = (a[0] + a[1]) + (a[2] + a[3]) + (bq[0] + bq[1]) + (bq[2] + bq[3]); const float rr = __builtin_amdgcn_rsqf(tot * (1.f / 128.f) + EPS);
                    const size_t row = tok0 + t; const float gv = bf2f(*(const LAS unsigned short*)(F.lds + HG_GT + t * 256 + ((((2 * w + (fr >> 3)) ^ ((t >> 2) & 3)) << 4) | ((2 * fr) & 15))));
                    { const float ov_ = o[tb][r] * rr * ngv * gv * sigmoidf_(gv); if (!(P3_PROBE == 1 && dry)) F_MIX[row * DM + 512 + h * 128 + 16 * w + fr] = (bf16)f2bf(ov_); else asm volatile("" :: "v"(ov_)); } }
            TP_END(42)
        }
    if (z == 0) { TP_END(8) } else { TP_END(10) } }
    lds_barrier();
}
__device__ __forceinline__ void hgrn_p3_unit(Frame& F, int e, int unit, bool dry = false) {
    const int gI = unit & 15, h = (unit >> 4) & 3, b = unit >> 6;
    TP_BEGIN(9) hgrn_p3_dir<0>(F, e, b, h, gI, dry);
    asm volatile("s_waitcnt vmcnt(0)" ::: "memory"); __syncthreads();
    hgrn_p3_dir<1>(F, e, b, h, gI, dry); TP_END(9)
}
__device__ __forceinline__ void sgu_load_w(Frame& F, int e, int h) {
    const float* Ws = F.in[I_SGUW] + (size_t)((e * 4 + h) * 128) * 128; const int tid = F.tid;
#pragma unroll
    for (int i = 0; i < 4; ++i) { const int idx = tid + 512 * i, row = idx >> 4, c16 = idx & 15;
        const f32x4 a = *(const GAS f32x4*)(Ws + row * 128 + c16 * 8), bq = *(const GAS f32x4*)(Ws + row * 128 + c16 * 8 + 4);
        v4u w; w.x = pk2(a[0], a[1]); w.y = pk2(a[2], a[3]); w.z = pk2(bq[0], bq[1]); w.w = pk2(bq[2], bq[3]);
        *(LAS v4u*)(F.lds + hsw(row, c16 * 16)) = w; }
    if (tid < 128) ((LAS float*)(F.lds + 65536))[tid] = F.in[I_SGUB][(e * 4 + h) * 128 + tid];
}
__device__ __forceinline__ void sgu_unit(Frame& F, int e, int unit) {
    const int h = unit & 3, n = (unit >> 2) & 31, b = unit >> 7; const size_t row0 = (size_t)b * SEQ + n * 128;
    LAS unsigned char* WT = F.lds; LAS unsigned char* VN = F.lds + 32768;
    const bf16* Y = F_Y; int tid = F.tid; asm volatile("" : "+v"(tid));
    const int lane = tid & 63, w = F.wave, fr = lane & 15, g = lane >> 4, qp = fr >> 2, pp = fr & 3;
    { const int q = tid >> 2, part = tid & 3; const bf16* vp = Y + (row0 + q) * EVEN_IN + 512 + h * 128 + part * 32;
      float gl[32]; float ss = 0.f;
#pragma unroll
      for (int i = 0; i < 4; ++i) { float f8[8]; unpack8(*(const GAS v4u*)(vp + 8 * i), f8);
#pragma unroll
          for (int j = 0; j < 8; ++j) { const float x = gelu_tanh(f8[j]); gl[8 * i + j] = x; ss += x * x; } }
      ss += __shfl_xor(ss, 1); ss += __shfl_xor(ss, 2);
      const float r = __builtin_amdgcn_rsqf(ss * (1.f / 128.f) + EPS); const float* ng = F.in[I_SGUG] + e * 512 + h * 128 + part * 32;
#pragma unroll
      for (int i = 0; i < 4; ++i) { float f8[8];
#pragma unroll
          for (int j = 0; j < 8; ++j) f8[j] = gl[8 * i + j] * r * ng[8 * i + j];
          *(LAS v4u*)(VN + hsw(q, part * 64 + i * 16)) = pack8(f8); } }
    lds_barrier();
    bf16x8 Bf[4];
#pragma unroll
    for (int s = 0; s < 4; ++s) { const int row = 32 * s + 8 * g + qp;
        const v4i16_t lo = tr_read16(VN + hsw(row, 32 * w + 8 * pp)), hi = tr_read16(VN + hsw(row + 4, 32 * w + 8 * pp));
        Bf[s] = (bf16x8){lo[0], lo[1], lo[2], lo[3], hi[0], hi[1], hi[2], hi[3]}; }
    const LAS float* bs = (const LAS float*)(F.lds + 65536);
    unsigned short ur[32];
#pragma unroll
    for (int i = 0; i < 32; ++i) { const int p = 16 * (i >> 2) + 4 * g + (i & 3); ur[i] = Y[(row0 + p) * EVEN_IN + h * 128 + 16 * w + fr]; }
#pragma unroll
    for (int pb = 0; pb < 8; ++pb) { f32x4 acc = (f32x4){0.f, 0.f, 0.f, 0.f};
#pragma unroll
        for (int s = 0; s < 4; ++s) { const bf16x8 af = *(const LAS bf16x8*)(WT + hsw(16 * pb + fr, 64 * s + 16 * g)); acc = __builtin_amdgcn_mfma_f32_16x16x32_bf16(af, Bf[s], acc, 0, 0, 0); }
        const f32x4 b4 = *(const LAS f32x4*)(bs + 16 * pb + 4 * g);
#pragma unroll
        for (int r = 0; r < 4; ++r) { const int p = 16 * pb + 4 * g + r; const float u = bf2f(ur[pb * 4 + r]);
            F_MIX[(row0 + p) * DM + h * 128 + 16 * w + fr] = (bf16)f2bf(gelu_tanh(u) * (acc[r] + b4[r])); } }
    lds_barrier();
}
__device__ __forceinline__ void sgu_phase(Frame& F, int e) {
    int hprev = -1;
    if (F.G == 256) {
        const int x = F.bx & 7, j = F.bx >> 3, b = x >> 1, h = j & 3, n0 = 16 * (x & 1) + (j >> 2);
        lds_barrier(); sgu_load_w(F, e, h);
        sgu_unit(F, e, b * 128 + n0 * 4 + h); sgu_unit(F, e, b * 128 + (n0 + 8) * 4 + h);
        return; }
    for (int u = F.bx; u < 512; u += F.G) { const int h = u & 3; if (h != hprev) { lds_barrier(); sgu_load_w(F, e, h); hprev = h; } sgu_unit(F, e, u); }
}
#ifndef TP_SCALE
#define TP_SCALE 32.f
#define TP_OFFS 0.f
#endif
#ifndef TP_BLK
#define TP_BLK 0
#endif
#ifndef SCAN_OVERLAP
#define SCAN_OVERLAP 1
#endif
#ifndef BARCAT
#define BARCAT -1
#endif
constexpr int NPH = 1 + 2 * 7 + 2 * 6;
struct Args { const float* in[N_IN]; float* out; unsigned char* ws; int ph_lo, ph_hi, li, pad; };
__global__ void __launch_bounds__(NWAVES * 64, 2) fwd_kernel(Args args) {
    extern __shared__ __attribute__((aligned(16))) unsigned char lds[];
    const int wv_ = __builtin_amdgcn_readfirstlane((int)threadIdx.x >> 6);
#define MK_TID(dst) do { int ln_; asm volatile("v_mbcnt_lo_u32_b32 %0, -1, 0\n\tv_mbcnt_hi_u32_b32 %0, -1, %0" : "=v"(ln_)); (dst) = wv_ * 64 + ln_; } while (0)
    { int t0_; MK_TID(t0_);
      for (int u = t0_; u < (LDS_BYTES - LDSCTL_OFF) / 4; u += NWAVES * 64) ((LAS unsigned*)((LAS unsigned char*)lds + LDSCTL_OFF))[u] = 0u;
      __syncthreads();
      if (t0_ == 0) ((gu32*)(args.ws + WS_CTL))[CW_CENSUS + blockIdx.x] = xb_xcc_id() + 1u;
      if (args.ph_hi - args.ph_lo > 1) (void)xcd_barrier_post((unsigned*)((gu32*)(args.ws + WS_CTL) + CW_BAR), (volatile LAS unsigned*)((LAS unsigned char*)lds + MISC_OFF) + 8, t0_ == 0); }
    const int lo = args.ph_lo, hi = args.ph_hi; const int cat_ = -1; (void)cat_;
    int pc = 0;
#if defined(TPROBE) && TPROBE >= 100
    const unsigned long long tk0_ = __builtin_amdgcn_s_memrealtime();
#define TPH_T0 const unsigned long long tph0_ = __builtin_amdgcn_s_memrealtime(); const unsigned long long tpc0_ = __builtin_amdgcn_s_memtime();
#define TPH_T1 if (TPROBE == 200 + cat_ && blockIdx.x == 0 && threadIdx.x == 0) { volatile LAS unsigned long long* pa_ = (volatile LAS unsigned long long*)((LAS unsigned char*)lds + MISC_OFF + 64); pa_[2] = pa_[2] + (__builtin_amdgcn_s_memrealtime() - tph0_); pa_[1] = pa_[1] + (__builtin_amdgcn_s_memtime() - tpc0_); } \
    if (TPROBE == 100 + cat_ && blockIdx.x == 0 && threadIdx.x == 0) { volatile LAS unsigned long long* pa_ = (volatile LAS unsigned long long*)((LAS unsigned char*)lds + MISC_OFF + 64) + 1; *pa_ = *pa_ + (__builtin_amdgcn_s_memrealtime() - tph0_); }
#else
#define TPH_T0
#define TPH_T1
#endif
#if defined(TPROBE) && TPROBE == 150
#define GB_T0 const unsigned long long gb0_ = __builtin_amdgcn_s_memrealtime();
#define GB_T1 if (blockIdx.x == TP_BLK && bb.lead && (BARCAT < 0 || cat_ == BARCAT)) { volatile LAS unsigned long long* pa_ = (volatile LAS unsigned long long*)((LAS unsigned char*)lds + MISC_OFF + 64) + 1; *pa_ = *pa_ + (__builtin_amdgcn_s_memrealtime() - gb0_); }
#else
#define GB_T0
#define GB_T1
#endif
#define GRID_BARRIER() do { unsigned long long wsb_ = (unsigned long long)args.ws; unsigned b0_ = (unsigned)wsb_, b1_ = (unsigned)(wsb_ >> 32); asm volatile("" : "+v"(b0_), "+v"(b1_)); b0_ = __builtin_amdgcn_readfirstlane(b0_); b1_ = __builtin_amdgcn_readfirstlane(b1_);   \
        XcdBarrier bb; bb.bar = (unsigned*)((gu32*)((unsigned char*)(((unsigned long long)b1_ << 32) | b0_) + WS_CTL) + CW_BAR); bb.x = xb_xcc_id(); bb.st = (volatile LAS unsigned*)((LAS unsigned char*)lds + MISC_OFF) + 8; { int tb_; MK_TID(tb_); bb.lead = tb_ == 0; } GB_T0 xcd_barrier(bb); GB_T1 } while (0)
#define GROUP_BARRIER_X(ARR, WON, WTG, ALO, AHI) do { unsigned long long wsb_ = (unsigned long long)args.ws; unsigned b0_ = (unsigned)wsb_, b1_ = (unsigned)(wsb_ >> 32); asm volatile("" : "+v"(b0_), "+v"(b1_)); b0_ = __builtin_amdgcn_readfirstlane(b0_); b1_ = __builtin_amdgcn_readfirstlane(b1_); \
        unsigned* ctl_ = (unsigned*)((gu32*)((unsigned char*)(((unsigned long long)b1_ << 32) | b0_) + WS_CTL)); XcdBarrier bb; bb.bar = ctl_ + CW_BAR; bb.x = xb_xcc_id(); bb.st = (volatile LAS unsigned*)((LAS unsigned char*)lds + MISC_OFF) + 8; int tb_; MK_TID(tb_); bb.lead = tb_ == 0; \
        group_barrier(bb, ctl_, gridDim.x, blockIdx.x, tb_, (ARR), (WON), (WTG), (ALO), (AHI)); } while (0)
#define GROUP_BARRIER() GROUP_BARRIER_X(-1, -1, 0u, -1, -1)
#define GUARD_WAIT(IDX, TGT) do { unsigned long long wsb_ = (unsigned long long)args.ws; unsigned b0_ = (unsigned)wsb_, b1_ = (unsigned)(wsb_ >> 32); asm volatile("" : "+v"(b0_), "+v"(b1_)); b0_ = __builtin_amdgcn_readfirstlane(b0_); b1_ = __builtin_amdgcn_readfirstlane(b1_); \
        unsigned* ctl_ = (unsigned*)((gu32*)((unsigned char*)(((unsigned long long)b1_ << 32) | b0_) + WS_CTL)); XcdBarrier bb; bb.bar = ctl_ + CW_BAR; bb.x = 0u; bb.st = (volatile LAS unsigned*)((LAS unsigned char*)lds + MISC_OFF) + 8; int tb_; MK_TID(tb_); bb.lead = tb_ == 0; \
        guard_wait(bb, ctl_, (IDX), (TGT)); } while (0)
#ifdef PROBE_DUP
#define PH_REP_OPEN for (int rep_ = 0; rep_ < ((cat_ == PROBE_DUP) ? 2 : 1); ++rep_) { if (rep_) GRID_BARRIER();
#define PH_REP_CLOSE }
#define PH_FIRST(x) if (!rep_) { x; }
#define PH_ISDUP (cat_ == PROBE_DUP && rep_ == 0)
#else
#define PH_REP_OPEN {
#define PH_REP_CLOSE }
#define PH_FIRST(x) x;
#define PH_ISDUP false
#endif
#define PH_BEGIN(CAT) if (pc >= lo && pc < hi) { const int cat_ = (CAT); (void)cat_; TPH_T0 PH_REP_OPEN Frame F; { int bx_ = blockIdx.x, tid_; MK_TID(tid_); unsigned long long ws_ = (unsigned long long)args.ws, out_ = (unsigned long long)args.out; unsigned w0 = (unsigned)ws_, w1 = (unsigned)(ws_ >> 32), o0 = (unsigned)out_, o1 = (unsigned)(out_ >> 32); \
        asm volatile("" : "+v"(bx_), "+v"(w0), "+v"(w1), "+v"(o0), "+v"(o1), "+v"(tid_)); bx_ = __builtin_amdgcn_readfirstlane(bx_); w0 = __builtin_amdgcn_readfirstlane(w0); w1 = __builtin_amdgcn_readfirstlane(w1); o0 = __builtin_amdgcn_readfirstlane(o0); o1 = __builtin_amdgcn_readfirstlane(o1); \
        F.lds = (LAS unsigned char*)lds; F.tid = tid_; F.lane = tid_ & 63; F.wave = __builtin_amdgcn_readfirstlane(tid_ >> 6); F.G = gridDim.x; F.in = args.in; \
        F.bx = bx_; F.ws = (unsigned char*)(((unsigned long long)w1 << 32) | w0); F.out = (float*)(((unsigned long long)o1 << 32) | o0); F.vcu = (F.G % 8 == 0) ? (bx_ % 8) * (F.G / 8) + bx_ / 8 : bx_; }
#ifdef PROBE_XBAR
#define PH_XBAR if (cat_ == 9) for (int xb_ = 0; xb_ < PROBE_XBAR; ++xb_) GRID_BARRIER();
#else
#define PH_XBAR
#endif
#define PH_END   PH_REP_CLOSE if (pc + 1 < hi) GRID_BARRIER(); PH_XBAR TPH_T1 } ++pc;
#ifndef NO_GROUP_BARRIER
#define PH_END_G PH_REP_CLOSE if (pc + 1 < hi) GROUP_BARRIER(); PH_XBAR TPH_T1 } ++pc;
#define PH_END_C(cond) PH_REP_CLOSE if (pc + 1 < hi) { if (cond) GROUP_BARRIER(); else GRID_BARRIER(); } PH_XBAR TPH_T1 } ++pc;
#define PH_END_GX(ARR, WON, WTG) PH_REP_CLOSE if (pc + 1 < hi) GROUP_BARRIER_X(ARR, WON, WTG, -1, -1); PH_XBAR TPH_T1 } ++pc;
#define PH_END_GP(ALO, AHI) PH_REP_CLOSE if (pc + 1 < hi) GROUP_BARRIER_X(1, -1, 0u, ALO, AHI); PH_XBAR TPH_T1 } ++pc;
#else
#define PH_END_G PH_END
#define PH_END_C(cond) PH_END
#define PH_END_GX(ARR, WON, WTG) PH_END
#define PH_END_GP(ALO, AHI) PH_END
#endif
#define OWN_UNIT(bx_) ((((((bx_) & 7) >> 1) * 4 + ((bx_) >> 6)) * 16) + 8 * ((bx_) & 1) + (((bx_) >> 3) & 7))
    for (int l = 0; l < DEPTH; ++l) {
        const bool even = (l & 1) == 0; const int li = l >> 1; const int Nin = even ? EVEN_IN : ODD_IN;
        if (l == 0) { PH_BEGIN(0) prep_weights(F, 0, 0, 0, F.G); x_to_bf16(F, F.in[I_X]); PH_END }
        PH_BEGIN(1) { pg8::Gemm g{F_XB, F_WIN, M, Nin, DM, 0, F.tid}; pg8::StaticOrder S; S.init(M, Nin, F.G, F.bx);
            fill_rstd(F, S, (const float*)(F.ws + WS_SSB));
            pg8::EpiBf16S<0> E{F_Y, Nin, (const LAS float*)(F.lds + RST_OFF), (const LAS int*)(F.lds + RST_OFF + 4096), false};
            pg8::gemm_phase<pg8::EpiBf16S<0>, pg8::StaticOrder, true, true>(F.lds + RING_OFF, g, S, E); }
            GUARD_WAIT(1, gridDim.x * (unsigned)l);
            if (even && F.G == 256) { if (F.bx >= 128) { const int sv = F.vcu; F.vcu = F.bx - 128; prep_weights(F, l, 1, 0, 128); F.vcu = sv; } } else prep_weights(F, l, 1, 0, F.G);
        PH_END_C(even)
        if (even) {
            PH_BEGIN(2) { TP_BEGIN(32) if (F.G == 256) { hgrn_p1_item(F, li, OWN_UNIT(F.bx)); hgrn_p1_item(F, li, 256 + OWN_UNIT(F.bx)); } else for (int u = F.bx; u < 512; u += F.G) hgrn_p1_item(F, li, u); TP_END(32) }
            PH_END
            PH_BEGIN(3) { TP_BEGIN(30)
#ifndef PROBE_DUP
              if (SCAN_OVERLAP && F.G * NWAVES * 64 == 32 * 4096) { f32x4 uv_[16]; hgrn_scan_issue(F, uv_); sgu_phase(F, li); hgrn_scan_finish(F, uv_); } else
#endif
              { PH_FIRST(hgrn_scan(F)) sgu_phase(F, li); } TP_END(30) }
              if (l + 1 < DEPTH) { lds_barrier(); prep_weights(F, l + 1, 0, 0, F.G); }
            PH_END
            PH_BEGIN(4) for (int u0_ = F.bx; u0_ < 256; u0_ += F.G) { const int u = (F.G == 256) ? OWN_UNIT(u0_) : u0_;
#if defined(P3_X) && P3_X == 7
                _Pragma("unroll 1") for (int r2_ = 0; r2_ < 2; ++r2_)
#endif
                { int uu_ = u, tt_ = F.tid; asm volatile("" : "+v"(uu_), "+v"(tt_)); uu_ = __builtin_amdgcn_readfirstlane(uu_); F.tid = tt_; F.lane = tt_ & 63; hgrn_p3_unit(F, li, uu_, PH_ISDUP); } } PH_END_GX(0, -1, 0u)
        } else {
            PH_BEGIN(5)
#ifndef NO_ODDPREP
 { TP_BEGIN(33) conv_phase(F, li); TP_END(33) } { TP_BEGIN(34) qk_prep_phase(F, li); TP_END(34) } { TP_BEGIN(35) vt_phase(F); TP_END(35) }
                if (l + 1 < DEPTH) { lds_barrier(); prep_weights(F, l + 1, 0, 0, F.G); }
#endif
 PH_END
            PH_BEGIN(6)
#ifndef NO_ATTN
 { float m2_, lam_, linit_; attn_params(F, li, l, m2_, lam_, linit_); if (F.G == 256) attn_unit(F, li, OWN_UNIT(F.bx), m2_, lam_, linit_); else for (int u = F.vcu; u < 256; u += F.G) attn_unit(F, li, u, m2_, lam_, linit_);     }
#endif
 PH_END_GX(0, -1, 0u)
        }
        PH_BEGIN(7) { pg8::Gemm g{F_MIX, F_WOUT, M, DM, DM, 0, F.tid}; pg8::StaticOrder S; S.init(M, DM, F.G, F.bx);
            { pg8::EpiRes<false, false> E{F_XB, F_XB, DM, (float*)(F.ws + WS_SSA)}; pg8::gemm_phase<pg8::EpiRes<false, false>, pg8::StaticOrder, true, true>(F.lds + RING_OFF, g, S, E); } } PH_END_GX(-1, 0, gridDim.x * (unsigned)(l + 1))
        PH_BEGIN(9) { pg8::Gemm g{F_XB, F_W1, M, FF, DM, 0, F.tid};
#if defined(PROBE_DUP) && defined(PROBE_SHORTK)
            if (rep_ == 0) g.nt_over = PROBE_SHORTK;
#endif
            pg8::StaticOrder S; S.init(M, FF, F.G, F.bx);
            fill_rstd(F, S, (const float*)(F.ws + WS_SSA));
            pg8::EpiBf16S<2> E{F_Y, FF, (const LAS float*)(F.lds + RST_OFF), (const LAS int*)(F.lds + RST_OFF + 4096), false};
#if defined(PROBE_DUP) && defined(PROBE_NOSTORE)
            if (rep_ == 0) E.nostore = true;
#endif
            { TP_BEGIN(1) pg8::gemm_phase<pg8::EpiBf16S<2>, pg8::StaticOrder, true, true>(F.lds + RING_OFF, g, S, E); TP_END(1) } } PH_END_G
        PH_BEGIN(10) { pg8::Gemm g{F_Y, F_W2, M, DM, FF, 0, F.tid}; pg8::StaticOrder S; S.init(M, DM, F.G, F.bx);
            if (l == DEPTH - 1) { pg8::EpiRes<false, true> E{F_XB, F.out, DM, nullptr}; pg8::gemm_phase<pg8::EpiRes<false, true>, pg8::StaticOrder, true, true>(F.lds + RING_OFF, g, S, E); }
            else { pg8::EpiRes<false, false> E{F_XB, F_XB, DM, (float*)(F.ws + WS_SSB)}; pg8::gemm_phase<pg8::EpiRes<false, false>, pg8::StaticOrder, true, true>(F.lds + RING_OFF, g, S, E); } }
        PH_END_GP((int)(((unsigned)(8 * (blockIdx.x & 7) + ((blockIdx.x >> 3) & 7)) * 256u * (unsigned)(even ? ODD_IN : EVEN_IN) * 2u) >> 21), (int)((((unsigned)(8 * (blockIdx.x & 7) + ((blockIdx.x >> 3) & 7)) + 1u) * 256u * (unsigned)(even ? ODD_IN : EVEN_IN) * 2u - 1u) >> 21))
    }
#if defined(TPROBE) && TPROBE >= 100
    if (blockIdx.x == TP_BLK && threadIdx.x == 0) { volatile LAS unsigned long long* pa_ = (volatile LAS unsigned long long*)((LAS unsigned char*)lds + MISC_OFF + 64); *pa_ = __builtin_amdgcn_s_memrealtime() - tk0_; }
#endif
#ifdef TPROBE
    GRID_BARRIER();
    if (blockIdx.x == TP_BLK && threadIdx.x == 0) { volatile LAS unsigned long long* pa = (volatile LAS unsigned long long*)((LAS unsigned char*)lds + MISC_OFF + 64); const float a0 = (float)pa[0], a1 = (float)pa[1];
        args.out[0] = (TPROBE >= 200) ? 10.f + floorf(4.f * a1 / (float)pa[2] + 0.5f) : 10.f + floorf((TPROBE >= 100 ? 200.f : TP_SCALE) * a1 / a0 + 0.5f) - TP_OFFS; }
#endif
#undef PH_BEGIN
#undef PH_END
}

extern "C" void kernel_launch(void* const* d_in, const int* in_sizes, int n_in, void* d_out, int out_size, void* d_ws, size_t ws_size, hipStream_t stream) {
    static int grid = 0;
    if (grid == 0) {
        if (n_in != N_IN || in_sizes[0] != M * DM || out_size != M * DM || ws_size < 255 * MiB) { fprintf(stderr, "kernel_launch: unexpected shapes (n_in %d, in0 %d, out %d, ws %zu)\n", n_in, n_in > 0 ? in_sizes[0] : -1, out_size, ws_size); grid = -1; return; }
        int dev = 0, cus = 0, per_cu = 0;
        if (hipGetDevice(&dev) != hipSuccess || hipDeviceGetAttribute(&cus, hipDeviceAttributeMultiprocessorCount, dev) != hipSuccess) { grid = -1; return; }
        if (hipFuncSetAttribute((const void*)fwd_kernel, hipFuncAttributeMaxDynamicSharedMemorySize, LDS_BYTES) != hipSuccess) { fprintf(stderr, "kernel_launch: hipFuncSetAttribute failed\n"); grid = -1; return; }
        if (hipOccupancyMaxActiveBlocksPerMultiprocessor(&per_cu, (const void*)fwd_kernel, NWAVES * 64, LDS_BYTES) != hipSuccess || per_cu < 1) { fprintf(stderr, "kernel_launch: occupancy query reports %d workgroups per CU\n", per_cu); per_cu = 1; }
        (void)hipGetLastError();
        grid = cus;
    }
    if (grid < 0) return;
    if (hipMemsetAsync((char*)d_ws + WS_CTL, 0, CTL_ZERO_BYTES, stream) != hipSuccess) return;
    Args a{};
    for (int i = 0; i < N_IN; ++i) a.in[i] = (const float*)d_in[i];
    a.out = (float*)d_out; a.ws = (unsigned char*)d_ws;
#if MK_ONE_LAUNCH
    a.ph_lo = 0; a.ph_hi = NPH; a.li = 0;
    hipLaunchKernelGGL(fwd_kernel, dim3(grid), dim3(NWAVES * 64), LDS_BYTES, stream, a);
#else
    for (int p = 0; p < NPH; ++p) { a.ph_lo = p; a.ph_hi = p + 1; a.li = p;
        hipLaunchKernelGGL(fwd_kernel, dim3(grid), dim3(NWAVES * 64), LDS_BYTES, stream, a); }
#endif
}
```
